# Optimizing an MI355X kernel written in HIP

```python
import jax
import jax.numpy as jnp
from jax import lax
import numpy as np

D_MODEL = 1024
BATCH = 8
SEQ = 4096
DEPTH = 4

GRID_W = 64
CTX_LEN = 256
N_MOD = 9
D_FF = 2816
DEEPNORM_ALPHA = (2.0 * DEPTH) ** 0.25
DEEPNORM_BETA = (8.0 * DEPTH) ** -0.25
LN_EPS = 1e-6

GLA_HEADS = 4
GLA_DK = 32
GLA_DV = 64
GLA_GATE_RANK = 16
GLA_GATE_TAU = 16.0
GLA_CHUNK = 64
GLA_W = GLA_HEADS * GLA_DV

SWA_Q_HEADS = 8
SWA_KV_HEADS = 2
SWA_HEAD_DIM = 64
SWA_WINDOW = 128
SWA_BLOCK = 128
SWA_W = SWA_Q_HEADS * SWA_HEAD_DIM
ROPE_BASE = 10000.0

RWKV_HEADS = 4
RWKV_N = 64
RWKV_DECAY_RANK = 64
RWKV_A_RANK = 64
RWKV_GATE_RANK = 128
RWKV_GN_EPS = 64e-5
RWKV_W = RWKV_HEADS * RWKV_N
RWKV_SIZES = (RWKV_W, RWKV_W, RWKV_W, RWKV_DECAY_RANK, RWKV_DECAY_RANK,
              RWKV_A_RANK, RWKV_A_RANK, RWKV_GATE_RANK)
RWKV_IN = 3 * RWKV_W + 2 * RWKV_DECAY_RANK + 2 * RWKV_A_RANK + RWKV_GATE_RANK

IN_SIZES = (GLA_HEADS * GLA_DK, GLA_HEADS * GLA_DK, GLA_W, GLA_W, GLA_GATE_RANK, GLA_GATE_RANK,
            SWA_W, SWA_KV_HEADS * SWA_HEAD_DIM, SWA_KV_HEADS * SWA_HEAD_DIM, RWKV_IN)
D_IN = (2 * GLA_HEADS * GLA_DK + 2 * GLA_W + 2 * GLA_GATE_RANK
        + SWA_W + 2 * SWA_KV_HEADS * SWA_HEAD_DIM + RWKV_IN)
D_MIX = GLA_W + SWA_W + RWKV_W

kernel_name = 'hybrid_gla_swa_rwkv7_macaron_dit'


def split_cols(t, sizes):
    parts, start = [], 0
    for s in sizes:
        parts.append(t[..., start:start + s])
        start += s
    return parts


def flip(t):
    return t[:, ::-1]


def layer_norm(x, g, b):
    xf = x.astype(jnp.float32)
    mu = jnp.mean(xf, axis=-1, keepdims=True)
    var = jnp.mean(jnp.square(xf - mu), axis=-1, keepdims=True)
    y = (xf - mu) * lax.rsqrt(var + LN_EPS) * g.astype(jnp.float32) + b.astype(jnp.float32)
    return y.astype(x.dtype)


def post_norm(x, h, g, b):
    return layer_norm(DEEPNORM_ALPHA * x + h, g, b)


def adaln_params(cvec, w, b):
    m = jax.nn.silu(cvec) @ w + b
    return m.reshape(cvec.shape[0], 1, N_MOD, D_MODEL)


def modulate(h, m, i):
    return h * (1.0 + m[:, :, 3 * i + 1]) + m[:, :, 3 * i]


def swiglu(u, wg, wu, wd):
    return (jax.nn.silu(u @ wg) * (u @ wu)) @ wd


def half_ffn(h, m, i, wg, wu, wd, g, b):
    u = modulate(h, m, i)
    return post_norm(h, 0.5 * m[:, :, 3 * i + 2] * swiglu(u, wg, wu, wd), g, b)


def centred_shift(f):
    zero = jnp.zeros_like(f[:, :1])
    prev = jnp.concatenate([zero, f[:, :-1]], axis=1)
    nxt = jnp.concatenate([f[:, 1:], zero], axis=1)
    return 0.5 * (prev + nxt)


def axial_rope(t, row, col):
    half = t.shape[-1] // 2
    quarter = half // 2
    inv_freq = ROPE_BASE ** (-jnp.arange(quarter, dtype=jnp.float32) / quarter)

    def rotate(seg, pos):
        ang = pos.astype(jnp.float32)[:, None] * inv_freq
        cos = jnp.cos(ang)[None, :, None, :]
        sin = jnp.sin(ang)[None, :, None, :]
        s1 = seg[..., :quarter].astype(jnp.float32)
        s2 = seg[..., quarter:].astype(jnp.float32)
        return jnp.concatenate([s1 * cos - s2 * sin, s1 * sin + s2 * cos], axis=-1)

    out = jnp.concatenate([rotate(t[..., :half], row), rotate(t[..., half:], col)], axis=-1)
    return out.astype(t.dtype)


def sink_softmax(s, sink):
    sink = sink.astype(jnp.float32)
    m = jnp.maximum(jnp.max(s, axis=-1, keepdims=True), sink)
    p = jnp.exp(s - m)
    return p / (jnp.sum(p, axis=-1, keepdims=True) + jnp.exp(sink - m))


def bidirectional(scan_fn, fwd, bwd, s0_f, s0_b):
    y_f, s_f = scan_fn(*fwd, s0_f)
    y_b, s_b = scan_fn(*[flip(t) for t in bwd], s0_b)
    return y_f + flip(y_b), s_f, s_b


def gla_chunk_scan(q, k, v, log_g, s0):
    bsz, n, h, _ = q.shape
    dv = v.shape[-1]
    nc = n // GLA_CHUNK

    def chunks(t):
        t = t.astype(jnp.float32).reshape(bsz, nc, GLA_CHUNK, h, t.shape[-1])
        return jnp.moveaxis(t, 1, 0)

    pos = jnp.arange(GLA_CHUNK)
    lower = (pos[:, None] >= pos[None, :])[None, :, :, None, None]

    def step(S, inp):
        qc, kc, vc, gc = inp
        b = jnp.cumsum(gc, axis=1)
        rel = jnp.exp(jnp.where(lower, b[:, :, None] - b[:, None, :], -jnp.inf))
        att = jnp.einsum('bihd,bjhd,bijhd->bhij', qc, kc, rel)
        o = (jnp.einsum('bhij,bjhe->bihe', att, vc)
             + jnp.einsum('bihd,bhde->bihe', qc * jnp.exp(b), S))
        b_last = b[:, -1]
        S = (jnp.exp(b_last)[..., None] * S
             + jnp.einsum('bjhd,bjhe->bhde', kc * jnp.exp(b_last[:, None] - b), vc))
        return S, o

    S, o = lax.scan(step, s0, (chunks(q), chunks(k), chunks(v), chunks(log_g)))
    return jnp.moveaxis(o, 0, 1).reshape(bsz, n, h, dv), S


def gla_features(parts, gate_up, gate_bias):
    qa, ka, va, ga, zf, zb = parts
    bsz, n, _ = qa.shape
    q = qa.reshape(bsz, n, GLA_HEADS, GLA_DK) * (GLA_DK ** -0.5)
    k = ka.reshape(bsz, n, GLA_HEADS, GLA_DK)
    v = va.reshape(bsz, n, GLA_HEADS, GLA_DV)
    log_g = []
    for d, z in enumerate((zf, zb)):
        lg = jax.nn.log_sigmoid((z @ gate_up[d] + gate_bias[d]).astype(jnp.float32)) / GLA_GATE_TAU
        log_g.append(lg.reshape(bsz, n, GLA_HEADS, GLA_DK))
    return q, k, v, ga, log_g[0], log_g[1]


def gla_output(o, ga, norm_g):
    bsz, n = o.shape[:2]
    o = o * lax.rsqrt(jnp.mean(jnp.square(o), axis=-1, keepdims=True) + LN_EPS)
    o = o.reshape(bsz, n, GLA_W) * norm_g
    return (o * jax.nn.silu(ga)).astype(ga.dtype)


def swa_latent(q, k, v, k_ctx, v_ctx, sink):
    bsz, n, hq, hd = q.shape
    grp = hq // SWA_KV_HEADS
    nb = n // SWA_BLOCK
    scale = hd ** -0.5
    pad = ((0, 0), (SWA_BLOCK, SWA_BLOCK), (0, 0), (0, 0))
    kp, vp = jnp.pad(k, pad), jnp.pad(v, pad)
    qb = jnp.moveaxis(q.reshape(bsz, nb, SWA_BLOCK, SWA_KV_HEADS, grp, hd), 1, 0)
    sink_b = sink.reshape(SWA_KV_HEADS, grp)[None, :, :, None, None]

    def block(args):
        i, qi = args
        kb = lax.dynamic_slice_in_dim(kp, i * SWA_BLOCK, 3 * SWA_BLOCK, axis=1)
        vb = lax.dynamic_slice_in_dim(vp, i * SWA_BLOCK, 3 * SWA_BLOCK, axis=1)
        qpos = i * SWA_BLOCK + jnp.arange(SWA_BLOCK)
        kpos = (i - 1) * SWA_BLOCK + jnp.arange(3 * SWA_BLOCK)
        valid = ((jnp.abs(kpos[None, :] - qpos[:, None]) <= SWA_WINDOW)
                 & (kpos >= 0)[None, :] & (kpos < n)[None, :])
        s_loc = jnp.einsum('bqhgd,bkhd->bhgqk', qi, kb, preferred_element_type=jnp.float32) * scale
        s_loc = jnp.where(valid, s_loc, -jnp.inf)
        s_ctx = jnp.einsum('bqhgd,bkhd->bhgqk', qi, k_ctx, preferred_element_type=jnp.float32) * scale
        p = sink_softmax(jnp.concatenate([s_loc, s_ctx], axis=-1), sink_b).astype(v.dtype)
        return (jnp.einsum('bhgqk,bkhd->bqhgd', p[..., :3 * SWA_BLOCK], vb)
                + jnp.einsum('bhgqk,bkhd->bqhgd', p[..., 3 * SWA_BLOCK:], v_ctx))

    o = lax.map(block, (jnp.arange(nb), qb))
    return jnp.moveaxis(o, 0, 1).reshape(bsz, n, hq * hd)


def swa_context(q, k, v, sink):
    bsz, lc, hq, hd = q.shape
    grp = hq // SWA_KV_HEADS
    qg = q.reshape(bsz, lc, SWA_KV_HEADS, grp, hd)
    s = jnp.einsum('bqhgd,bkhd->bhgqk', qg, k, preferred_element_type=jnp.float32) * (hd ** -0.5)
    p = sink_softmax(s, sink.reshape(SWA_KV_HEADS, grp)[None, :, :, None, None]).astype(v.dtype)
    return jnp.einsum('bhgqk,bkhd->bqhgd', p, v).reshape(bsz, lc, hq * hd)


def rwkv7_scan(r, decay, k, v, kk, a, s0):
    def step(S, inp):
        r_t, w_t, k_t, v_t, kk_t, a_t = inp
        S = (S * w_t[:, :, None, :]
             - jnp.einsum('bhvk,bhk->bhv', S, kk_t)[..., None] * (kk_t * a_t)[:, :, None, :]
             + v_t[..., None] * k_t[:, :, None, :])
        return S, jnp.einsum('bhvk,bhk->bhv', S, r_t)

    xs = tuple(jnp.moveaxis(t.astype(jnp.float32), 1, 0) for t in (r, decay, k, v, kk, a))
    S, y = lax.scan(step, s0, xs)
    return jnp.moveaxis(y, 0, 1), S


def rwkv_features(f, mu, w0, w_up, a0, a_up, g_up, k_k, k_a):
    f = f + mu * (centred_shift(f) - f)
    r, k, v, zwf, zwb, zaf, zab, zg = split_cols(f, RWKV_SIZES)
    bsz, n, _ = f.shape

    def heads(t):
        return t.reshape(bsz, n, RWKV_HEADS, RWKV_N)

    kk = heads((k * k_k).astype(jnp.float32))
    kk = kk / jnp.maximum(jnp.sqrt(jnp.sum(jnp.square(kk), axis=-1, keepdims=True)), 1e-12)
    per_dir = []
    for d, (zw, za) in enumerate(((zwf, zaf), (zwb, zab))):
        w = -jax.nn.softplus(-(w0[d] + jnp.tanh(zw) @ w_up[d])) - 0.5
        decay = jnp.exp(-jnp.exp(w.astype(jnp.float32)))
        a = jax.nn.sigmoid(a0[d] + za @ a_up[d])
        k_d = k * (1.0 + (a - 1.0) * k_a)
        per_dir.append((heads(decay), heads(k_d), heads(a)))
    g = jax.nn.sigmoid(zg) @ g_up
    return heads(r), heads(v), kk, per_dir, g


def rwkv_mix(feats, s0_f, s0_b):
    r, v, kk, ((w_f, k_f, a_f), (w_b, k_b, a_b)), _ = feats
    return bidirectional(rwkv7_scan, (r, w_f, k_f, v, kk, a_f), (r, w_b, k_b, v, kk, a_b), s0_f, s0_b)


def rwkv_output(y, feats, r_k, gn_g, gn_b):
    r, v, _, ((_, k_f, _), (_, k_b, _)), g = feats
    bsz, n = y.shape[:2]
    mu = jnp.mean(y, axis=-1, keepdims=True)
    var = jnp.mean(jnp.square(y - mu), axis=-1, keepdims=True)
    yn = ((y - mu) * lax.rsqrt(var + RWKV_GN_EPS)).reshape(bsz, n, RWKV_W) * gn_g + gn_b
    bonus = jnp.sum(r * (0.5 * (k_f + k_b)) * r_k, axis=-1, keepdims=True) * v
    return ((yn + bonus.reshape(bsz, n, RWKV_W)) * g).astype(g.dtype)


def token_mixing(u_x, u_c, row, col, w_in, gla_up, gla_bias, gla_g, sink,
                 mu, w0, w_up, a0, a_up, g_up, k_k, k_a, r_k, gn_g, gn_b, need_ctx_out):
    bsz, n, _ = u_x.shape
    lc = u_c.shape[1]
    px = split_cols(u_x @ w_in, IN_SIZES)
    pc = split_cols(u_c @ w_in, IN_SIZES)

    qx, kx, vx, gx, lfx, lbx = gla_features(px[:6], gla_up, gla_bias)
    qc, kc, vc, gc, lfc, lbc = gla_features(pc[:6], gla_up, gla_bias)
    zero_a = jnp.zeros((bsz, GLA_HEADS, GLA_DK, GLA_DV), jnp.float32)
    oc, sa_f, sa_b = bidirectional(gla_chunk_scan, (qc, kc, vc, lfc), (qc, kc, vc, lbc), zero_a, zero_a)
    ox, _, _ = bidirectional(gla_chunk_scan, (qx, kx, vx, lfx), (qx, kx, vx, lbx), sa_f, sa_b)
    out_a = gla_output(ox, gx, gla_g)

    sq_x = axial_rope(px[6].reshape(bsz, n, SWA_Q_HEADS, SWA_HEAD_DIM), row, col)
    sk_x = axial_rope(px[7].reshape(bsz, n, SWA_KV_HEADS, SWA_HEAD_DIM), row, col)
    sv_x = px[8].reshape(bsz, n, SWA_KV_HEADS, SWA_HEAD_DIM)
    sk_c = pc[7].reshape(bsz, lc, SWA_KV_HEADS, SWA_HEAD_DIM)
    sv_c = pc[8].reshape(bsz, lc, SWA_KV_HEADS, SWA_HEAD_DIM)
    out_b = swa_latent(sq_x, sk_x, sv_x, sk_c, sv_c, sink)

    fx = rwkv_features(px[9], mu, w0, w_up, a0, a_up, g_up, k_k, k_a)
    fc = rwkv_features(pc[9], mu, w0, w_up, a0, a_up, g_up, k_k, k_a)
    zero_c = jnp.zeros((bsz, RWKV_HEADS, RWKV_N, RWKV_N), jnp.float32)
    yc, sc_f, sc_b = rwkv_mix(fc, zero_c, zero_c)
    yx, _, _ = rwkv_mix(fx, sc_f, sc_b)
    out_c = rwkv_output(yx, fx, r_k, gn_g, gn_b)

    mix_x = jnp.concatenate([out_a, out_b, out_c], axis=-1)
    if not need_ctx_out:
        return mix_x, None
    sq_c = pc[6].reshape(bsz, lc, SWA_Q_HEADS, SWA_HEAD_DIM)
    mix_c = jnp.concatenate([gla_output(oc, gc, gla_g),
                             swa_context(sq_c, sk_c, sv_c, sink),
                             rwkv_output(yc, fc, r_k, gn_g, gn_b)], axis=-1)
    return mix_x, mix_c


def setup_inputs(seed: int = 0) -> dict:
    key = jax.random.key(seed)
    ks = iter(jax.random.split(key, 32))
    L, D = DEPTH, D_MODEL

    def nrm(shape, scale):
        return scale * jax.random.normal(next(ks), shape, jnp.float32)

    return {
        'x': nrm((BATCH, SEQ, D), 1.0),
        'c': nrm((BATCH, D), 1.0),
        'ctx': nrm((BATCH, CTX_LEN, D), 1.0),
        'c_ctx': nrm((D,), 1.0),
        'w_ada': nrm((L, D, N_MOD * D), 0.5 * D ** -0.5),
        'b_ada': nrm((L, N_MOD * D), 0.02),
        'ffn1_wg': nrm((L, D, D_FF), D ** -0.5),
        'ffn1_wu': nrm((L, D, D_FF), D ** -0.5),
        'ffn1_wd': nrm((L, D_FF, D), DEEPNORM_BETA * D_FF ** -0.5),
        'ffn2_wg': nrm((L, D, D_FF), D ** -0.5),
        'ffn2_wu': nrm((L, D, D_FF), D ** -0.5),
        'ffn2_wd': nrm((L, D_FF, D), DEEPNORM_BETA * D_FF ** -0.5),
        'ln_g': 1.0 + nrm((L, 3, D), 0.02),
        'ln_b': nrm((L, 3, D), 0.02),
        'w_in': nrm((L, D, D_IN), D ** -0.5),
        'w_out': nrm((L, D_MIX, D), DEEPNORM_BETA * D_MIX ** -0.5),
        'gla_gate_up': nrm((L, 2, GLA_GATE_RANK, GLA_HEADS * GLA_DK), GLA_GATE_RANK ** -0.5),
        'gla_gate_bias': nrm((L, 2, GLA_HEADS * GLA_DK), 0.1),
        'gla_norm_g': 1.0 + nrm((L, GLA_W), 0.02),
        'swa_sink': nrm((L, SWA_Q_HEADS), 0.5),
        'rwkv_mu': jax.random.uniform(next(ks), (L, RWKV_IN), jnp.float32),
        'rwkv_w0': -2.0 + nrm((L, 2, RWKV_W), 0.5),
        'rwkv_w_up': nrm((L, 2, RWKV_DECAY_RANK, RWKV_W), 0.5 * RWKV_DECAY_RANK ** -0.5),
        'rwkv_a0': nrm((L, 2, RWKV_W), 0.1),
        'rwkv_a_up': nrm((L, 2, RWKV_A_RANK, RWKV_W), RWKV_A_RANK ** -0.5),
        'rwkv_g_up': nrm((L, RWKV_GATE_RANK, RWKV_W), RWKV_GATE_RANK ** -0.5),
        'rwkv_k_k': 0.85 + nrm((L, RWKV_W), 0.05),
        'rwkv_k_a': 1.0 + nrm((L, RWKV_W), 0.05),
        'rwkv_r_k': nrm((L, RWKV_HEADS, RWKV_N), 0.1),
        'rwkv_gn_g': 1.0 + nrm((L, RWKV_W), 0.02),
        'rwkv_gn_b': nrm((L, RWKV_W), 0.02),
    }


def reference(x, c, ctx, c_ctx, w_ada, b_ada, ffn1_wg, ffn1_wu, ffn1_wd, ffn2_wg, ffn2_wu, ffn2_wd,
              ln_g, ln_b, w_in, w_out, gla_gate_up, gla_gate_bias, gla_norm_g, swa_sink,
              rwkv_mu, rwkv_w0, rwkv_w_up, rwkv_a0, rwkv_a_up, rwkv_g_up, rwkv_k_k, rwkv_k_a,
              rwkv_r_k, rwkv_gn_g, rwkv_gn_b):
    n = x.shape[1]
    n_rows = n // GRID_W
    row = jnp.repeat(jnp.arange(n_rows, dtype=jnp.int32), GRID_W)
    col = jnp.tile(jnp.arange(GRID_W, dtype=jnp.int32), n_rows)
    h_x, h_c = x, ctx
    for l in range(DEPTH):
        last = l == DEPTH - 1
        m_x = adaln_params(c, w_ada[l], b_ada[l])
        m_c = adaln_params(c_ctx[None], w_ada[l], b_ada[l])

        h_x = half_ffn(h_x, m_x, 0, ffn1_wg[l], ffn1_wu[l], ffn1_wd[l], ln_g[l, 0], ln_b[l, 0])
        h_c = half_ffn(h_c, m_c, 0, ffn1_wg[l], ffn1_wu[l], ffn1_wd[l], ln_g[l, 0], ln_b[l, 0])

        mix_x, mix_c = token_mixing(
            modulate(h_x, m_x, 1), modulate(h_c, m_c, 1), row, col, w_in[l],
            gla_gate_up[l], gla_gate_bias[l], gla_norm_g[l], swa_sink[l],
            rwkv_mu[l], rwkv_w0[l], rwkv_w_up[l], rwkv_a0[l], rwkv_a_up[l], rwkv_g_up[l],
            rwkv_k_k[l], rwkv_k_a[l], rwkv_r_k[l], rwkv_gn_g[l], rwkv_gn_b[l], not last)
        h_x = post_norm(h_x, m_x[:, :, 5] * (mix_x @ w_out[l]), ln_g[l, 1], ln_b[l, 1])

        h_x = half_ffn(h_x, m_x, 2, ffn2_wg[l], ffn2_wu[l], ffn2_wd[l], ln_g[l, 2], ln_b[l, 2])
        if not last:
            h_c = post_norm(h_c, m_c[:, :, 5] * (mix_c @ w_out[l]), ln_g[l, 1], ln_b[l, 1])
            h_c = half_ffn(h_c, m_c, 2, ffn2_wg[l], ffn2_wu[l], ffn2_wd[l], ln_g[l, 2], ln_b[l, 2])
    return h_x
```

```cpp
#include <hip/hip_runtime.h>
#include <hip/hip_cooperative_groups.h>
#include <cstdio>
#include <cstdint>
namespace cg = cooperative_groups;
namespace pg8 {
#define PG8_LAS __attribute__((address_space(3)))
typedef unsigned short bf16_t;
typedef short bf16x8 __attribute__((ext_vector_type(8)));
typedef float f32x4 __attribute__((ext_vector_type(4)));
typedef unsigned u32x4 __attribute__((ext_vector_type(4)));
constexpr int BM = 256, BK = 64, HALF = 128, HTB = HALF * BK * 2  , STAGE_BYTES = 8 * HTB, NXCD = 8, WGM = 8;

__host__ __device__ __forceinline__ int lds_byte(int r, int c) { const int st = (r >> 4) * 2 + (c >> 5), rr = r & 15, cc = c & 31, ob = rr * 64 + cc * 2; return st * 1024 + (ob ^ (((ob >> 9) & 1) << 5)); }
__host__ __device__ __forceinline__ void stage_rc(int b, int& R, int& C) { const int st = b / 1024, sb = b % 1024, swz = sb ^ (((sb >> 9) & 1) << 5); R = (st >> 1) * 16 + swz / 64; C = (st & 1) * 32 + (swz % 64) / 2; }
__host__ __device__ __forceinline__ int perm32(int rho) { const int n = rho >> 4, i = rho & 15; return 8 * (i >> 2) + 4 * n + (i & 3); }

struct Unit { int pm, pn; };
struct Gemm { const bf16_t* A; const bf16_t* Bt; int M, N, K; };

struct StaticOrder {
    int nM, nN, nwg, G, c;
    __host__ __device__ void init(int M, int N, int G_, int c_) { nM = M / BM; nN = N / BM; nwg = nM * nN; G = G_; c = c_; }
    __host__ __device__ bool next(int i, Unit& u) const {
        const long L = (long)i * G + c; if (L >= nwg) return false;
        int wgid = (int)L; { const int q = nwg / NXCD, r = nwg % NXCD, xcd = wgid % NXCD, off = wgid / NXCD; wgid = (xcd < r ? xcd * (q + 1) : r * (q + 1) + (xcd - r) * q) + off; }
        const int nig = WGM * nN, gid = wgid / nig, fm = gid * WGM, gsz = (nM - fm) < WGM ? (nM - fm) : WGM;
        u.pm = fm + ((wgid % nig) % gsz); u.pn = (wgid % nig) / gsz; return true;
    }
    __device__ __forceinline__ void a_ready(const Unit&) const {}
    __device__ __forceinline__ void done(const Unit&) const {}
};

__device__ __forceinline__ unsigned cvt_pk_bf16(float lo, float hi) { unsigned r; asm volatile("v_cvt_pk_bf16_f32 %0, %1, %2" : "=v"(r) : "v"(lo), "v"(hi)); return r; }
typedef _Float16 f16x8 __attribute__((ext_vector_type(8)));
typedef unsigned u32x2 __attribute__((ext_vector_type(2)));
__device__ __forceinline__ float fast_sigmoid(float x) { return __builtin_amdgcn_rcpf(1.0f + __expf(-x)); }
__device__ __forceinline__ float log_sigmoid(float x) { return fminf(x, 0.f) - __logf(1.0f + __expf(-fabsf(x))); }

struct EpiSwiglu {
    static constexpr bool PERM = true, AFTER_DRAIN = false;
    bf16_t* O; int ldc;
    __device__ __forceinline__ void operator()(const f32x4 (&acc)[2][2][4][2], const Unit& u, int wr, int wc, int fr, int fq) const {
        const int row0 = u.pm * BM + wr * 64 + fr, col0 = u.pn * HALF + wc * 32 + 8 * fq;
#pragma unroll
        for (int ai = 0; ai < 2; ++ai)
#pragma unroll
            for (int m = 0; m < 4; ++m) {
                bf16_t* rowp = O + (size_t)(row0 + ai * HALF + m * 16) * ldc + col0;
                float h[8];
#pragma unroll
                for (int n = 0; n < 2; ++n)
#pragma unroll
                    for (int e = 0; e < 4; ++e) { const float g = acc[ai][0][m][n][e], up = acc[ai][1][m][n][e]; h[4 * n + e] = g * fast_sigmoid(g) * up; }
                u32x4 w; w.x = cvt_pk_bf16(h[0], h[1]); w.y = cvt_pk_bf16(h[2], h[3]); w.z = cvt_pk_bf16(h[4], h[5]); w.w = cvt_pk_bf16(h[6], h[7]);
                *(u32x4*)rowp = w;
            }
    }
};
struct EpiStore {
    static constexpr bool PERM = true, AFTER_DRAIN = false;
    bf16_t* O; int ldc;
    __device__ __forceinline__ void operator()(const f32x4 (&acc)[2][2][4][2], const Unit& u, int wr, int wc, int fr, int fq) const {
        const int row0 = u.pm * BM + wr * 64 + fr, col0 = u.pn * BM + wc * 32 + 8 * fq;
#pragma unroll
        for (int ai = 0; ai < 2; ++ai)
#pragma unroll
            for (int m = 0; m < 4; ++m) {
                bf16_t* rowp = O + (size_t)(row0 + ai * HALF + m * 16) * ldc + col0;
#pragma unroll
                for (int bj = 0; bj < 2; ++bj) { const f32x4 v0 = acc[ai][bj][m][0], v1 = acc[ai][bj][m][1];
                    u32x4 w; w.x = cvt_pk_bf16(v0[0], v0[1]); w.y = cvt_pk_bf16(v0[2], v0[3]); w.z = cvt_pk_bf16(v1[0], v1[1]); w.w = cvt_pk_bf16(v1[2], v1[3]);
                    *(u32x4*)(rowp + bj * HALF) = w; }
            }
    }
};
struct EpiResid {
    static constexpr bool PERM = false, AFTER_DRAIN = false;
    const float* src_lat; const float* src_ctx; float* dst_lat; float* dst_ctx; const float* gate  ; float alpha, coef;
    __device__ __forceinline__ void operator()(const f32x4 (&acc)[2][2][4][2], const Unit& u, int wr, int wc, int fr, int fq) const {
        const bool ctx = u.pm >= 128; const int bi = ctx ? 8 : (u.pm >> 4);
        const float* src = ctx ? src_ctx + (size_t)(u.pm - 128) * BM * 1024 : src_lat + (size_t)u.pm * BM * 1024;
        float* dst = ctx ? dst_ctx + (size_t)(u.pm - 128) * BM * 1024 : dst_lat + (size_t)u.pm * BM * 1024;
        const float* gp = gate + (size_t)bi * 9216;
        const int col0 = u.pn * BM + wc * 32 + 4 * fq;
        f32x4 gv[2][2];
#pragma unroll
        for (int bj = 0; bj < 2; ++bj)
#pragma unroll
            for (int n = 0; n < 2; ++n) gv[bj][n] = *(const f32x4*)(gp + col0 + bj * HALF + n * 16) * coef;
#pragma unroll
        for (int ai = 0; ai < 2; ++ai)
#pragma unroll
            for (int m = 0; m < 4; ++m) { const size_t off = (size_t)(ai * HALF + wr * 64 + m * 16 + fr) * 1024 + col0;
#pragma unroll
                for (int bj = 0; bj < 2; ++bj)
#pragma unroll
                    for (int n = 0; n < 2; ++n) { const f32x4 s = *(const f32x4*)(src + off + bj * HALF + n * 16);
                        *(f32x4*)(dst + off + bj * HALF + n * 16) = s * alpha + gv[bj][n] * acc[ai][bj][m][n]; } }
    }
};
struct EpiLora {
    static constexpr bool PERM = true, AFTER_DRAIN = false;
    _Float16* O; const float* w0; const float* a0; const float* gbias;
    template <int MODE> __device__ __forceinline__ void tile(const f32x4 (&acc)[2][2][4][2], const Unit& u, int wr, int wc, int fr, int fq, const float* bias) const {
        const int row0 = u.pm * BM + wr * 64 + fr, lc0 = wc * 32 + 8 * fq;
        float bv[2][8];
#pragma unroll
        for (int bj = 0; bj < 2; ++bj)
#pragma unroll
            for (int e = 0; e < 8; ++e) bv[bj][e] = (MODE == 2) ? 0.f : bias[lc0 + bj * HALF + e];
#pragma unroll
        for (int ai = 0; ai < 2; ++ai)
#pragma unroll
            for (int m = 0; m < 4; ++m) {
                _Float16* rowp = O + (size_t)(row0 + ai * HALF + m * 16) * 1536 + u.pn * BM + lc0;
#pragma unroll
                for (int bj = 0; bj < 2; ++bj) {
                    f16x8 o;
#pragma unroll
                    for (int e = 0; e < 8; ++e) { const float x = acc[ai][bj][m][e >> 2][e & 3] + bv[bj][e]; float r;
                        if (MODE == 0) r = __expf(-__expf(log_sigmoid(x) - 0.5f));
                        else if (MODE == 1) r = fast_sigmoid(x);
                        else if (MODE == 2) r = x;
                        else r = log_sigmoid(x) * (1.0f / 16.0f);
                        o[e] = (_Float16)r; }
                    *(f16x8*)(rowp + bj * HALF) = o;
                }
            }
    }
    __device__ __forceinline__ void operator()(const f32x4 (&acc)[2][2][4][2], const Unit& u, int wr, int wc, int fr, int fq) const {
        const int pn = u.pn;
        if (pn < 2) tile<0>(acc, u, wr, wc, fr, fq, w0 + pn * 256);
        else if (pn < 4) tile<1>(acc, u, wr, wc, fr, fq, a0 + (pn - 2) * 256);
        else if (pn == 4) tile<2>(acc, u, wr, wc, fr, fq, gbias);
        else tile<3>(acc, u, wr, wc, fr, fq, gbias);
    }
};

template <class Epi, class Sched, bool ALIGN_EPI = false, bool SP2 = false>
__device__ __forceinline__ void gemm_phase(PG8_LAS unsigned char* lds, const Gemm g, const Sched& S, const Epi& E) {
    int tid_ = threadIdx.x; asm volatile("" : "+v"(tid_)); const int tid = tid_, wid = __builtin_amdgcn_readfirstlane(tid >> 6), lane = tid & 63, wr = wid >> 2, wc = wid & 3, fr = lane & 15, fq = lane >> 4;
    const int K = g.K, nt = K / BK;
    unsigned voffA[2], voffB[2];
#pragma unroll
    for (int i = 0; i < 2; ++i) { int R, C; stage_rc(tid * 16 + i * 8192, R, C); const int Rb = Epi::PERM ? ((R & ~31) + perm32(R & 31)) : R;
        voffA[i] = (unsigned)(R * K + C) * 2u; voffB[i] = (unsigned)(Rb * K + C) * 2u; }
    const size_t kstep = (size_t)(BK * 2);
    const size_t hstep = (size_t)HALF * K * 2;
    const size_t tstep = 2 * hstep;
    const unsigned ldsw = (unsigned)wid * 1024u;
    const int aoff = lds_byte(wr * 64 + fr, fq * 8), boff = lds_byte(wc * 32 + fr, fq * 8);
#define PG8_SA(b, h) (((b) * 2 + (h)) * HTB)
#define PG8_SB(b, h) ((4 + (b) * 2 + (h)) * HTB)
#define PG8_STAGE(bufoff, gbase, voff) do { _Pragma("unroll") for (int _i = 0; _i < 2; ++_i) \
        __builtin_amdgcn_global_load_lds((const unsigned*)((const char*)(gbase) + (voff)[_i]), (PG8_LAS unsigned*)(lds + (bufoff) + ldsw + _i * 8192), 16, 0, 0); } while (0)
#define PG8_LDA(dst, b, h) do { _Pragma("unroll") for (int m = 0; m < 4; ++m) _Pragma("unroll") for (int k = 0; k < 2; ++k) dst[m][k] = *(const PG8_LAS bf16x8*)(lds + PG8_SA(b, h) + aoff + m * 2048 + k * 1024); } while (0)
#define PG8_LDB(dst, b, h) do { _Pragma("unroll") for (int n = 0; n < 2; ++n) _Pragma("unroll") for (int k = 0; k < 2; ++k) dst[n][k] = *(const PG8_LAS bf16x8*)(lds + PG8_SB(b, h) + boff + n * 2048 + k * 1024); } while (0)
#define PG8_MMA(ai, bj, At, Bt) do { __builtin_amdgcn_s_setprio(1); _Pragma("unroll") for (int m = 0; m < 4; ++m) _Pragma("unroll") for (int n = 0; n < 2; ++n) _Pragma("unroll") for (int k = 0; k < 2; ++k) \
        acc[ai][bj][m][n] = __builtin_amdgcn_mfma_f32_16x16x32_bf16(Bt[n][k], At[m][k], acc[ai][bj][m][n], 0, 0, 0); __builtin_amdgcn_s_setprio(0); } while (0)
#define PG8_WAIT_V(n) asm volatile("s_waitcnt vmcnt(" #n ")" ::: "memory")
#define PG8_WAIT_L(n) asm volatile("s_waitcnt lgkmcnt(" #n ")" ::: "memory")
#define PG8_BAR __builtin_amdgcn_s_barrier()
#define PG8_SCHED __builtin_amdgcn_sched_barrier(0)
    Unit cur, nxt; int ui = 0;
    if (!S.next(0, cur)) return;
    f32x4 acc[2][2][4][2];
#pragma unroll
    for (int a = 0; a < 2; ++a)
#pragma unroll
        for (int b = 0; b < 2; ++b)
#pragma unroll
            for (int m = 0; m < 4; ++m)
#pragma unroll
                for (int n = 0; n < 2; ++n) acc[a][b][m][n] = (f32x4){0.f, 0.f, 0.f, 0.f};
    bf16x8 At[4][2], B0[2][2], B1[2][2];
    const char* cA = (const char*)g.A + (size_t)cur.pm * tstep; const char* cB = (const char*)g.Bt + (size_t)cur.pn * tstep;
    S.a_ready(cur);
    if constexpr (SP2) {
        PG8_STAGE(PG8_SB(0, 0), cB, voffB); PG8_STAGE(PG8_SB(0, 1), cB + hstep, voffB); PG8_STAGE(PG8_SA(0, 0), cA, voffA); PG8_STAGE(PG8_SA(0, 1), cA + hstep, voffA);
        if (wr == 1) PG8_BAR;
        PG8_WAIT_V(2); PG8_BAR;
        PG8_STAGE(PG8_SB(1, 0), cB + kstep, voffB); PG8_STAGE(PG8_SA(1, 0), cA + kstep, voffA); PG8_STAGE(PG8_SB(1, 1), cB + hstep + kstep, voffB);
        PG8_WAIT_V(6); PG8_BAR;
    } else {
        PG8_STAGE(PG8_SB(0, 0), cB, voffB); PG8_STAGE(PG8_SA(0, 0), cA, voffA); PG8_STAGE(PG8_SB(0, 1), cB + hstep, voffB); PG8_STAGE(PG8_SA(0, 1), cA + hstep, voffA);
        if (wr == 1) PG8_BAR;
        PG8_WAIT_V(4); PG8_BAR;
        PG8_STAGE(PG8_SB(1, 0), cB + kstep, voffB); PG8_STAGE(PG8_SA(1, 0), cA + kstep, voffA); PG8_STAGE(PG8_SB(1, 1), cB + hstep + kstep, voffB);
        PG8_WAIT_V(6); PG8_BAR;
    }
    for (;;) {
        const bool has_next = S.next(ui + 1, nxt);
        const char* nA = has_next ? (const char*)g.A + (size_t)nxt.pm * tstep : cA; const char* nB = has_next ? (const char*)g.Bt + (size_t)nxt.pn * tstep : cB;
        for (int t = 0; t < nt; t += 2) {
            const bool last = (t == nt - 2);
            const char* a1 = cA + (size_t)(t + 1) * kstep;
            const char* a2 = last ? nA : cA + (size_t)(t + 2) * kstep; const char* b2 = last ? nB : cB + (size_t)(t + 2) * kstep;
            const char* a3 = a2 + kstep; const char* b3 = b2 + kstep;
            if (last && has_next) S.a_ready(nxt);
            if constexpr (SP2) {
            PG8_LDB(B0, 0, 0); PG8_LDB(B1, 0, 1); PG8_SCHED; PG8_LDA(At, 0, 0); PG8_STAGE(PG8_SA(1, 1), a1 + hstep, voffA);
            PG8_WAIT_V(8); PG8_WAIT_L(0); PG8_BAR; PG8_MMA(0, 0, At, B0); PG8_MMA(0, 1, At, B1); PG8_BAR; PG8_SCHED;
            PG8_LDA(At, 0, 1); PG8_STAGE(PG8_SB(0, 0), b2, voffB); PG8_STAGE(PG8_SB(0, 1), b2 + hstep, voffB); PG8_STAGE(PG8_SA(0, 0), a2, voffA);
            PG8_WAIT_V(8); PG8_WAIT_L(0); PG8_BAR; PG8_MMA(1, 0, At, B0); PG8_MMA(1, 1, At, B1); PG8_BAR; PG8_SCHED;
            PG8_LDB(B0, 1, 0); PG8_LDB(B1, 1, 1); PG8_SCHED; PG8_LDA(At, 1, 0); PG8_STAGE(PG8_SA(0, 1), a2 + hstep, voffA);
            PG8_WAIT_V(8); PG8_WAIT_L(0); PG8_BAR; PG8_MMA(0, 0, At, B0); PG8_MMA(0, 1, At, B1); PG8_BAR; PG8_SCHED;
            PG8_LDA(At, 1, 1); PG8_STAGE(PG8_SB(1, 0), b3, voffB); PG8_STAGE(PG8_SB(1, 1), b3 + hstep, voffB); PG8_STAGE(PG8_SA(1, 0), a3, voffA);
            PG8_WAIT_V(8); PG8_WAIT_L(0); PG8_BAR; PG8_MMA(1, 0, At, B0); PG8_MMA(1, 1, At, B1); PG8_BAR; PG8_SCHED;
            } else {
            PG8_LDB(B0, 0, 0); PG8_SCHED; PG8_LDA(At, 0, 0); PG8_STAGE(PG8_SA(1, 1), a1 + hstep, voffA);
            PG8_WAIT_L(8); PG8_BAR; PG8_WAIT_L(0); PG8_MMA(0, 0, At, B0); PG8_BAR; PG8_SCHED;
            PG8_LDB(B1, 0, 1); PG8_STAGE(PG8_SB(0, 0), b2, voffB);
            PG8_BAR; PG8_WAIT_L(0); PG8_MMA(0, 1, At, B1); PG8_BAR;
            PG8_LDA(At, 0, 1); PG8_STAGE(PG8_SA(0, 0), a2, voffA);
            PG8_BAR; PG8_WAIT_L(0); PG8_MMA(1, 0, At, B0); PG8_BAR; PG8_SCHED;
            PG8_STAGE(PG8_SB(0, 1), b2 + hstep, voffB);
            PG8_WAIT_V(6); PG8_BAR; PG8_MMA(1, 1, At, B1); PG8_BAR;
            PG8_LDB(B0, 1, 0); PG8_SCHED; PG8_LDA(At, 1, 0); PG8_STAGE(PG8_SA(0, 1), a2 + hstep, voffA);
            PG8_WAIT_L(8); PG8_BAR; PG8_WAIT_L(0); PG8_MMA(0, 0, At, B0); PG8_BAR; PG8_SCHED;
            PG8_LDB(B1, 1, 1); PG8_STAGE(PG8_SB(1, 0), b3, voffB);
            PG8_BAR; PG8_WAIT_L(0); PG8_MMA(0, 1, At, B1); PG8_BAR;
            PG8_LDA(At, 1, 1); PG8_STAGE(PG8_SA(1, 0), a3, voffA);
            PG8_BAR; PG8_WAIT_L(0); PG8_MMA(1, 0, At, B0); PG8_BAR; PG8_SCHED;
            PG8_STAGE(PG8_SB(1, 1), b3 + hstep, voffB);
            PG8_WAIT_V(6); PG8_BAR; PG8_MMA(1, 1, At, B1); PG8_BAR;
            }
        }
        if constexpr (ALIGN_EPI) { if (wr == 0) PG8_BAR; }
        if constexpr (!Epi::AFTER_DRAIN) { E(acc, cur, wr, wc, fr, fq); S.done(cur); }
        if (!has_next) break;
#pragma unroll
        for (int a = 0; a < 2; ++a)
#pragma unroll
            for (int b = 0; b < 2; ++b)
#pragma unroll
                for (int m = 0; m < 4; ++m)
#pragma unroll
                    for (int n = 0; n < 2; ++n) acc[a][b][m][n] = (f32x4){0.f, 0.f, 0.f, 0.f};
        cur = nxt; cA = nA; cB = nB; ++ui;
        if constexpr (ALIGN_EPI) { if (wr == 1) PG8_BAR; }
    }
    PG8_WAIT_V(0);
    if constexpr (!ALIGN_EPI) { if (wr == 0) PG8_BAR; }
    PG8_BAR;
    if constexpr (Epi::AFTER_DRAIN) { E.fused(acc, cur, wr, wc, fr, fq, lds, wid, lane); S.done(cur); }
#undef PG8_SA
#undef PG8_SB
#undef PG8_STAGE
#undef PG8_LDA
#undef PG8_LDB
#undef PG8_MMA
#undef PG8_WAIT_V
#undef PG8_WAIT_L
#undef PG8_BAR
#undef PG8_SCHED
}
}

#define LAS __attribute__((address_space(3)))
typedef unsigned short bf16;
typedef float f32x4 __attribute__((ext_vector_type(4)));
typedef float f32x2 __attribute__((ext_vector_type(2)));
typedef short bf16x8 __attribute__((ext_vector_type(8)));
typedef short bf16x4 __attribute__((ext_vector_type(4)));
typedef unsigned v4u __attribute__((ext_vector_type(4)));
typedef unsigned v2u __attribute__((ext_vector_type(2)));
typedef _Float16 h2 __attribute__((ext_vector_type(2)));
typedef _Float16 h4 __attribute__((ext_vector_type(4)));
typedef _Float16 h8 __attribute__((ext_vector_type(8)));

constexpr int DM = 1024, NBATCH = 8, SEQ = 4096, CTXL = 256, DEPTH = 4, DFF = 2816, DIN = 2720, DINP = 2816;
constexpr int ML = NBATCH * SEQ, MC = NBATCH * CTXL, MA = ML + MC;
constexpr int LORA_K = 512, LORA_N = 1536;
constexpr float ALPHA = 1.681792830507429f;
constexpr float LN_EPS = 1e-6f;
constexpr int PC_GQ = 0, PC_GK = 128, PC_GV = 256, PC_GG = 512, PC_ZF = 768, PC_SQ = 800, PC_SK = 1312, PC_SV = 1440, PC_RW = 1568;
constexpr int LC_DEC = 0, LC_A = 512, LC_G = 1024, LC_LG = 1280;
constexpr int RF_R = 0, RF_K = 256, RF_V = 512, RF_KK = 768;

constexpr size_t MiB = 1u << 20;
constexpr size_t WS_MOD = 1 * MiB;
constexpr size_t WS_WGU1 = 3 * MiB;
constexpr size_t WS_WD1 = WS_WGU1 + 11 * MiB;
constexpr size_t WS_WGU2 = WS_WD1 + 6 * MiB;
constexpr size_t WS_WD2 = WS_WGU2 + 11 * MiB;
constexpr size_t WS_WIN = WS_WD2 + 6 * MiB;
constexpr size_t WS_WOUT = WS_WIN + 6 * MiB;
constexpr size_t WS_WLORA = WS_WOUT + 2 * MiB;
constexpr size_t WS_XC = WS_WLORA + 2 * MiB;
constexpr size_t WS_U = WS_XC + 8 * MiB;
constexpr size_t WS_HID = WS_U + 68 * MiB;
constexpr size_t WS_LO = WS_HID + 187 * MiB;
constexpr size_t WS_RF = WS_LO + 102 * MiB;
constexpr size_t WS_YO = WS_RF + 68 * MiB;
constexpr size_t WS_END = WS_YO + 68 * MiB;
constexpr int LDS_BYTES = 135168;

struct Args { const float* in[31]; float* out; unsigned char* ws; };
enum { I_X = 0, I_C, I_CTX, I_CCTX, I_WADA, I_BADA, I_F1G, I_F1U, I_F1D, I_F2G, I_F2U, I_F2D, I_LNG, I_LNB, I_WIN, I_WOUT, I_GUP, I_GBIAS, I_GNORM, I_SINK,
       I_MU, I_W0, I_WUP, I_A0, I_AUP, I_GUPR, I_KK, I_KA, I_RK, I_GNG, I_GNB };

__device__ __forceinline__ unsigned f2bf(float f) { unsigned u = __builtin_bit_cast(unsigned, f); return (u + 0x7fffu + ((u >> 16) & 1u)) >> 16; }
__device__ __forceinline__ unsigned pk2(float lo, float hi) { return f2bf(lo) | (f2bf(hi) << 16); }
__device__ __forceinline__ float bf2f(unsigned short u) { return __builtin_bit_cast(float, (unsigned)u << 16); }
__device__ __forceinline__ float bflo(unsigned u) { return __builtin_bit_cast(float, u << 16); }
__device__ __forceinline__ float bfhi(unsigned u) { return __builtin_bit_cast(float, u & 0xffff0000u); }
__device__ __forceinline__ float sigmoidf_(float x) { return 1.0f / (1.0f + __expf(-x)); }
__device__ __forceinline__ int otid() { int t = threadIdx.x; asm volatile("" : "+v"(t)); return t; }
__device__ __forceinline__ int obid() { int t = blockIdx.x; asm volatile("" : "+s"(t)); return t; }
__device__ __forceinline__ int ogdim() { int t = gridDim.x; asm volatile("" : "+s"(t)); return t; }
#define LDS_WAIT() asm volatile("s_waitcnt lgkmcnt(0)" ::: "memory")
template <int CTRL> __device__ __forceinline__ float dpp_f(float x) { return __builtin_bit_cast(float, __builtin_amdgcn_update_dpp(0, __builtin_bit_cast(int, x), CTRL, 0xF, 0xF, false)); }
__device__ __forceinline__ float allred16(float x) {
    x += dpp_f<0x128>(x); x += dpp_f<0x124>(x); x += dpp_f<0x122>(x); x += dpp_f<0x121>(x); return x;
}
__device__ __forceinline__ float wave_sum(float v) {
#pragma unroll
    for (int o = 1; o < 64; o <<= 1) v += __shfl_xor(v, o);
    return v;
}

__device__ __forceinline__ void phase_adaln(const Args& a, float* MOD, LAS unsigned char* lds) {
    LAS float* s = (LAS float*)lds;
    LAS float* red = s + 9 * 1024;
    const int tid = otid();
    for (int i = tid; i < 9 * 1024; i += 512) { const int bi = i >> 10, k = i & 1023; const float c = bi < 8 ? a.in[I_C][bi * 1024 + k] : a.in[I_CCTX][k]; s[i] = c * sigmoidf_(c); }
    __syncthreads();
    for (int unit = obid(); unit < 288; unit += ogdim()) {
        const int l = unit / 72, cb = unit % 72, col = cb * 128 + (tid & 127), kq = tid >> 7;
        const float* w = a.in[I_WADA] + (size_t)l * 1024 * 9216 + col;
        float acc[9];
#pragma unroll
        for (int bi = 0; bi < 9; ++bi) acc[bi] = 0.f;
#pragma unroll 8
        for (int k = kq * 256; k < kq * 256 + 256; ++k) { const float wv = w[(size_t)k * 9216];
#pragma unroll
            for (int bi = 0; bi < 9; ++bi) acc[bi] += s[bi * 1024 + k] * wv; }
#pragma unroll
        for (int bi = 0; bi < 9; ++bi) red[tid * 9 + bi] = acc[bi];
        __syncthreads();
        if (kq == 0) { const float bb = a.in[I_BADA][l * 9216 + col];
#pragma unroll
            for (int bi = 0; bi < 9; ++bi) { const float v = red[tid * 9 + bi] + red[(tid + 128) * 9 + bi] + red[(tid + 256) * 9 + bi] + red[(tid + 384) * 9 + bi] + bb;
                MOD[(size_t)(l * 9 + bi) * 9216 + col] = v; } }
        __syncthreads();
    }
}

__device__ __forceinline__ void transpose_item(const float* W, int K, int N, bf16* WT, int kb, int nb, int drow0, LAS float* scr, int lane) {
    const int k0 = 64 * kb, n0 = 32 * nb;
#pragma unroll 8
    for (int i = 0; i < 32; ++i) { const int kk = 2 * i + (lane >> 5); scr[kk * 33 + (lane & 31)] = W[(size_t)(k0 + kk) * N + n0 + (lane & 31)]; }
    LDS_WAIT(); asm volatile("" ::: "memory");
    const int c = lane & 7;
#pragma unroll
    for (int j = 0; j < 4; ++j) { const int n = (lane >> 3) + 8 * j; const LAS float* sp = scr + (8 * c) * 33 + n;
        v4u o; o.x = pk2(sp[0 * 33], sp[1 * 33]); o.y = pk2(sp[2 * 33], sp[3 * 33]); o.z = pk2(sp[4 * 33], sp[5 * 33]); o.w = pk2(sp[6 * 33], sp[7 * 33]);
        *(v4u*)(WT + (size_t)(drow0 + n) * K + k0 + 8 * c) = o; }
    LDS_WAIT(); asm volatile("" ::: "memory");
}
__device__ __forceinline__ void phase_convert(const Args& a, int l, unsigned char* ws, LAS unsigned char* lds) {
    const int tid = otid(), lane = tid & 63, wave = tid >> 6;
    LAS float* scr = (LAS float*)(lds + wave * 8704);
    const int gw = obid() * 8 + wave, NGW = ogdim() * 8;
    constexpr int I_GU = 16 * 88, I_D = 44 * 32, I_IN = 16 * 85, I_OUT = 16 * 32;
    constexpr int NIT = 4 * I_GU + 2 * I_D + I_IN + I_OUT;
    for (int it = gw; it < NIT; it += NGW) {
        int r = it;
        if (r < 4 * I_GU) { const int which = r / I_GU; r -= which * I_GU; const int kb = r / 88, nb = r % 88;
            const float* W = a.in[which == 0 ? I_F1G : which == 1 ? I_F1U : which == 2 ? I_F2G : I_F2U] + (size_t)l * 1024 * DFF;
            bf16* WT = (bf16*)(ws + (which < 2 ? WS_WGU1 : WS_WGU2));
            const int n0 = 32 * nb, drow0 = (n0 >> 7) * 256 + (which & 1) * 128 + (n0 & 127);
            transpose_item(W, 1024, DFF, WT, kb, nb, drow0, scr, lane); continue; }
        r -= 4 * I_GU;
        if (r < 2 * I_D) { const int which = r / I_D; r -= which * I_D; const int kb = r / 32, nb = r % 32;
            const float* W = a.in[which == 0 ? I_F1D : I_F2D] + (size_t)l * DFF * 1024;
            transpose_item(W, DFF, 1024, (bf16*)(ws + (which == 0 ? WS_WD1 : WS_WD2)), kb, nb, 32 * nb, scr, lane); continue; }
        r -= 2 * I_D;
        if (r < I_IN) { const int kb = r / 85, nb = r % 85;
            transpose_item(a.in[I_WIN] + (size_t)l * 1024 * DIN, 1024, DIN, (bf16*)(ws + WS_WIN), kb, nb, 32 * nb, scr, lane); continue; }
        r -= I_IN;
        { const int kb = r / 32, nb = r % 32; transpose_item(a.in[I_WOUT] + (size_t)l * 1024 * 1024, 1024, 1024, (bf16*)(ws + WS_WOUT), kb, nb, 32 * nb, scr, lane); }
    }
    const int gt = obid() * 512 + tid, NGT = ogdim() * 512;
    for (int i = gt; i < 96 * 1024 / 8; i += NGT) *(v4u*)((bf16*)(ws + WS_WIN) + (size_t)DIN * 1024 + (size_t)i * 8) = (v4u){0u, 0u, 0u, 0u};
    const float* wup = a.in[I_WUP] + (size_t)l * 2 * 64 * 256; const float* aup = a.in[I_AUP] + (size_t)l * 2 * 64 * 256;
    const float* gup = a.in[I_GUPR] + (size_t)l * 128 * 256; const float* ggu = a.in[I_GUP] + (size_t)l * 2 * 16 * 128;
    for (int ci = gt; ci < LORA_N * LORA_K / 8; ci += NGT) {
        const int n = ci >> 6, k8 = (ci & 63) * 8; float v[8];
#pragma unroll
        for (int e = 0; e < 8; ++e) v[e] = 0.f;
        const float* src = nullptr; int stride = 0;
        if (n < 256)       { if (k8 < 64)                 { src = wup + (size_t)k8 * 256 + n; stride = 256; } }
        else if (n < 512)  { if (k8 >= 64 && k8 < 128)    { src = wup + 64 * 256 + (size_t)(k8 - 64) * 256 + (n - 256); stride = 256; } }
        else if (n < 768)  { if (k8 >= 128 && k8 < 192)   { src = aup + (size_t)(k8 - 128) * 256 + (n - 512); stride = 256; } }
        else if (n < 1024) { if (k8 >= 192 && k8 < 256)   { src = aup + 64 * 256 + (size_t)(k8 - 192) * 256 + (n - 768); stride = 256; } }
        else if (n < 1280) { if (k8 >= 256 && k8 < 384)   { src = gup + (size_t)(k8 - 256) * 256 + (n - 1024); stride = 256; } }
        else if (n < 1408) { if (k8 >= 384 && k8 < 400)   { src = ggu + (size_t)(k8 - 384) * 128 + (n - 1280); stride = 128; } }
        else               { if (k8 >= 400 && k8 < 416)   { src = ggu + 16 * 128 + (size_t)(k8 - 400) * 128 + (n - 1408); stride = 128; } }
        if (src) {
#pragma unroll
            for (int e = 0; e < 8; ++e) v[e] = src[(size_t)e * stride]; }
        v4u o; o.x = pk2(v[0], v[1]); o.y = pk2(v[2], v[3]); o.z = pk2(v[4], v[5]); o.w = pk2(v[6], v[7]);
        *(v4u*)((bf16*)(ws + WS_WLORA) + (size_t)n * LORA_K + k8) = o;
    }
}

__device__ __forceinline__ float* xrow_ptr(float* xlat, float* xctx, int row) { return row < ML ? xlat + (size_t)row * 1024 : xctx + (size_t)(row - ML) * 1024; }
__device__ __forceinline__ int row_bi(int row) { return row < ML ? (row >> 12) : 8; }

__device__ __forceinline__ void phase_mod0(const Args& a, const float* MOD, bf16* U) {
    const int lane = otid() & 63, gw = obid() * 8 + (otid() >> 6), NGW = ogdim() * 8;
    for (int row = gw; row < MA; row += NGW) {
        const float* xr = row < ML ? a.in[I_X] + (size_t)row * 1024 : a.in[I_CTX] + (size_t)(row - ML) * 1024;
        const float* mp = MOD + (size_t)row_bi(row) * 9216;
#pragma unroll
        for (int j = 0; j < 4; ++j) { const int c = 4 * lane + 256 * j; const f32x4 v = *(const f32x4*)(xr + c), sh = *(const f32x4*)(mp + c), sc = *(const f32x4*)(mp + 1024 + c);
            const f32x4 o = v * (sc + 1.0f) + sh; v2u w; w.x = pk2(o.x, o.y); w.y = pk2(o.z, o.w); *(v2u*)(U + (size_t)row * 1024 + c) = w; }
    }
}
__device__ __forceinline__ void phase_ln(float* xlat, float* xctx, const float* lng, const float* lnb, const float* modn, bf16* U, int nrows, bool write_u) {
    const int lane = otid() & 63, gw = obid() * 8 + (otid() >> 6), NGW = ogdim() * 8;
    for (int row = gw; row < nrows; row += NGW) {
        float* xr = xrow_ptr(xlat, xctx, row);
        f32x4 v[4]; float s = 0.f;
#pragma unroll
        for (int j = 0; j < 4; ++j) { v[j] = *(const f32x4*)(xr + 4 * lane + 256 * j); s += (v[j].x + v[j].y) + (v[j].z + v[j].w); }
        const float mean = wave_sum(s) * (1.0f / 1024.0f); float s2 = 0.f;
#pragma unroll
        for (int j = 0; j < 4; ++j) { v[j] = v[j] - mean; s2 += (v[j].x * v[j].x + v[j].y * v[j].y) + (v[j].z * v[j].z + v[j].w * v[j].w); }
        const float rstd = 1.0f / sqrtf(wave_sum(s2) * (1.0f / 1024.0f) + LN_EPS);
        const float* mp = modn + (size_t)row_bi(row) * 9216;
#pragma unroll
        for (int j = 0; j < 4; ++j) { const int c = 4 * lane + 256 * j; const f32x4 h = v[j] * rstd * *(const f32x4*)(lng + c) + *(const f32x4*)(lnb + c);
            *(f32x4*)(xr + c) = h;
            if (write_u) { const f32x4 sh = *(const f32x4*)(mp + c), sc = *(const f32x4*)(mp + 1024 + c); const f32x4 o = h * (sc + 1.0f) + sh;
                v2u w; w.x = pk2(o.x, o.y); w.y = pk2(o.z, o.w); *(v2u*)(U + (size_t)row * 1024 + c) = w; } }
    }
}

__device__ __forceinline__ void phase_features(const Args& a, int l, bf16* P, _Float16* RF, bf16* AP, LAS unsigned char* lds) {
    LAS f32x2* tab = (LAS f32x2*)lds;
    const int tid = otid(), lane = tid & 63;
    for (int i = tid; i < 1024; i += 512) { const int pos = i >> 4, fi = i & 15; const float inv = exp2f(-(float)fi * (13.287712379549449f / 16.0f)); const float ang = (float)pos * inv;
        tab[i] = (f32x2){cosf(ang), sinf(ang)}; }
    __syncthreads();
    const float* mu = a.in[I_MU] + l * 1152; const float* kkw = a.in[I_KK] + l * 256;
    const int gw = obid() * 8 + (tid >> 6), NGW = ogdim() * 8;
    for (int row = gw; row < MA; row += NGW) {
        const bool lat = row < ML; const int t = lat ? (row & 4095) : ((row - ML) & 255); const int len = lat ? SEQ : CTXL;
        bf16* pr = P + (size_t)row * DINP;
        const float hp = t > 0 ? 0.5f : 0.f, hn = t < len - 1 ? 0.5f : 0.f;
        const bf16* rw = pr + PC_RW; const bf16* rwp = t > 0 ? rw - DINP : rw; const bf16* rwn = t < len - 1 ? rw + DINP : rw;
        _Float16* rf = RF + (size_t)row * 1024; bf16* ap = AP + (size_t)row * LORA_K;
#pragma unroll
        for (int j = 0; j < 9; ++j) {
            const int col = 2 * (lane + 64 * j);
            const unsigned uc = *(const unsigned*)(rw + col), up = *(const unsigned*)(rwp + col), un = *(const unsigned*)(rwn + col);
            const f32x2 m2 = *(const f32x2*)(mu + col);
            const float c0 = bflo(uc), c1 = bfhi(uc);
            const float f0 = c0 + m2.x * (hp * bflo(up) + hn * bflo(un) - c0), f1 = c1 + m2.y * (hp * bfhi(up) + hn * bfhi(un) - c1);
            if (j < 2) { *(h2*)(rf + RF_R + col) = (h2){(_Float16)f0, (_Float16)f1}; }
            else if (j < 4) { const int kc = col - 256; *(h2*)(rf + RF_K + kc) = (h2){(_Float16)f0, (_Float16)f1};
                const f32x2 kw = *(const f32x2*)(kkw + kc); const float q0 = f0 * kw.x, q1 = f1 * kw.y; float ss = q0 * q0 + q1 * q1;
#pragma unroll
                for (int o = 1; o < 32; o <<= 1) ss += __shfl_xor(ss, o);
                const float inv = 1.0f / fmaxf(sqrtf(ss), 1e-12f);
                *(h2*)(rf + RF_KK + kc) = (h2){(_Float16)(q0 * inv), (_Float16)(q1 * inv)}; }
            else if (j < 6) { *(h2*)(rf + RF_V + (col - 512)) = (h2){(_Float16)f0, (_Float16)f1}; }
            else if (j == 6) { *(unsigned*)(ap + (col - 768)) = pk2(tanhf(f0), tanhf(f1)); }
            else if (j == 7) { *(unsigned*)(ap + 128 + (col - 896)) = pk2(f0, f1); }
            else { *(unsigned*)(ap + 256 + (col - 1024)) = pk2(sigmoidf_(f0), sigmoidf_(f1)); }
        }
        { unsigned z = 0u; if (lane < 16) z = *(const unsigned*)(pr + PC_ZF + 2 * lane); *(unsigned*)(ap + 384 + 2 * lane) = z; }
#pragma unroll
        for (int j = 0; j < 5; ++j) {
            const int head = 2 * j + (lane >> 5), pi = lane & 31, fi = pi & 15;
            const int d1 = pi < 16 ? pi : 16 + pi, pos = pi < 16 ? (t >> 6) : (t & 63);
            bf16* hb = pr + (head < 8 ? PC_SQ + head * 64 : PC_SK + (head - 8) * 64);
            const float x1 = bf2f(hb[d1]), x2 = bf2f(hb[d1 + 16]);
            float o1 = x1, o2 = x2;
            if (lat) { const f32x2 cs = tab[pos * 16 + fi]; o1 = x1 * cs.x - x2 * cs.y; o2 = x1 * cs.y + x2 * cs.x; }
            if (head < 8) { o1 *= 0.125f; o2 *= 0.125f; }
            if (lat || head < 8) { hb[d1] = (bf16)f2bf(o1); hb[d1 + 16] = (bf16)f2bf(o2); }
        }
    }
}

__device__ __forceinline__ void phase_rwkv(const Args& a, int l, const _Float16* RF, const _Float16* LO, _Float16* YO, LAS unsigned char* lds) {
    constexpr int T = 32, SF = 336, NCH = (CTXL + SEQ) / T;
    LAS float* buf = (LAS float*)lds; LAS float* ybuf = buf + 2 * T * SF;
    const int tid = otid(), wave = tid >> 6, lane = tid & 63;
    for (int unit = obid(); unit < 256; unit += ogdim()) {
        const int chain = unit >> 2, rq = unit & 3, b = chain >> 3, h = (chain >> 1) & 3, dir = chain & 1;
        _Float16* Y = YO + (size_t)dir * MA * 256;
        const int ltid = tid - 256, lstep = ltid >> 3, lkq = ltid & 7, cols = h * 64 + 8 * lkq;
        float ka[8];
        if (wave >= 4) {
#pragma unroll
            for (int e = 0; e < 8; ++e) ka[e] = a.in[I_KA][l * 256 + cols + e]; }
        auto step_row = [&](int s) -> int { if (s < CTXL) return ML + b * CTXL + (dir ? CTXL - 1 - s : s); const int tq = s - CTXL; return b * SEQ + (dir ? SEQ - 1 - tq : tq); };
        auto load_chunk = [&](int c) {
            const int row = step_row(c * T + lstep);
            const _Float16* rf = RF + (size_t)row * 1024 + cols; const _Float16* lo = LO + (size_t)row * 1536 + dir * 256 + cols;
            const h8 r8 = *(const h8*)(rf + RF_R), k8 = *(const h8*)(rf + RF_K), v8 = *(const h8*)(rf + RF_V), q8 = *(const h8*)(rf + RF_KK);
            const h8 w8 = *(const h8*)(lo + LC_DEC), a8 = *(const h8*)(lo + LC_A);
            LAS float* d = buf + (c & 1) * T * SF + lstep * SF + 8 * lkq;
#pragma unroll
            for (int e = 0; e < 8; ++e) { const float kk = (float)q8[e], av = (float)a8[e], kv = (float)k8[e];
                d[e] = kk; d[64 + e] = (float)w8[e]; d[128 + e] = kk * av; d[192 + e] = kv * (1.0f + (av - 1.0f) * ka[e]); d[256 + e] = (float)r8[e]; }
            if ((lkq >> 1) == rq) { LAS float* dv = buf + (c & 1) * T * SF + lstep * SF + 320 + (lkq & 1) * 8;
#pragma unroll
                for (int e = 0; e < 8; ++e) dv[e] = (float)v8[e]; }
        };
        auto flush_y = [&](int c) {
            const int row = step_row(c * T + lstep);
            const LAS float* yb = ybuf + (c & 1) * T * 16 + lstep * 16 + 2 * lkq;
            *(h2*)(Y + (size_t)row * 256 + h * 64 + rq * 16 + 2 * lkq) = (h2){(_Float16)yb[0], (_Float16)yb[1]};
        };
        f32x4 S = (f32x4){0.f, 0.f, 0.f, 0.f};
        const int kg = lane & 15, ri = wave * 4 + (lane >> 4);
        if (wave >= 4) load_chunk(0);
        __syncthreads();
        for (int c = 0; c < NCH; ++c) {
            if (wave >= 4) { if (c > 0) flush_y(c - 1); if (c + 1 < NCH) load_chunk(c + 1); }
            else {
                const LAS float* bc = buf + (c & 1) * T * SF + 4 * kg; LAS float* yb = ybuf + (c & 1) * T * 16 + ri;
#pragma unroll 8
                for (int s = 0; s < T; ++s) {
                    const LAS float* p = bc + s * SF;
                    const f32x4 kk4 = *(const LAS f32x4*)p, w4 = *(const LAS f32x4*)(p + 64), b4 = *(const LAS f32x4*)(p + 128), kd4 = *(const LAS f32x4*)(p + 192), r4 = *(const LAS f32x4*)(p + 256);
                    const float vv = bc[s * SF + 320 - 4 * kg + ri];
                    float pd = (S.x * kk4.x + S.y * kk4.y) + (S.z * kk4.z + S.w * kk4.w);
                    const float sa = allred16(pd);
                    S = S * w4 + (kd4 * vv - b4 * sa);
                    float qd = (S.x * r4.x + S.y * r4.y) + (S.z * r4.z + S.w * r4.w);
                    const float y = allred16(qd);
                    if (kg == 0) yb[s * 16] = y;
                }
            }
            __syncthreads();
        }
        if (wave >= 4) flush_y(NCH - 1);
        __syncthreads();
    }
}

__device__ __forceinline__ void phase_gla(int l, const bf16* P, const _Float16* LO, _Float16* YO, LAS unsigned char* lds) {
    LAS float* qs = (LAS float*)lds;
    LAS float* kt = qs + 64 * 33;
    LAS float* kh = kt + 64 * 33;
    LAS float* bc = kh + 64 * 33;
    LAS float* vv = bc + 64 * 33;
    LAS float* att = vv + 64 * 17;
    LAS float* Sm = att + 64 * 65;
    LAS float* bl = Sm + 32 * 17;
    const int tid = otid();
    for (int unit = obid(); unit < 256; unit += ogdim()) {
        const int b = unit >> 5, h = (unit >> 3) & 3, dir = (unit >> 2) & 1, eq = unit & 3;
        _Float16* O = YO + (size_t)(2 + dir) * MA * 256;
        for (int i = tid; i < 32 * 17; i += 512) Sm[i] = 0.f;
        for (int cc = 0; cc < 68; ++cc) {
            const bool isc = cc < 4; const int ci = isc ? cc : cc - 4, len = isc ? CTXL : SEQ, rbase = isc ? ML + b * CTXL : b * SEQ;
            const int i = tid >> 3, part = tid & 7;
            const int tq = ci * 64 + i, row = rbase + (dir ? len - 1 - tq : tq);
            __syncthreads();
            {   const bf16* pr = P + (size_t)row * DINP;
                const v2u q2 = *(const v2u*)(pr + PC_GQ + h * 32 + 4 * part), k2 = *(const v2u*)(pr + PC_GK + h * 32 + 4 * part);
                const h4 g4 = *(const h4*)(LO + (size_t)row * 1536 + LC_LG + dir * 128 + h * 32 + 4 * part);
                const unsigned v1 = *(const unsigned*)(pr + PC_GV + h * 64 + eq * 16 + 2 * part);
                LAS float* qd = qs + i * 33 + 4 * part; qd[0] = bflo(q2.x); qd[1] = bfhi(q2.x); qd[2] = bflo(q2.y); qd[3] = bfhi(q2.y);
                LAS float* kd = kt + i * 33 + 4 * part; kd[0] = bflo(k2.x); kd[1] = bfhi(k2.x); kd[2] = bflo(k2.y); kd[3] = bfhi(k2.y);
                LAS float* gd = bc + i * 33 + 4 * part; gd[0] = (float)g4[0]; gd[1] = (float)g4[1]; gd[2] = (float)g4[2]; gd[3] = (float)g4[3];
                vv[i * 17 + 2 * part] = bflo(v1); vv[i * 17 + 2 * part + 1] = bfhi(v1); }
            __syncthreads();
            {
                const int d = tid >> 4, seg = tid & 15;
                const float g0 = bc[(4 * seg) * 33 + d], g1 = bc[(4 * seg + 1) * 33 + d], g2 = bc[(4 * seg + 2) * 33 + d], g3 = bc[(4 * seg + 3) * 33 + d];
                const float t4 = (g0 + g1) + (g2 + g3); float inc = t4;
#pragma unroll
                for (int o = 1; o < 16; o <<= 1) { const float n = __shfl_up(inc, o, 16); if (seg >= o) inc += n; }
                const float ex = inc - t4;
                bc[(4 * seg) * 33 + d] = ex + g0; bc[(4 * seg + 1) * 33 + d] = ex + g0 + g1; bc[(4 * seg + 2) * 33 + d] = ex + g0 + g1 + g2; bc[(4 * seg + 3) * 33 + d] = inc;
                if (seg == 15) bl[d] = inc; }
            __syncthreads();
            {
#pragma unroll
                for (int e = 0; e < 4; ++e) { const int d = 4 * part + e; const float bb = bc[i * 33 + d], kx = kt[i * 33 + d];
                    qs[i * 33 + d] = qs[i * 33 + d] * 0.17677669529663687f * __expf(bb); kt[i * 33 + d] = kx * __expf(-bb); kh[i * 33 + d] = kx * __expf(bl[d] - bb); } }
            __syncthreads();
            {
                const int j0 = 8 * part; float ac[8];
#pragma unroll
                for (int e = 0; e < 8; ++e) ac[e] = 0.f;
                if (j0 <= i) {
                    for (int d = 0; d < 32; ++d) { const float qv = qs[i * 33 + d];
#pragma unroll
                        for (int e = 0; e < 8; ++e) ac[e] += qv * kt[(j0 + e) * 33 + d]; } }
#pragma unroll
                for (int e = 0; e < 8; ++e) att[i * 65 + j0 + e] = (j0 + e <= i) ? ac[e] : 0.f; }
            __syncthreads();
            {
                const int e0 = 2 * part; float o0 = 0.f, o1 = 0.f;
                for (int j = 0; j <= i; ++j) { const float av = att[i * 65 + j]; o0 += av * vv[j * 17 + e0]; o1 += av * vv[j * 17 + e0 + 1]; }
#pragma unroll 8
                for (int d = 0; d < 32; ++d) { const float qv = qs[i * 33 + d]; o0 += qv * Sm[d * 17 + e0]; o1 += qv * Sm[d * 17 + e0 + 1]; }
                *(h2*)(O + (size_t)row * 256 + h * 64 + eq * 16 + e0) = (h2){(_Float16)o0, (_Float16)o1}; }
            __syncthreads();
            {
                const int d = tid >> 4, e = tid & 15; float sacc = __expf(bl[d]) * Sm[d * 17 + e];
#pragma unroll 8
                for (int j = 0; j < 64; ++j) sacc += kh[j * 33 + d] * vv[j * 17 + e];
                Sm[d * 17 + e] = sacc; }
        }
        __syncthreads();
    }
}

__device__ __forceinline__ void phase_swa(const Args& a, int l, const bf16* P, bf16* MIX, bool with_ctx, LAS unsigned char* lds) {
    LAS bf16* Ks = (LAS bf16*)lds;
    LAS bf16* Vt = Ks + 64 * 72;
    const int tid = otid(), wave = tid >> 6, lane = tid & 63, li = lane & 15, lq = lane >> 4;
    const int nunits = with_ctx ? 1088 : 1024;
    for (int u = obid(); u < nunits; u += ogdim()) {
        const bool isctx = u >= 1024;
        int b, kvh, blk;
        if (!isctx) { b = u >> 7; kvh = (u >> 6) & 1; blk = u & 63; } else { const int v = u - 1024; b = v >> 3; kvh = (v >> 2) & 1; blk = v & 3; }
        const int g = wave >> 1, half = wave & 1, hq = kvh * 4 + g;
        const int qtok0 = blk * 64 + half * 32, qrow0 = isctx ? ML + b * CTXL + qtok0 : b * SEQ + qtok0;
        bf16x8 qf[2][2];
#pragma unroll
        for (int qb = 0; qb < 2; ++qb)
#pragma unroll
            for (int ks = 0; ks < 2; ++ks) qf[qb][ks] = *(const bf16x8*)(P + (size_t)(qrow0 + 16 * qb + li) * DINP + PC_SQ + hq * 64 + 32 * ks + 8 * lq);
        f32x4 Oa[4][2];
#pragma unroll
        for (int x = 0; x < 4; ++x)
#pragma unroll
            for (int y = 0; y < 2; ++y) Oa[x][y] = (f32x4){0.f, 0.f, 0.f, 0.f};
        const float sinkv = a.in[I_SINK][l * 8 + hq];
        float mrun[2], lrun[2];
#pragma unroll
        for (int qb = 0; qb < 2; ++qb) { mrun[qb] = sinkv; lrun[qb] = lq == 0 ? 1.0f : 0.f; }
        int lo = 0, nlocal = 0;
        if (!isctx) { lo = 64 * blk - 128; if (lo < 0) lo = 0; int hi = 64 * blk + 192; if (hi > SEQ) hi = SEQ; nlocal = (hi - lo) >> 6; }
        const int ntiles = nlocal + 4;
        for (int t = 0; t < ntiles; ++t) {
            const bool local = t < nlocal; const int ktok0 = local ? lo + 64 * t : 64 * (t - nlocal); const int krow0 = local ? b * SEQ + ktok0 : ML + b * CTXL + ktok0;
            __syncthreads();
            {   const int key = tid >> 3, ch = tid & 7; const bf16* src = P + (size_t)(krow0 + key) * DINP;
                const v4u kv = *(const v4u*)(src + PC_SK + kvh * 64 + 8 * ch); *(LAS v4u*)(Ks + key * 72 + 8 * ch) = kv;
                const v4u v8 = *(const v4u*)(src + PC_SV + kvh * 64 + 8 * ch);
                LAS bf16* vd = Vt + (8 * ch) * 68 + key;
                vd[0 * 68] = (bf16)(v8.x & 0xffffu); vd[1 * 68] = (bf16)(v8.x >> 16); vd[2 * 68] = (bf16)(v8.y & 0xffffu); vd[3 * 68] = (bf16)(v8.y >> 16);
                vd[4 * 68] = (bf16)(v8.z & 0xffffu); vd[5 * 68] = (bf16)(v8.z >> 16); vd[6 * 68] = (bf16)(v8.w & 0xffffu); vd[7 * 68] = (bf16)(v8.w >> 16); }
            __syncthreads();
            const bool rel = !local || (ktok0 + 63 >= qtok0 - 128 && ktok0 <= qtok0 + 31 + 128);
            if (rel) {
#pragma unroll
                for (int qb = 0; qb < 2; ++qb) {
                    f32x4 s[4];
#pragma unroll
                    for (int kb = 0; kb < 4; ++kb) { s[kb] = (f32x4){0.f, 0.f, 0.f, 0.f};
#pragma unroll
                        for (int ks = 0; ks < 2; ++ks) { const bf16x8 kf = *(const LAS bf16x8*)(Ks + (16 * kb + li) * 72 + 32 * ks + 8 * lq);
                            s[kb] = __builtin_amdgcn_mfma_f32_16x16x32_bf16(kf, qf[qb][ks], s[kb], 0, 0, 0); } }
                    if (local) { const int qt = qtok0 + 16 * qb + li;
#pragma unroll
                        for (int kb = 0; kb < 4; ++kb)
#pragma unroll
                            for (int j = 0; j < 4; ++j) { const int dlt = ktok0 + 16 * kb + 4 * lq + j - qt; if (dlt > 128 || dlt < -128) s[kb][j] = -INFINITY; } }
                    float mx = -INFINITY;
#pragma unroll
                    for (int kb = 0; kb < 4; ++kb) mx = fmaxf(mx, fmaxf(fmaxf(s[kb][0], s[kb][1]), fmaxf(s[kb][2], s[kb][3])));
                    mx = fmaxf(mx, __shfl_xor(mx, 16)); mx = fmaxf(mx, __shfl_xor(mx, 32));
                    const float mnew = fmaxf(mrun[qb], mx), corr = __expf(mrun[qb] - mnew); mrun[qb] = mnew;
                    float ls = 0.f;
#pragma unroll
                    for (int kb = 0; kb < 4; ++kb)
#pragma unroll
                        for (int j = 0; j < 4; ++j) { const float p = __expf(s[kb][j] - mnew); s[kb][j] = p; ls += p; }
                    lrun[qb] = lrun[qb] * corr + ls;
#pragma unroll
                    for (int db = 0; db < 4; ++db) Oa[db][qb] = Oa[db][qb] * corr;
#pragma unroll
                    for (int kk = 0; kk < 2; ++kk) {
                        v4u pw; pw.x = pk2(s[2 * kk][0], s[2 * kk][1]); pw.y = pk2(s[2 * kk][2], s[2 * kk][3]); pw.z = pk2(s[2 * kk + 1][0], s[2 * kk + 1][1]); pw.w = pk2(s[2 * kk + 1][2], s[2 * kk + 1][3]);
                        const bf16x8 pf = __builtin_bit_cast(bf16x8, pw);
#pragma unroll
                        for (int db = 0; db < 4; ++db) { const LAS bf16* vp = Vt + (16 * db + li) * 68 + 32 * kk + 4 * lq;
                            const v2u va = *(const LAS v2u*)vp, vb = *(const LAS v2u*)(vp + 16);
                            const bf16x8 vf = __builtin_bit_cast(bf16x8, (v4u){va.x, va.y, vb.x, vb.y});
                            Oa[db][qb] = __builtin_amdgcn_mfma_f32_16x16x32_bf16(vf, pf, Oa[db][qb], 0, 0, 0); }
                    }
                }
            }
        }
#pragma unroll
        for (int qb = 0; qb < 2; ++qb) { float lt = lrun[qb]; lt += __shfl_xor(lt, 16); lt += __shfl_xor(lt, 32); const float inv = 1.0f / lt;
            bf16* op = MIX + (size_t)(qrow0 + 16 * qb + li) * 1024 + 256 + hq * 64 + 4 * lq;
#pragma unroll
            for (int db = 0; db < 4; ++db) { const f32x4 o = Oa[db][qb] * inv; v2u w; w.x = pk2(o.x, o.y); w.y = pk2(o.z, o.w); *(v2u*)(op + 16 * db) = w; } }
    }
}

__device__ __forceinline__ void phase_assemble(const Args& a, int l, const bf16* P, const _Float16* RF, const _Float16* LO, const _Float16* YO, bf16* MIX, int nrows) {
    const int lane = otid() & 63, gw = obid() * 8 + (otid() >> 6), NGW = ogdim() * 8, c = 4 * lane;
    const f32x4 ng = *(const f32x4*)(a.in[I_GNORM] + l * 256 + c), ka = *(const f32x4*)(a.in[I_KA] + l * 256 + c), rk = *(const f32x4*)(a.in[I_RK] + l * 256 + c);
    const f32x4 gg = *(const f32x4*)(a.in[I_GNG] + l * 256 + c), gb = *(const f32x4*)(a.in[I_GNB] + l * 256 + c);
    for (int row = gw; row < nrows; row += NGW) {
        {
            const h4 of = *(const h4*)(YO + ((size_t)2 * MA + row) * 256 + c), ob = *(const h4*)(YO + ((size_t)3 * MA + row) * 256 + c);
            f32x4 o; float ss = 0.f;
#pragma unroll
            for (int e = 0; e < 4; ++e) { o[e] = (float)of[e] + (float)ob[e]; ss += o[e] * o[e]; }
            ss += __shfl_xor(ss, 1); ss += __shfl_xor(ss, 2); ss += __shfl_xor(ss, 4); ss += __shfl_xor(ss, 8);
            const float rms = 1.0f / sqrtf(ss * (1.0f / 64.0f) + LN_EPS);
            const v2u g2 = *(const v2u*)(P + (size_t)row * DINP + PC_GG + c);
            const float ga[4] = {bflo(g2.x), bfhi(g2.x), bflo(g2.y), bfhi(g2.y)}; float r[4];
#pragma unroll
            for (int e = 0; e < 4; ++e) r[e] = o[e] * rms * ng[e] * (ga[e] * sigmoidf_(ga[e]));
            v2u w; w.x = pk2(r[0], r[1]); w.y = pk2(r[2], r[3]); *(v2u*)(MIX + (size_t)row * 1024 + c) = w; }
        {
            const h4 yf = *(const h4*)(YO + ((size_t)0 * MA + row) * 256 + c), yb = *(const h4*)(YO + ((size_t)1 * MA + row) * 256 + c);
            const _Float16* rf = RF + (size_t)row * 1024 + c; const _Float16* lo = LO + (size_t)row * 1536 + c;
            const h4 r4 = *(const h4*)(rf + RF_R), k4 = *(const h4*)(rf + RF_K), v4 = *(const h4*)(rf + RF_V);
            const h4 af = *(const h4*)(lo + LC_A), ab = *(const h4*)(lo + LC_A + 256), g4 = *(const h4*)(lo + LC_G);
            f32x4 y; float s1 = 0.f, bon = 0.f;
#pragma unroll
            for (int e = 0; e < 4; ++e) { y[e] = (float)yf[e] + (float)yb[e]; s1 += y[e];
                bon += (float)r4[e] * (float)k4[e] * (1.0f + (0.5f * ((float)af[e] + (float)ab[e]) - 1.0f) * ka[e]) * rk[e]; }
            s1 += __shfl_xor(s1, 1); s1 += __shfl_xor(s1, 2); s1 += __shfl_xor(s1, 4); s1 += __shfl_xor(s1, 8);
            bon += __shfl_xor(bon, 1); bon += __shfl_xor(bon, 2); bon += __shfl_xor(bon, 4); bon += __shfl_xor(bon, 8);
            const float mu = s1 * (1.0f / 64.0f); float s2 = 0.f;
#pragma unroll
            for (int e = 0; e < 4; ++e) { y[e] -= mu; s2 += y[e] * y[e]; }
            s2 += __shfl_xor(s2, 1); s2 += __shfl_xor(s2, 2); s2 += __shfl_xor(s2, 4); s2 += __shfl_xor(s2, 8);
            const float rstd = 1.0f / sqrtf(s2 * (1.0f / 64.0f) + 64e-5f); float r[4];
#pragma unroll
            for (int e = 0; e < 4; ++e) r[e] = (y[e] * rstd * gg[e] + gb[e] + bon * (float)v4[e]) * (float)g4[e];
            v2u w; w.x = pk2(r[0], r[1]); w.y = pk2(r[2], r[3]); *(v2u*)(MIX + (size_t)row * 1024 + 768 + c) = w; }
    }
}

#define GSYNC() grid.sync()
__global__ void __launch_bounds__(512, 2) mega_fwd(Args a) {
    extern __shared__ __attribute__((aligned(16))) unsigned char lds_raw[];
    cg::grid_group grid = cg::this_grid();
    LAS unsigned char* lds = (LAS unsigned char*)lds_raw;
    unsigned char* ws = a.ws;
    float* MOD = (float*)(ws + WS_MOD);
    float* XL = a.out; float* XC = (float*)(ws + WS_XC);
    bf16* U = (bf16*)(ws + WS_U); bf16* HID = (bf16*)(ws + WS_HID);
    _Float16* LO = (_Float16*)(ws + WS_LO); _Float16* RF = (_Float16*)(ws + WS_RF); _Float16* YO = (_Float16*)(ws + WS_YO);

    phase_adaln(a, MOD, lds);
    __syncthreads();
    phase_convert(a, 0, ws, lds);
    GSYNC();
    phase_mod0(a, MOD, U);
    GSYNC();
    for (int l = 0; l < DEPTH; ++l) {
        const bool last = (l == DEPTH - 1);
        const float* modl = MOD + (size_t)l * 9 * 9216;
        const float* lng = a.in[I_LNG] + l * 3 * 1024; const float* lnb = a.in[I_LNB] + l * 3 * 1024;
        { pg8::Gemm g{U, (const bf16*)(ws + WS_WGU1), MA, 2 * DFF, 1024}; pg8::StaticOrder S; S.init(MA, 2 * DFF, ogdim(), obid());
          pg8::EpiSwiglu E{HID, DFF}; pg8::gemm_phase<pg8::EpiSwiglu, pg8::StaticOrder, true, true>(lds, g, S, E); }
        GSYNC();
        { pg8::Gemm g{HID, (const bf16*)(ws + WS_WD1), MA, 1024, DFF}; pg8::StaticOrder S; S.init(MA, 1024, ogdim(), obid());
          pg8::EpiResid E{l == 0 ? a.in[I_X] : XL, l == 0 ? a.in[I_CTX] : XC, XL, XC, modl + 2 * 1024, ALPHA, 0.5f};
          pg8::gemm_phase<pg8::EpiResid, pg8::StaticOrder, true, true>(lds, g, S, E); }
        GSYNC();
        phase_ln(XL, XC, lng, lnb, modl + 3 * 1024, U, MA, true);
        GSYNC();
        { pg8::Gemm g{U, (const bf16*)(ws + WS_WIN), MA, DINP, 1024}; pg8::StaticOrder S; S.init(MA, DINP, ogdim(), obid());
          pg8::EpiStore E{HID, DINP}; pg8::gemm_phase<pg8::EpiStore, pg8::StaticOrder, true, true>(lds, g, S, E); }
        GSYNC();
        phase_features(a, l, HID, RF, U, lds);
        GSYNC();
        { pg8::Gemm g{U, (const bf16*)(ws + WS_WLORA), MA, LORA_N, LORA_K}; pg8::StaticOrder S; S.init(MA, LORA_N, ogdim(), obid());
          pg8::EpiLora E{LO, a.in[I_W0] + l * 512, a.in[I_A0] + l * 512, a.in[I_GBIAS] + l * 256};
          pg8::gemm_phase<pg8::EpiLora, pg8::StaticOrder, true, true>(lds, g, S, E); }
        GSYNC();
        phase_rwkv(a, l, RF, LO, YO, lds);
        __syncthreads();
        phase_gla(l, HID, LO, YO, lds);
        __syncthreads();
        phase_swa(a, l, HID, U, !last, lds);
        GSYNC();
        phase_assemble(a, l, HID, RF, LO, YO, U, last ? ML : MA);
        GSYNC();
        const int Mo = last ? ML : MA;
        { pg8::Gemm g{U, (const bf16*)(ws + WS_WOUT), Mo, 1024, 1024}; pg8::StaticOrder S; S.init(Mo, 1024, ogdim(), obid());
          pg8::EpiResid E{XL, XC, XL, XC, modl + 5 * 1024, ALPHA, 1.0f};
          pg8::gemm_phase<pg8::EpiResid, pg8::StaticOrder, true, true>(lds, g, S, E); }
        GSYNC();
        phase_ln(XL, XC, lng + 1024, lnb + 1024, modl + 6 * 1024, U, Mo, true);
        GSYNC();
        { pg8::Gemm g{U, (const bf16*)(ws + WS_WGU2), Mo, 2 * DFF, 1024}; pg8::StaticOrder S; S.init(Mo, 2 * DFF, ogdim(), obid());
          pg8::EpiSwiglu E{HID, DFF}; pg8::gemm_phase<pg8::EpiSwiglu, pg8::StaticOrder, true, true>(lds, g, S, E); }
        GSYNC();
        { pg8::Gemm g{HID, (const bf16*)(ws + WS_WD2), Mo, 1024, DFF}; pg8::StaticOrder S; S.init(Mo, 1024, ogdim(), obid());
          pg8::EpiResid E{XL, XC, XL, XC, modl + 8 * 1024, ALPHA, 0.5f};
          pg8::gemm_phase<pg8::EpiResid, pg8::StaticOrder, true, true>(lds, g, S, E); }
        GSYNC();
        phase_ln(XL, XC, lng + 2048, lnb + 2048, MOD + (size_t)(last ? l : l + 1) * 9 * 9216, U, Mo, !last);
        if (!last) { __syncthreads(); phase_convert(a, l + 1, ws, lds); }
        GSYNC();
    }
}

extern "C" void kernel_launch(void* const* d_in, const int* in_sizes, int n_in, void* d_out, int out_size, void* d_ws, size_t ws_size, hipStream_t stream) {
    static int grid = 0;
    if (grid == 0) {
        if (n_in != 31 || out_size != ML * DM || ws_size < WS_END) { fprintf(stderr, "kernel_launch: unexpected problem (n_in %d, out %d, ws %zu need %zu)\n", n_in, out_size, ws_size, (size_t)WS_END); grid = -1; return; }
        int dev = 0, cus = 0, per_cu = 0;
        hipGetDevice(&dev); hipDeviceGetAttribute(&cus, hipDeviceAttributeMultiprocessorCount, dev);
        if (hipFuncSetAttribute((const void*)mega_fwd, hipFuncAttributeMaxDynamicSharedMemorySize, LDS_BYTES) != hipSuccess) { fprintf(stderr, "kernel_launch: hipFuncSetAttribute failed\n"); grid = -1; return; }
        if (hipOccupancyMaxActiveBlocksPerMultiprocessor(&per_cu, (const void*)mega_fwd, 512, LDS_BYTES) != hipSuccess || per_cu < 1) { fprintf(stderr, "kernel_launch: occupancy query says %d\n", per_cu); per_cu = 1; }
        (void)hipGetLastError();
        grid = cus * per_cu;
    }
    if (grid < 0) return;
    Args a{};
    for (int i = 0; i < 31; ++i) a.in[i] = (const float*)d_in[i];
    a.out = (float*)d_out; a.ws = (unsigned char*)d_ws;
    void* args[] = {&a};
    const hipError_t e = hipLaunchCooperativeKernel((const void*)mega_fwd, dim3(grid), dim3(512), args, LDS_BYTES, stream);
    if (e != hipSuccess) fprintf(stderr, "kernel_launch: cooperative launch failed: %s (grid %d)\n", hipGetErrorString(e), grid);
}
```

```cpp
#include <hip/hip_runtime.h>
#include <hip/hip_cooperative_groups.h>
#include <cstdio>
#include <cstdint>
namespace cg = cooperative_groups;
namespace pg8 {
#define PG8_LAS __attribute__((address_space(3)))
typedef unsigned short bf16_t;
typedef short bf16x8 __attribute__((ext_vector_type(8)));
typedef float f32x4 __attribute__((ext_vector_type(4)));
typedef unsigned u32x4 __attribute__((ext_vector_type(4)));
constexpr int BM = 256, BK = 64, HALF = 128, HTB = HALF * BK * 2  , STAGE_BYTES = 8 * HTB, NXCD = 8, WGM = 8;

__host__ __device__ __forceinline__ int lds_byte(int r, int c) { const int st = (r >> 4) * 2 + (c >> 5), rr = r & 15, cc = c & 31, ob = rr * 64 + cc * 2; return st * 1024 + (ob ^ (((ob >> 9) & 1) << 5)); }
__host__ __device__ __forceinline__ void stage_rc(int b, int& R, int& C) { const int st = b / 1024, sb = b % 1024, swz = sb ^ (((sb >> 9) & 1) << 5); R = (st >> 1) * 16 + swz / 64; C = (st & 1) * 32 + (swz % 64) / 2; }
__host__ __device__ __forceinline__ int perm32(int rho) { const int n = rho >> 4, i = rho & 15; return 8 * (i >> 2) + 4 * n + (i & 3); }

struct Unit { int pm, pn; };
struct Gemm { const bf16_t* A; const bf16_t* Bt; int M, N, K; };

struct StaticOrder {
    int nM, nN, nwg, G, c;
    __host__ __device__ void init(int M, int N, int G_, int c_) { nM = M / BM; nN = N / BM; nwg = nM * nN; G = G_; c = c_; }
    __host__ __device__ bool next(int i, Unit& u) const {
        const long L = (long)i * G + c; if (L >= nwg) return false;
        int wgid = (int)L; { const int q = nwg / NXCD, r = nwg % NXCD, xcd = wgid % NXCD, off = wgid / NXCD; wgid = (xcd < r ? xcd * (q + 1) : r * (q + 1) + (xcd - r) * q) + off; }
        const int nig = WGM * nN, gid = wgid / nig, fm = gid * WGM, gsz = (nM - fm) < WGM ? (nM - fm) : WGM;
        u.pm = fm + ((wgid % nig) % gsz); u.pn = (wgid % nig) / gsz; return true;
    }
    __device__ __forceinline__ void a_ready(const Unit&) const {}
    __device__ __forceinline__ void done(const Unit&) const {}
};

__device__ __forceinline__ unsigned cvt_pk_bf16(float lo, float hi) { unsigned r; asm volatile("v_cvt_pk_bf16_f32 %0, %1, %2" : "=v"(r) : "v"(lo), "v"(hi)); return r; }
typedef _Float16 f16x8 __attribute__((ext_vector_type(8)));
typedef unsigned u32x2 __attribute__((ext_vector_type(2)));
__device__ __forceinline__ float fast_sigmoid(float x) { return __builtin_amdgcn_rcpf(1.0f + __expf(-x)); }
__device__ __forceinline__ float log_sigmoid(float x) { return fminf(x, 0.f) - __logf(1.0f + __expf(-fabsf(x))); }

struct EpiSwiglu {
    static constexpr bool PERM = true, AFTER_DRAIN = false;
    bf16_t* O; int ldc;
    __device__ __forceinline__ void operator()(const f32x4 (&acc)[2][2][4][2], const Unit& u, int wr, int wc, int fr, int fq) const {
        const int row0 = u.pm * BM + wr * 64 + fr, col0 = u.pn * HALF + wc * 32 + 8 * fq;
#pragma unroll
        for (int ai = 0; ai < 2; ++ai)
#pragma unroll
            for (int m = 0; m < 4; ++m) {
                bf16_t* rowp = O + (size_t)(row0 + ai * HALF + m * 16) * ldc + col0;
                float h[8];
#pragma unroll
                for (int n = 0; n < 2; ++n)
#pragma unroll
                    for (int e = 0; e < 4; ++e) { const float g = acc[ai][0][m][n][e], up = acc[ai][1][m][n][e]; h[4 * n + e] = g * fast_sigmoid(g) * up; }
                u32x4 w; w.x = cvt_pk_bf16(h[0], h[1]); w.y = cvt_pk_bf16(h[2], h[3]); w.z = cvt_pk_bf16(h[4], h[5]); w.w = cvt_pk_bf16(h[6], h[7]);
                *(u32x4*)rowp = w;
            }
    }
};
struct EpiStore {
    static constexpr bool PERM = true, AFTER_DRAIN = false;
    bf16_t* O; int ldc;
    __device__ __forceinline__ void operator()(const f32x4 (&acc)[2][2][4][2], const Unit& u, int wr, int wc, int fr, int fq) const {
        const int row0 = u.pm * BM + wr * 64 + fr, col0 = u.pn * BM + wc * 32 + 8 * fq;
#pragma unroll
        for (int ai = 0; ai < 2; ++ai)
#pragma unroll
            for (int m = 0; m < 4; ++m) {
                bf16_t* rowp = O + (size_t)(row0 + ai * HALF + m * 16) * ldc + col0;
#pragma unroll
                for (int bj = 0; bj < 2; ++bj) { const f32x4 v0 = acc[ai][bj][m][0], v1 = acc[ai][bj][m][1];
                    u32x4 w; w.x = cvt_pk_bf16(v0[0], v0[1]); w.y = cvt_pk_bf16(v0[2], v0[3]); w.z = cvt_pk_bf16(v1[0], v1[1]); w.w = cvt_pk_bf16(v1[2], v1[3]);
                    *(u32x4*)(rowp + bj * HALF) = w; }
            }
    }
};
struct EpiResid {
    static constexpr bool PERM = false, AFTER_DRAIN = false;
    const float* src_lat; const float* src_ctx; float* dst_lat; float* dst_ctx; const float* gate  ; float alpha, coef;
    __device__ __forceinline__ void operator()(const f32x4 (&acc)[2][2][4][2], const Unit& u, int wr, int wc, int fr, int fq) const {
        const bool ctx = u.pm >= 128; const int bi = ctx ? 8 : (u.pm >> 4);
        const float* src = ctx ? src_ctx + (size_t)(u.pm - 128) * BM * 1024 : src_lat + (size_t)u.pm * BM * 1024;
        float* dst = ctx ? dst_ctx + (size_t)(u.pm - 128) * BM * 1024 : dst_lat + (size_t)u.pm * BM * 1024;
        const float* gp = gate + (size_t)bi * 9216;
        const int col0 = u.pn * BM + wc * 32 + 4 * fq;
        f32x4 gv[2][2];
#pragma unroll
        for (int bj = 0; bj < 2; ++bj)
#pragma unroll
            for (int n = 0; n < 2; ++n) gv[bj][n] = *(const f32x4*)(gp + col0 + bj * HALF + n * 16) * coef;
#pragma unroll
        for (int ai = 0; ai < 2; ++ai)
#pragma unroll
            for (int m = 0; m < 4; ++m) { const size_t off = (size_t)(ai * HALF + wr * 64 + m * 16 + fr) * 1024 + col0;
#pragma unroll
                for (int bj = 0; bj < 2; ++bj)
#pragma unroll
                    for (int n = 0; n < 2; ++n) { const f32x4 s = *(const f32x4*)(src + off + bj * HALF + n * 16);
                        *(f32x4*)(dst + off + bj * HALF + n * 16) = s * alpha + gv[bj][n] * acc[ai][bj][m][n]; } }
    }
};
struct EpiLora {
    static constexpr bool PERM = true, AFTER_DRAIN = false;
    _Float16* O; const float* w0; const float* a0; const float* gbias;
    template <int MODE> __device__ __forceinline__ void tile(const f32x4 (&acc)[2][2][4][2], const Unit& u, int wr, int wc, int fr, int fq, const float* bias) const {
        const int row0 = u.pm * BM + wr * 64 + fr, lc0 = wc * 32 + 8 * fq;
        float bv[2][8];
#pragma unroll
        for (int bj = 0; bj < 2; ++bj)
#pragma unroll
            for (int e = 0; e < 8; ++e) bv[bj][e] = (MODE == 2) ? 0.f : bias[lc0 + bj * HALF + e];
#pragma unroll
        for (int ai = 0; ai < 2; ++ai)
#pragma unroll
            for (int m = 0; m < 4; ++m) {
                _Float16* rowp = O + (size_t)(row0 + ai * HALF + m * 16) * 1536 + u.pn * BM + lc0;
#pragma unroll
                for (int bj = 0; bj < 2; ++bj) {
                    f16x8 o;
#pragma unroll
                    for (int e = 0; e < 8; ++e) { const float x = acc[ai][bj][m][e >> 2][e & 3] + bv[bj][e]; float r;
                        if (MODE == 0) r = __expf(-__expf(log_sigmoid(x) - 0.5f));
                        else if (MODE == 1) r = fast_sigmoid(x);
                        else if (MODE == 2) r = x;
                        else r = log_sigmoid(x) * (1.0f / 16.0f);
                        o[e] = (_Float16)r; }
                    *(f16x8*)(rowp + bj * HALF) = o;
                }
            }
    }
    __device__ __forceinline__ void operator()(const f32x4 (&acc)[2][2][4][2], const Unit& u, int wr, int wc, int fr, int fq) const {
        const int pn = u.pn;
        if (pn < 2) tile<0>(acc, u, wr, wc, fr, fq, w0 + pn * 256);
        else if (pn < 4) tile<1>(acc, u, wr, wc, fr, fq, a0 + (pn - 2) * 256);
        else if (pn == 4) tile<2>(acc, u, wr, wc, fr, fq, gbias);
        else tile<3>(acc, u, wr, wc, fr, fq, gbias);
    }
};

template <class Epi, class Sched, bool ALIGN_EPI = false, bool SP2 = false>
__device__ __forceinline__ void gemm_phase(PG8_LAS unsigned char* lds, const Gemm g, const Sched& S, const Epi& E) {
    int tid_ = threadIdx.x; asm volatile("" : "+v"(tid_)); const int tid = tid_, wid = __builtin_amdgcn_readfirstlane(tid >> 6), lane = tid & 63, wr = wid >> 2, wc = wid & 3, fr = lane & 15, fq = lane >> 4;
    const int K = g.K, nt = K / BK;
    unsigned voffA[2], voffB[2];
#pragma unroll
    for (int i = 0; i < 2; ++i) { int R, C; stage_rc(tid * 16 + i * 8192, R, C); const int Rb = Epi::PERM ? ((R & ~31) + perm32(R & 31)) : R;
        voffA[i] = (unsigned)(R * K + C) * 2u; voffB[i] = (unsigned)(Rb * K + C) * 2u; }
    const size_t kstep = (size_t)(BK * 2);
    const size_t hstep = (size_t)HALF * K * 2;
    const size_t tstep = 2 * hstep;
    const unsigned ldsw = (unsigned)wid * 1024u;
    const int aoff = lds_byte(wr * 64 + fr, fq * 8), boff = lds_byte(wc * 32 + fr, fq * 8);
#define PG8_SA(b, h) (((b) * 2 + (h)) * HTB)
#define PG8_SB(b, h) ((4 + (b) * 2 + (h)) * HTB)
#define PG8_STAGE(bufoff, gbase, voff) do { _Pragma("unroll") for (int _i = 0; _i < 2; ++_i) \
        __builtin_amdgcn_global_load_lds((const unsigned*)((const char*)(gbase) + (voff)[_i]), (PG8_LAS unsigned*)(lds + (bufoff) + ldsw + _i * 8192), 16, 0, 0); } while (0)
#define PG8_LDA(dst, b, h) do { _Pragma("unroll") for (int m = 0; m < 4; ++m) _Pragma("unroll") for (int k = 0; k < 2; ++k) dst[m][k] = *(const PG8_LAS bf16x8*)(lds + PG8_SA(b, h) + aoff + m * 2048 + k * 1024); } while (0)
#define PG8_LDB(dst, b, h) do { _Pragma("unroll") for (int n = 0; n < 2; ++n) _Pragma("unroll") for (int k = 0; k < 2; ++k) dst[n][k] = *(const PG8_LAS bf16x8*)(lds + PG8_SB(b, h) + boff + n * 2048 + k * 1024); } while (0)
#define PG8_MMA(ai, bj, At, Bt) do { __builtin_amdgcn_s_setprio(1); _Pragma("unroll") for (int m = 0; m < 4; ++m) _Pragma("unroll") for (int n = 0; n < 2; ++n) _Pragma("unroll") for (int k = 0; k < 2; ++k) \
        acc[ai][bj][m][n] = __builtin_amdgcn_mfma_f32_16x16x32_bf16(Bt[n][k], At[m][k], acc[ai][bj][m][n], 0, 0, 0); __builtin_amdgcn_s_setprio(0); } while (0)
#define PG8_WAIT_V(n) asm volatile("s_waitcnt vmcnt(" #n ")" ::: "memory")
#define PG8_WAIT_L(n) asm volatile("s_waitcnt lgkmcnt(" #n ")" ::: "memory")
#define PG8_BAR __builtin_amdgcn_s_barrier()
#define PG8_SCHED __builtin_amdgcn_sched_barrier(0)
    Unit cur, nxt; int ui = 0;
    if (!S.next(0, cur)) return;
    f32x4 acc[2][2][4][2];
#pragma unroll
    for (int a = 0; a < 2; ++a)
#pragma unroll
        for (int b = 0; b < 2; ++b)
#pragma unroll
            for (int m = 0; m < 4; ++m)
#pragma unroll
                for (int n = 0; n < 2; ++n) acc[a][b][m][n] = (f32x4){0.f, 0.f, 0.f, 0.f};
    bf16x8 At[4][2], B0[2][2], B1[2][2];
    const char* cA = (const char*)g.A + (size_t)cur.pm * tstep; const char* cB = (const char*)g.Bt + (size_t)cur.pn * tstep;
    S.a_ready(cur);
    if constexpr (SP2) {
        PG8_STAGE(PG8_SB(0, 0), cB, voffB); PG8_STAGE(PG8_SB(0, 1), cB + hstep, voffB); PG8_STAGE(PG8_SA(0, 0), cA, voffA); PG8_STAGE(PG8_SA(0, 1), cA + hstep, voffA);
        if (wr == 1) PG8_BAR;
        PG8_WAIT_V(2); PG8_BAR;
        PG8_STAGE(PG8_SB(1, 0), cB + kstep, voffB); PG8_STAGE(PG8_SA(1, 0), cA + kstep, voffA); PG8_STAGE(PG8_SB(1, 1), cB + hstep + kstep, voffB);
        PG8_WAIT_V(6); PG8_BAR;
    } else {
        PG8_STAGE(PG8_SB(0, 0), cB, voffB); PG8_STAGE(PG8_SA(0, 0), cA, voffA); PG8_STAGE(PG8_SB(0, 1), cB + hstep, voffB); PG8_STAGE(PG8_SA(0, 1), cA + hstep, voffA);
        if (wr == 1) PG8_BAR;
        PG8_WAIT_V(4); PG8_BAR;
        PG8_STAGE(PG8_SB(1, 0), cB + kstep, voffB); PG8_STAGE(PG8_SA(1, 0), cA + kstep, voffA); PG8_STAGE(PG8_SB(1, 1), cB + hstep + kstep, voffB);
        PG8_WAIT_V(6); PG8_BAR;
    }
    for (;;) {
        const bool has_next = S.next(ui + 1, nxt);
        const char* nA = has_next ? (const char*)g.A + (size_t)nxt.pm * tstep : cA; const char* nB = has_next ? (const char*)g.Bt + (size_t)nxt.pn * tstep : cB;
        for (int t = 0; t < nt; t += 2) {
            const bool last = (t == nt - 2);
            const char* a1 = cA + (size_t)(t + 1) * kstep;
            const char* a2 = last ? nA : cA + (size_t)(t + 2) * kstep; const char* b2 = last ? nB : cB + (size_t)(t + 2) * kstep;
            const char* a3 = a2 + kstep; const char* b3 = b2 + kstep;
            if (last && has_next) S.a_ready(nxt);
            if constexpr (SP2) {
            PG8_LDB(B0, 0, 0); PG8_LDB(B1, 0, 1); PG8_SCHED; PG8_LDA(At, 0, 0); PG8_STAGE(PG8_SA(1, 1), a1 + hstep, voffA);
            PG8_WAIT_V(8); PG8_WAIT_L(0); PG8_BAR; PG8_MMA(0, 0, At, B0); PG8_MMA(0, 1, At, B1); PG8_BAR; PG8_SCHED;
            PG8_LDA(At, 0, 1); PG8_STAGE(PG8_SB(0, 0), b2, voffB); PG8_STAGE(PG8_SB(0, 1), b2 + hstep, voffB); PG8_STAGE(PG8_SA(0, 0), a2, voffA);
            PG8_WAIT_V(8); PG8_WAIT_L(0); PG8_BAR; PG8_MMA(1, 0, At, B0); PG8_MMA(1, 1, At, B1); PG8_BAR; PG8_SCHED;
            PG8_LDB(B0, 1, 0); PG8_LDB(B1, 1, 1); PG8_SCHED; PG8_LDA(At, 1, 0); PG8_STAGE(PG8_SA(0, 1), a2 + hstep, voffA);
            PG8_WAIT_V(8); PG8_WAIT_L(0); PG8_BAR; PG8_MMA(0, 0, At, B0); PG8_MMA(0, 1, At, B1); PG8_BAR; PG8_SCHED;
            PG8_LDA(At, 1, 1); PG8_STAGE(PG8_SB(1, 0), b3, voffB); PG8_STAGE(PG8_SB(1, 1), b3 + hstep, voffB); PG8_STAGE(PG8_SA(1, 0), a3, voffA);
            PG8_WAIT_V(8); PG8_WAIT_L(0); PG8_BAR; PG8_MMA(1, 0, At, B0); PG8_MMA(1, 1, At, B1); PG8_BAR; PG8_SCHED;
            } else {
            PG8_LDB(B0, 0, 0); PG8_SCHED; PG8_LDA(At, 0, 0); PG8_STAGE(PG8_SA(1, 1), a1 + hstep, voffA);
            PG8_WAIT_L(8); PG8_BAR; PG8_WAIT_L(0); PG8_MMA(0, 0, At, B0); PG8_BAR; PG8_SCHED;
            PG8_LDB(B1, 0, 1); PG8_STAGE(PG8_SB(0, 0), b2, voffB);
            PG8_BAR; PG8_WAIT_L(0); PG8_MMA(0, 1, At, B1); PG8_BAR;
            PG8_LDA(At, 0, 1); PG8_STAGE(PG8_SA(0, 0), a2, voffA);
            PG8_BAR; PG8_WAIT_L(0); PG8_MMA(1, 0, At, B0); PG8_BAR; PG8_SCHED;
            PG8_STAGE(PG8_SB(0, 1), b2 + hstep, voffB);
            PG8_WAIT_V(6); PG8_BAR; PG8_MMA(1, 1, At, B1); PG8_BAR;
            PG8_LDB(B0, 1, 0); PG8_SCHED; PG8_LDA(At, 1, 0); PG8_STAGE(PG8_SA(0, 1), a2 + hstep, voffA);
            PG8_WAIT_L(8); PG8_BAR; PG8_WAIT_L(0); PG8_MMA(0, 0, At, B0); PG8_BAR; PG8_SCHED;
            PG8_LDB(B1, 1, 1); PG8_STAGE(PG8_SB(1, 0), b3, voffB);
            PG8_BAR; PG8_WAIT_L(0); PG8_MMA(0, 1, At, B1); PG8_BAR;
            PG8_LDA(At, 1, 1); PG8_STAGE(PG8_SA(1, 0), a3, voffA);
            PG8_BAR; PG8_WAIT_L(0); PG8_MMA(1, 0, At, B0); PG8_BAR; PG8_SCHED;
            PG8_STAGE(PG8_SB(1, 1), b3 + hstep, voffB);
            PG8_WAIT_V(6); PG8_BAR; PG8_MMA(1, 1, At, B1); PG8_BAR;
            }
        }
        if constexpr (ALIGN_EPI) { if (wr == 0) PG8_BAR; }
        if constexpr (!Epi::AFTER_DRAIN) { E(acc, cur, wr, wc, fr, fq); S.done(cur); }
        if (!has_next) break;
#pragma unroll
        for (int a = 0; a < 2; ++a)
#pragma unroll
            for (int b = 0; b < 2; ++b)
#pragma unroll
                for (int m = 0; m < 4; ++m)
#pragma unroll
                    for (int n = 0; n < 2; ++n) acc[a][b][m][n] = (f32x4){0.f, 0.f, 0.f, 0.f};
        cur = nxt; cA = nA; cB = nB; ++ui;
        if constexpr (ALIGN_EPI) { if (wr == 1) PG8_BAR; }
    }
    PG8_WAIT_V(0);
    if constexpr (!ALIGN_EPI) { if (wr == 0) PG8_BAR; }
    PG8_BAR;
    if constexpr (Epi::AFTER_DRAIN) { E.fused(acc, cur, wr, wc, fr, fq, lds, wid, lane); S.done(cur); }
#undef PG8_SA
#undef PG8_SB
#undef PG8_STAGE
#undef PG8_LDA
#undef PG8_LDB
#undef PG8_MMA
#undef PG8_WAIT_V
#undef PG8_WAIT_L
#undef PG8_BAR
#undef PG8_SCHED
}
}

#define LAS __attribute__((address_space(3)))
typedef unsigned short bf16;
typedef float f32x4 __attribute__((ext_vector_type(4)));
typedef float f32x2 __attribute__((ext_vector_type(2)));
typedef short bf16x8 __attribute__((ext_vector_type(8)));
typedef short bf16x4 __attribute__((ext_vector_type(4)));
typedef unsigned v4u __attribute__((ext_vector_type(4)));
typedef unsigned v2u __attribute__((ext_vector_type(2)));
typedef _Float16 h2 __attribute__((ext_vector_type(2)));
typedef _Float16 h4 __attribute__((ext_vector_type(4)));
typedef _Float16 h8 __attribute__((ext_vector_type(8)));

constexpr int DM = 1024, NBATCH = 8, SEQ = 4096, CTXL = 256, DEPTH = 4, DFF = 2816, DIN = 2720, DINP = 2816;
constexpr int ML = NBATCH * SEQ, MC = NBATCH * CTXL, MA = ML + MC;
constexpr int LORA_K = 512, LORA_N = 1536;
constexpr float ALPHA = 1.681792830507429f;
constexpr float LN_EPS = 1e-6f;
constexpr int PC_GQ = 0, PC_GK = 128, PC_GV = 256, PC_GG = 512, PC_ZF = 768, PC_SQ = 800, PC_SK = 1312, PC_SV = 1440, PC_RW = 1568;
constexpr int LC_DEC = 0, LC_A = 512, LC_G = 1024, LC_LG = 1280;
constexpr int RF_R = 0, RF_K = 256, RF_V = 512, RF_KK = 768;

constexpr size_t MiB = 1u << 20;
constexpr size_t WS_MOD = 1 * MiB;
constexpr size_t WS_WGU1 = 3 * MiB;
constexpr size_t WS_WD1 = WS_WGU1 + 11 * MiB;
constexpr size_t WS_WGU2 = WS_WD1 + 6 * MiB;
constexpr size_t WS_WD2 = WS_WGU2 + 11 * MiB;
constexpr size_t WS_WIN = WS_WD2 + 6 * MiB;
constexpr size_t WS_WOUT = WS_WIN + 6 * MiB;
constexpr size_t WS_WLORA = WS_WOUT + 2 * MiB;
constexpr size_t WS_XC = WS_WLORA + 2 * MiB;
constexpr size_t WS_U = WS_XC + 8 * MiB;
constexpr size_t WS_HID = WS_U + 68 * MiB;
constexpr size_t WS_LO = WS_HID + 187 * MiB;
constexpr size_t WS_RF = WS_LO + 102 * MiB;
constexpr size_t WS_YO = WS_RF + 68 * MiB;
constexpr size_t WS_KV = WS_YO + 68 * MiB;
constexpr size_t WS_ST = WS_KV + 17 * MiB;
constexpr size_t WS_DEC = WS_ST + 17 * MiB;
constexpr size_t WS_END = WS_DEC + 1 * MiB;
constexpr int LDS_BYTES = 135168;

struct Args { const float* in[31]; float* out; unsigned char* ws; };
enum { I_X = 0, I_C, I_CTX, I_CCTX, I_WADA, I_BADA, I_F1G, I_F1U, I_F1D, I_F2G, I_F2U, I_F2D, I_LNG, I_LNB, I_WIN, I_WOUT, I_GUP, I_GBIAS, I_GNORM, I_SINK,
       I_MU, I_W0, I_WUP, I_A0, I_AUP, I_GUPR, I_KK, I_KA, I_RK, I_GNG, I_GNB };

__device__ __forceinline__ unsigned f2bf(float f) { unsigned u = __builtin_bit_cast(unsigned, f); return (u + 0x7fffu + ((u >> 16) & 1u)) >> 16; }
__device__ __forceinline__ unsigned pk2(float lo, float hi) { return f2bf(lo) | (f2bf(hi) << 16); }
__device__ __forceinline__ float bf2f(unsigned short u) { return __builtin_bit_cast(float, (unsigned)u << 16); }
__device__ __forceinline__ float bflo(unsigned u) { return __builtin_bit_cast(float, u << 16); }
__device__ __forceinline__ float bfhi(unsigned u) { return __builtin_bit_cast(float, u & 0xffff0000u); }
__device__ __forceinline__ float sigmoidf_(float x) { return 1.0f / (1.0f + __expf(-x)); }
__device__ __forceinline__ int otid() { int t = threadIdx.x; asm volatile("" : "+v"(t)); return t; }
__device__ __forceinline__ int obid() { int t = blockIdx.x; asm volatile("" : "+s"(t)); return t; }
__device__ __forceinline__ int ogdim() { int t = gridDim.x; asm volatile("" : "+s"(t)); return t; }
#define LDS_WAIT() asm volatile("s_waitcnt lgkmcnt(0)" ::: "memory")
template <int CTRL> __device__ __forceinline__ float dpp_f(float x) { return __builtin_bit_cast(float, __builtin_amdgcn_update_dpp(0, __builtin_bit_cast(int, x), CTRL, 0xF, 0xF, false)); }
__device__ __forceinline__ float allred16(float x) {
    x += dpp_f<0x128>(x); x += dpp_f<0x124>(x); x += dpp_f<0x122>(x); x += dpp_f<0x121>(x); return x;
}
__device__ __forceinline__ float wave_sum(float v) {
#pragma unroll
    for (int o = 1; o < 64; o <<= 1) v += __shfl_xor(v, o);
    return v;
}

__device__ __forceinline__ void phase_adaln(const Args& a, float* MOD, LAS unsigned char* lds) {
    LAS float* s = (LAS float*)lds;
    LAS float* red = s + 9 * 1024;
    const int tid = otid();
    for (int i = tid; i < 9 * 1024; i += 512) { const int bi = i >> 10, k = i & 1023; const float c = bi < 8 ? a.in[I_C][bi * 1024 + k] : a.in[I_CCTX][k]; s[i] = c * sigmoidf_(c); }
    __syncthreads();
    for (int unit = obid(); unit < 288; unit += ogdim()) {
        const int l = unit / 72, cb = unit % 72, col = cb * 128 + (tid & 127), kq = tid >> 7;
        const float* w = a.in[I_WADA] + (size_t)l * 1024 * 9216 + col;
        float acc[9];
#pragma unroll
        for (int bi = 0; bi < 9; ++bi) acc[bi] = 0.f;
#pragma unroll 8
        for (int k = kq * 256; k < kq * 256 + 256; ++k) { const float wv = w[(size_t)k * 9216];
#pragma unroll
            for (int bi = 0; bi < 9; ++bi) acc[bi] += s[bi * 1024 + k] * wv; }
#pragma unroll
        for (int bi = 0; bi < 9; ++bi) red[tid * 9 + bi] = acc[bi];
        __syncthreads();
        if (kq == 0) { const float bb = a.in[I_BADA][l * 9216 + col];
#pragma unroll
            for (int bi = 0; bi < 9; ++bi) { const float v = red[tid * 9 + bi] + red[(tid + 128) * 9 + bi] + red[(tid + 256) * 9 + bi] + red[(tid + 384) * 9 + bi] + bb;
                MOD[(size_t)(l * 9 + bi) * 9216 + col] = v; } }
        __syncthreads();
    }
}

__device__ __forceinline__ void transpose_item(const float* W, int K, int N, bf16* WT, int kb, int nb, int drow0, LAS float* scr, int lane) {
    const int k0 = 64 * kb, n0 = 32 * nb;
#pragma unroll 8
    for (int i = 0; i < 32; ++i) { const int kk = 2 * i + (lane >> 5); scr[kk * 33 + (lane & 31)] = W[(size_t)(k0 + kk) * N + n0 + (lane & 31)]; }
    LDS_WAIT(); asm volatile("" ::: "memory");
    const int c = lane & 7;
#pragma unroll
    for (int j = 0; j < 4; ++j) { const int n = (lane >> 3) + 8 * j; const LAS float* sp = scr + (8 * c) * 33 + n;
        v4u o; o.x = pk2(sp[0 * 33], sp[1 * 33]); o.y = pk2(sp[2 * 33], sp[3 * 33]); o.z = pk2(sp[4 * 33], sp[5 * 33]); o.w = pk2(sp[6 * 33], sp[7 * 33]);
        *(v4u*)(WT + (size_t)(drow0 + n) * K + k0 + 8 * c) = o; }
    LDS_WAIT(); asm volatile("" ::: "memory");
}
__device__ __forceinline__ void phase_convert(const Args& a, int l, unsigned char* ws, LAS unsigned char* lds) {
    const int tid = otid(), lane = tid & 63, wave = __builtin_amdgcn_readfirstlane(tid >> 6);
    LAS float* scr = (LAS float*)(lds + wave * 8704);
    const int gw = obid() * 8 + wave, NGW = ogdim() * 8;
    constexpr int I_GU = 16 * 88, I_D = 44 * 32, I_IN = 16 * 85, I_OUT = 16 * 32;
    constexpr int NIT = 4 * I_GU + 2 * I_D + I_IN + I_OUT;
    for (int it = gw; it < NIT; it += NGW) {
        int r = it;
        if (r < 4 * I_GU) { const int which = r / I_GU; r -= which * I_GU; const int kb = r / 88, nb = r % 88;
            const float* W = a.in[which == 0 ? I_F1G : which == 1 ? I_F1U : which == 2 ? I_F2G : I_F2U] + (size_t)l * 1024 * DFF;
            bf16* WT = (bf16*)(ws + (which < 2 ? WS_WGU1 : WS_WGU2));
            const int n0 = 32 * nb, drow0 = (n0 >> 7) * 256 + (which & 1) * 128 + (n0 & 127);
            transpose_item(W, 1024, DFF, WT, kb, nb, drow0, scr, lane); continue; }
        r -= 4 * I_GU;
        if (r < 2 * I_D) { const int which = r / I_D; r -= which * I_D; const int kb = r / 32, nb = r % 32;
            const float* W = a.in[which == 0 ? I_F1D : I_F2D] + (size_t)l * DFF * 1024;
            transpose_item(W, DFF, 1024, (bf16*)(ws + (which == 0 ? WS_WD1 : WS_WD2)), kb, nb, 32 * nb, scr, lane); continue; }
        r -= 2 * I_D;
        if (r < I_IN) { const int kb = r / 85, nb = r % 85;
            transpose_item(a.in[I_WIN] + (size_t)l * 1024 * DIN, 1024, DIN, (bf16*)(ws + WS_WIN), kb, nb, 32 * nb, scr, lane); continue; }
        r -= I_IN;
        { const int kb = r / 32, nb = r % 32; transpose_item(a.in[I_WOUT] + (size_t)l * 1024 * 1024, 1024, 1024, (bf16*)(ws + WS_WOUT), kb, nb, 32 * nb, scr, lane); }
    }
    const int gt = obid() * 512 + tid, NGT = ogdim() * 512;
    for (int i = gt; i < 96 * 1024 / 8; i += NGT) *(v4u*)((bf16*)(ws + WS_WIN) + (size_t)DIN * 1024 + (size_t)i * 8) = (v4u){0u, 0u, 0u, 0u};
    const float* wup = a.in[I_WUP] + (size_t)l * 2 * 64 * 256; const float* aup = a.in[I_AUP] + (size_t)l * 2 * 64 * 256;
    const float* gup = a.in[I_GUPR] + (size_t)l * 128 * 256; const float* ggu = a.in[I_GUP] + (size_t)l * 2 * 16 * 128;
    for (int ci = gt; ci < LORA_N * LORA_K / 8; ci += NGT) {
        const int n = ci >> 6, k8 = (ci & 63) * 8; float v[8];
#pragma unroll
        for (int e = 0; e < 8; ++e) v[e] = 0.f;
        const float* src = nullptr; int stride = 0;
        if (n < 256)       { if (k8 < 64)                 { src = wup + (size_t)k8 * 256 + n; stride = 256; } }
        else if (n < 512)  { if (k8 >= 64 && k8 < 128)    { src = wup + 64 * 256 + (size_t)(k8 - 64) * 256 + (n - 256); stride = 256; } }
        else if (n < 768)  { if (k8 >= 128 && k8 < 192)   { src = aup + (size_t)(k8 - 128) * 256 + (n - 512); stride = 256; } }
        else if (n < 1024) { if (k8 >= 192 && k8 < 256)   { src = aup + 64 * 256 + (size_t)(k8 - 192) * 256 + (n - 768); stride = 256; } }
        else if (n < 1280) { if (k8 >= 256 && k8 < 384)   { src = gup + (size_t)(k8 - 256) * 256 + (n - 1024); stride = 256; } }
        else if (n < 1408) { if (k8 >= 384 && k8 < 400)   { src = ggu + (size_t)(k8 - 384) * 128 + (n - 1280); stride = 128; } }
        else               { if (k8 >= 400 && k8 < 416)   { src = ggu + 16 * 128 + (size_t)(k8 - 400) * 128 + (n - 1408); stride = 128; } }
        if (src) {
#pragma unroll
            for (int e = 0; e < 8; ++e) v[e] = src[(size_t)e * stride]; }
        v4u o; o.x = pk2(v[0], v[1]); o.y = pk2(v[2], v[3]); o.z = pk2(v[4], v[5]); o.w = pk2(v[6], v[7]);
        *(v4u*)((bf16*)(ws + WS_WLORA) + (size_t)n * LORA_K + k8) = o;
    }
}

__device__ __forceinline__ float* xrow_ptr(float* xlat, float* xctx, int row) { return row < ML ? xlat + (size_t)row * 1024 : xctx + (size_t)(row - ML) * 1024; }
__device__ __forceinline__ int row_bi(int row) { return row < ML ? (row >> 12) : 8; }

__device__ __forceinline__ void phase_mod0(const Args& a, const float* MOD, bf16* U) {
    const int lane = otid() & 63, gw = obid() * 8 + (otid() >> 6), NGW = ogdim() * 8;
    for (int row = gw; row < MA; row += NGW) {
        const float* xr = row < ML ? a.in[I_X] + (size_t)row * 1024 : a.in[I_CTX] + (size_t)(row - ML) * 1024;
        const float* mp = MOD + (size_t)row_bi(row) * 9216;
#pragma unroll
        for (int j = 0; j < 4; ++j) { const int c = 4 * lane + 256 * j; const f32x4 v = *(const f32x4*)(xr + c), sh = *(const f32x4*)(mp + c), sc = *(const f32x4*)(mp + 1024 + c);
            const f32x4 o = v * (sc + 1.0f) + sh; v2u w; w.x = pk2(o.x, o.y); w.y = pk2(o.z, o.w); *(v2u*)(U + (size_t)row * 1024 + c) = w; }
    }
}
__device__ __forceinline__ void phase_ln(float* xlat, float* xctx, const float* lng, const float* lnb, const float* modn, bf16* U, int nrows, bool write_u) {
    const int lane = otid() & 63, gw = obid() * 8 + (otid() >> 6), NGW = ogdim() * 8;
    for (int row = gw; row < nrows; row += NGW) {
        float* xr = xrow_ptr(xlat, xctx, row);
        f32x4 v[4]; float s = 0.f;
#pragma unroll
        for (int j = 0; j < 4; ++j) { v[j] = *(const f32x4*)(xr + 4 * lane + 256 * j); s += (v[j].x + v[j].y) + (v[j].z + v[j].w); }
        const float mean = wave_sum(s) * (1.0f / 1024.0f); float s2 = 0.f;
#pragma unroll
        for (int j = 0; j < 4; ++j) { v[j] = v[j] - mean; s2 += (v[j].x * v[j].x + v[j].y * v[j].y) + (v[j].z * v[j].z + v[j].w * v[j].w); }
        const float rstd = 1.0f / sqrtf(wave_sum(s2) * (1.0f / 1024.0f) + LN_EPS);
        const float* mp = modn + (size_t)row_bi(row) * 9216;
#pragma unroll
        for (int j = 0; j < 4; ++j) { const int c = 4 * lane + 256 * j; const f32x4 h = v[j] * rstd * *(const f32x4*)(lng + c) + *(const f32x4*)(lnb + c);
            *(f32x4*)(xr + c) = h;
            if (write_u) { const f32x4 sh = *(const f32x4*)(mp + c), sc = *(const f32x4*)(mp + 1024 + c); const f32x4 o = h * (sc + 1.0f) + sh;
                v2u w; w.x = pk2(o.x, o.y); w.y = pk2(o.z, o.w); *(v2u*)(U + (size_t)row * 1024 + c) = w; } }
    }
}

__device__ __forceinline__ void phase_features(const Args& a, int l, bf16* P, _Float16* RF, bf16* AP, LAS unsigned char* lds) {
    LAS f32x2* tab = (LAS f32x2*)lds;
    const int tid = otid(), lane = tid & 63;
    for (int i = tid; i < 1024; i += 512) { const int pos = i >> 4, fi = i & 15; const float inv = exp2f(-(float)fi * (13.287712379549449f / 16.0f)); const float ang = (float)pos * inv;
        tab[i] = (f32x2){cosf(ang), sinf(ang)}; }
    __syncthreads();
    const float* mu = a.in[I_MU] + l * 1152; const float* kkw = a.in[I_KK] + l * 256;
    const int gw = obid() * 8 + (tid >> 6), NGW = ogdim() * 8;
    for (int row = gw; row < MA; row += NGW) {
        const bool lat = row < ML; const int t = lat ? (row & 4095) : ((row - ML) & 255); const int len = lat ? SEQ : CTXL;
        bf16* pr = P + (size_t)row * DINP;
        const float hp = t > 0 ? 0.5f : 0.f, hn = t < len - 1 ? 0.5f : 0.f;
        const bf16* rw = pr + PC_RW; const bf16* rwp = t > 0 ? rw - DINP : rw; const bf16* rwn = t < len - 1 ? rw + DINP : rw;
        _Float16* rf = RF + (size_t)row * 1024; bf16* ap = AP + (size_t)row * LORA_K;
#pragma unroll
        for (int j = 0; j < 9; ++j) {
            const int col = 2 * (lane + 64 * j);
            const unsigned uc = *(const unsigned*)(rw + col), up = *(const unsigned*)(rwp + col), un = *(const unsigned*)(rwn + col);
            const f32x2 m2 = *(const f32x2*)(mu + col);
            const float c0 = bflo(uc), c1 = bfhi(uc);
            const float f0 = c0 + m2.x * (hp * bflo(up) + hn * bflo(un) - c0), f1 = c1 + m2.y * (hp * bfhi(up) + hn * bfhi(un) - c1);
            if (j < 2) { *(h2*)(rf + RF_R + col) = (h2){(_Float16)f0, (_Float16)f1}; }
            else if (j < 4) { const int kc = col - 256; *(h2*)(rf + RF_K + kc) = (h2){(_Float16)f0, (_Float16)f1};
                const f32x2 kw = *(const f32x2*)(kkw + kc); const float q0 = f0 * kw.x, q1 = f1 * kw.y; float ss = q0 * q0 + q1 * q1;
#pragma unroll
                for (int o = 1; o < 32; o <<= 1) ss += __shfl_xor(ss, o);
                const float inv = 1.0f / fmaxf(sqrtf(ss), 1e-12f);
                *(h2*)(rf + RF_KK + kc) = (h2){(_Float16)(q0 * inv), (_Float16)(q1 * inv)}; }
            else if (j < 6) { *(h2*)(rf + RF_V + (col - 512)) = (h2){(_Float16)f0, (_Float16)f1}; }
            else if (j == 6) { *(unsigned*)(ap + (col - 768)) = pk2(tanhf(f0), tanhf(f1)); }
            else if (j == 7) { *(unsigned*)(ap + 128 + (col - 896)) = pk2(f0, f1); }
            else { *(unsigned*)(ap + 256 + (col - 1024)) = pk2(sigmoidf_(f0), sigmoidf_(f1)); }
        }
        { unsigned z = 0u; if (lane < 16) z = *(const unsigned*)(pr + PC_ZF + 2 * lane); *(unsigned*)(ap + 384 + 2 * lane) = z; }
#pragma unroll
        for (int j = 0; j < 5; ++j) {
            const int head = 2 * j + (lane >> 5), pi = lane & 31, fi = pi & 15;
            const int d1 = pi < 16 ? pi : 16 + pi, pos = pi < 16 ? (t >> 6) : (t & 63);
            bf16* hb = pr + (head < 8 ? PC_SQ + head * 64 : PC_SK + (head - 8) * 64);
            const float x1 = bf2f(hb[d1]), x2 = bf2f(hb[d1 + 16]);
            float o1 = x1, o2 = x2;
            if (lat) { const f32x2 cs = tab[pos * 16 + fi]; o1 = x1 * cs.x - x2 * cs.y; o2 = x1 * cs.y + x2 * cs.x; }
            if (head < 8) { o1 *= 0.125f; o2 *= 0.125f; }
            if (lat || head < 8) { hb[d1] = (bf16)f2bf(o1); hb[d1 + 16] = (bf16)f2bf(o2); }
        }
    }
}

__device__ __forceinline__ void phase_rwkv(const Args& a, int l, const _Float16* RF, const _Float16* LO, _Float16* YO, LAS unsigned char* lds) {
    constexpr int T = 32, SF = 336, NCH = (CTXL + SEQ) / T;
    LAS float* buf = (LAS float*)lds; LAS float* ybuf = buf + 2 * T * SF;
    const int tid = otid(), wave = __builtin_amdgcn_readfirstlane(tid >> 6), lane = tid & 63;
    for (int unit = obid(); unit < 256; unit += ogdim()) {
        const int chain = unit >> 2, rq = unit & 3, b = chain >> 3, h = (chain >> 1) & 3, dir = chain & 1;
        _Float16* Y = YO + (size_t)dir * MA * 256;
        const int ltid = tid - 256, lstep = ltid >> 3, lkq = ltid & 7, cols = h * 64 + 8 * lkq;
        float ka[8];
        if (wave >= 4) {
#pragma unroll
            for (int e = 0; e < 8; ++e) ka[e] = a.in[I_KA][l * 256 + cols + e]; }
        auto step_row = [&](int s) -> int { if (s < CTXL) return ML + b * CTXL + (dir ? CTXL - 1 - s : s); const int tq = s - CTXL; return b * SEQ + (dir ? SEQ - 1 - tq : tq); };
        h8 cr8, ck8, cv8, cq8, cw8, ca8, nr8, nk8, nv8, nq8, nw8, na8;
#define RW_LOAD(c, R8, K8, V8, Q8, W8, A8) do { const int row_ = step_row((c) * T + lstep); \
            const _Float16* rf_ = RF + (size_t)row_ * 1024 + cols; const _Float16* lo_ = LO + (size_t)row_ * 1536 + dir * 256 + cols; \
            R8 = *(const h8*)(rf_ + RF_R); K8 = *(const h8*)(rf_ + RF_K); V8 = *(const h8*)(rf_ + RF_V); Q8 = *(const h8*)(rf_ + RF_KK); \
            W8 = *(const h8*)(lo_ + LC_DEC); A8 = *(const h8*)(lo_ + LC_A); } while (0)
#define RW_WRITE(c, R8, K8, V8, Q8, W8, A8) do { LAS float* d_ = buf + ((c) & 1) * T * SF + lstep * SF + 8 * lkq; \
            _Pragma("unroll") for (int e = 0; e < 8; ++e) { const float kk_ = (float)Q8[e], av_ = (float)A8[e], kv_ = (float)K8[e]; \
                d_[e] = kk_; d_[64 + e] = (float)W8[e]; d_[128 + e] = kk_ * av_; d_[192 + e] = kv_ * (1.0f + (av_ - 1.0f) * ka[e]); d_[256 + e] = (float)R8[e]; } \
            if ((lkq >> 1) == rq) { LAS float* dv_ = buf + ((c) & 1) * T * SF + lstep * SF + 320 + (lkq & 1) * 8; \
                _Pragma("unroll") for (int e = 0; e < 8; ++e) dv_[e] = (float)V8[e]; } } while (0)
        auto flush_y = [&](int c) {
            const int row = step_row(c * T + lstep);
            const LAS float* yb = ybuf + (c & 1) * T * 16 + lstep * 16 + 2 * lkq;
            *(h2*)(Y + (size_t)row * 256 + h * 64 + rq * 16 + 2 * lkq) = (h2){(_Float16)yb[0], (_Float16)yb[1]};
        };
        f32x4 S = (f32x4){0.f, 0.f, 0.f, 0.f};
        const int kg = lane & 15, ri = wave * 4 + (lane >> 4);
        if (wave >= 4) { RW_LOAD(0, cr8, ck8, cv8, cq8, cw8, ca8); RW_WRITE(0, cr8, ck8, cv8, cq8, cw8, ca8); RW_LOAD(1, cr8, ck8, cv8, cq8, cw8, ca8); }
        __syncthreads();
        for (int c = 0; c < NCH; ++c) {
            if (wave >= 4) {
                if (c + 2 < NCH) RW_LOAD(c + 2, nr8, nk8, nv8, nq8, nw8, na8);
                if (c + 1 < NCH) RW_WRITE(c + 1, cr8, ck8, cv8, cq8, cw8, ca8);
                if (c > 0) flush_y(c - 1);
                cr8 = nr8; ck8 = nk8; cv8 = nv8; cq8 = nq8; cw8 = nw8; ca8 = na8;
            } else {
                const LAS float* bc = buf + (c & 1) * T * SF + 4 * kg; LAS float* yb = ybuf + (c & 1) * T * 16 + ri;
#pragma unroll 8
                for (int s = 0; s < T; ++s) {
                    const LAS float* p = bc + s * SF;
                    const f32x4 kk4 = *(const LAS f32x4*)p, w4 = *(const LAS f32x4*)(p + 64), b4 = *(const LAS f32x4*)(p + 128), kd4 = *(const LAS f32x4*)(p + 192), r4 = *(const LAS f32x4*)(p + 256);
                    const float vv = bc[s * SF + 320 - 4 * kg + ri];
                    float pd = (S.x * kk4.x + S.y * kk4.y) + (S.z * kk4.z + S.w * kk4.w);
                    const float sa = allred16(pd);
                    S = S * w4 + (kd4 * vv - b4 * sa);
                    float qd = (S.x * r4.x + S.y * r4.y) + (S.z * r4.z + S.w * r4.w);
                    const float y = allred16(qd);
                    if (kg == 0) yb[s * 16] = y;
                }
            }
            asm volatile("s_waitcnt lgkmcnt(0)" ::: "memory"); __builtin_amdgcn_s_barrier(); asm volatile("" ::: "memory");
        }
        if (wave >= 4) flush_y(NCH - 1);
        __syncthreads();
    }
#undef RW_LOAD
#undef RW_WRITE
}

template <int CTRL> __device__ __forceinline__ float dpp0_f(float x) { return __builtin_bit_cast(float, __builtin_amdgcn_update_dpp(0, __builtin_bit_cast(int, x), CTRL, 0xF, 0xF, true)); }
__device__ __forceinline__ void phase_gla_a(int l, bf16* P, const _Float16* LO, _Float16* YO, _Float16* KV, float* DEC, LAS unsigned char* lds) {
    LAS bf16* Vt = (LAS bf16*)lds;
    LAS bf16* KhT = Vt + 4 * 64 * 72;
    const int tid = otid(), wave = __builtin_amdgcn_readfirstlane(tid >> 6), lane = tid & 63, r = lane & 15, kq = lane >> 4, h = wave >> 1, dir = wave & 1;
    LAS bf16* Vh = Vt + h * 64 * 72; LAS bf16* Kw = KhT + wave * 32 * 72;
    for (int unit = obid(); unit < 544; unit += ogdim()) {
        const int b = unit / 68, cc = unit % 68; const int row0 = cc < 4 ? ML + b * CTXL + cc * 64 : b * SEQ + (cc - 4) * 64;
        const int u = ((b * 4 + h) * 2 + dir) * 68 + cc;
        __syncthreads();
        {   const int j = tid >> 3, c8 = tid & 7; const bf16* src = P + (size_t)(row0 + j) * DINP + PC_GV;
#pragma unroll
            for (int q = 0; q < 4; ++q) { const int col = 8 * (c8 + 8 * q); const v4u v8 = *(const v4u*)(src + col);
                LAS bf16* vd = Vt + (col >> 6) * 64 * 72 + (col & 63) * 72 + j;
                vd[0 * 72] = (bf16)(v8.x & 0xffffu); vd[1 * 72] = (bf16)(v8.x >> 16); vd[2 * 72] = (bf16)(v8.y & 0xffffu); vd[3 * 72] = (bf16)(v8.y >> 16);
                vd[4 * 72] = (bf16)(v8.z & 0xffffu); vd[5 * 72] = (bf16)(v8.z >> 16); vd[6 * 72] = (bf16)(v8.w & 0xffffu); vd[7 * 72] = (bf16)(v8.w >> 16); } }
        v4u q8[4], k8[4]; h8 g8[4];
#pragma unroll
        for (int ib = 0; ib < 4; ++ib) { const size_t row = (size_t)(row0 + 16 * ib + r);
            q8[ib] = *(const v4u*)(P + row * DINP + PC_GQ + h * 32 + 8 * kq); k8[ib] = *(const v4u*)(P + row * DINP + PC_GK + h * 32 + 8 * kq);
            g8[ib] = *(const h8*)(LO + row * 1536 + LC_LG + dir * 128 + h * 32 + 8 * kq); }
        __syncthreads();
        float pre[4][8], G[8];
#pragma unroll
        for (int e = 0; e < 8; ++e) { float carry = 0.f;
#pragma unroll
            for (int ib = 0; ib < 4; ++ib) { const float g = (float)g8[ib][e]; float x = g;
                x += dpp0_f<0x111>(x); x += dpp0_f<0x112>(x); x += dpp0_f<0x114>(x); x += dpp0_f<0x118>(x);
                pre[ib][e] = x + carry; carry += allred16(g); }
            G[e] = carry; }
        bf16x8 qf[4], kf[4];
#pragma unroll
        for (int ib = 0; ib < 4; ++ib) { float qs[8], ks[8], kh[8];
            const unsigned qu[4] = {q8[ib].x, q8[ib].y, q8[ib].z, q8[ib].w}, ku[4] = {k8[ib].x, k8[ib].y, k8[ib].z, k8[ib].w};
#pragma unroll
            for (int e = 0; e < 8; ++e) { const float qv = (e & 1) ? bfhi(qu[e >> 1]) : bflo(qu[e >> 1]), kv = (e & 1) ? bfhi(ku[e >> 1]) : bflo(ku[e >> 1]);
                const float bb = dir ? (G[e] - pre[ib][e] + (float)g8[ib][e]) : pre[ib][e];
                qs[e] = qv * 0.17677669529663687f * __expf(bb); ks[e] = kv * __expf(-bb); kh[e] = kv * __expf(G[e] - bb);
                Kw[(8 * kq + e) * 72 + 16 * ib + r] = (bf16)f2bf(kh[e]); }
            v4u qw, kw; qw.x = pk2(qs[0], qs[1]); qw.y = pk2(qs[2], qs[3]); qw.z = pk2(qs[4], qs[5]); qw.w = pk2(qs[6], qs[7]);
            kw.x = pk2(ks[0], ks[1]); kw.y = pk2(ks[2], ks[3]); kw.z = pk2(ks[4], ks[5]); kw.w = pk2(ks[6], ks[7]);
            qf[ib] = __builtin_bit_cast(bf16x8, qw); kf[ib] = __builtin_bit_cast(bf16x8, kw);
            *(v4u*)(P + (size_t)(row0 + 16 * ib + r) * DINP + (dir ? PC_GK : PC_GQ) + h * 32 + 8 * kq) = qw; }
        if (r == 0) {
#pragma unroll
            for (int e = 0; e < 8; ++e) DEC[(size_t)u * 32 + 8 * kq + e] = __expf(G[e]); }
        LDS_WAIT(); asm volatile("" ::: "memory");
#pragma unroll
        for (int ib = 0; ib < 4; ++ib) {
            f32x4 oT[4];
#pragma unroll
            for (int eb = 0; eb < 4; ++eb) oT[eb] = (f32x4){0.f, 0.f, 0.f, 0.f};
#pragma unroll
            for (int kk = 0; kk < 2; ++kk) {
                const bool any = dir ? (2 * kk + 1 >= ib) : (2 * kk <= ib);
                if (any) {
                    f32x4 sb[2];
#pragma unroll
                    for (int x = 0; x < 2; ++x) { const int jb = 2 * kk + x; sb[x] = (f32x4){0.f, 0.f, 0.f, 0.f};
                        const bool need = dir ? (jb >= ib) : (jb <= ib);
                        if (need) { sb[x] = __builtin_amdgcn_mfma_f32_16x16x32_bf16(kf[jb], qf[ib], sb[x], 0, 0, 0);
                            if (jb == ib) {
#pragma unroll
                                for (int reg = 0; reg < 4; ++reg) { const int jj = 4 * kq + reg; const bool keep = dir ? (jj >= r) : (jj <= r); if (!keep) sb[x][reg] = 0.f; } } } }
                    v4u pw; pw.x = pk2(sb[0][0], sb[0][1]); pw.y = pk2(sb[0][2], sb[0][3]); pw.z = pk2(sb[1][0], sb[1][1]); pw.w = pk2(sb[1][2], sb[1][3]);
                    const bf16x8 pf = __builtin_bit_cast(bf16x8, pw);
#pragma unroll
                    for (int eb = 0; eb < 4; ++eb) { const LAS bf16* vp = Vh + (16 * eb + r) * 72 + 32 * kk + 4 * kq;
                        const v2u va = *(const LAS v2u*)vp, vb = *(const LAS v2u*)(vp + 16);
                        const bf16x8 vf = __builtin_bit_cast(bf16x8, (v4u){va.x, va.y, vb.x, vb.y});
                        oT[eb] = __builtin_amdgcn_mfma_f32_16x16x32_bf16(vf, pf, oT[eb], 0, 0, 0); }
                }
            }
            _Float16* op = YO + ((size_t)(2 + dir) * MA + row0 + 16 * ib + r) * 256 + h * 64 + 4 * kq;
#pragma unroll
            for (int eb = 0; eb < 4; ++eb) *(h4*)(op + 16 * eb) = (h4){(_Float16)oT[eb][0], (_Float16)oT[eb][1], (_Float16)oT[eb][2], (_Float16)oT[eb][3]};
        }
        f32x4 kvt[4][2];
#pragma unroll
        for (int eb = 0; eb < 4; ++eb) { kvt[eb][0] = (f32x4){0.f, 0.f, 0.f, 0.f}; kvt[eb][1] = (f32x4){0.f, 0.f, 0.f, 0.f}; }
#pragma unroll
        for (int kk = 0; kk < 2; ++kk) {
            bf16x8 bfr[2];
#pragma unroll
            for (int nb = 0; nb < 2; ++nb) bfr[nb] = *(const LAS bf16x8*)(Kw + (16 * nb + r) * 72 + 32 * kk + 8 * kq);
#pragma unroll
            for (int eb = 0; eb < 4; ++eb) { const bf16x8 afr = *(const LAS bf16x8*)(Vh + (16 * eb + r) * 72 + 32 * kk + 8 * kq);
                kvt[eb][0] = __builtin_amdgcn_mfma_f32_16x16x32_bf16(afr, bfr[0], kvt[eb][0], 0, 0, 0);
                kvt[eb][1] = __builtin_amdgcn_mfma_f32_16x16x32_bf16(afr, bfr[1], kvt[eb][1], 0, 0, 0); } }
        _Float16* kvp = KV + (size_t)u * 2048;
#pragma unroll
        for (int eb = 0; eb < 4; ++eb)
#pragma unroll
            for (int nb = 0; nb < 2; ++nb)
#pragma unroll
                for (int reg = 0; reg < 4; ++reg) kvp[(16 * eb + 4 * kq + reg) * 32 + 16 * nb + r] = (_Float16)kvt[eb][nb][reg];
    }
}
__device__ __forceinline__ void phase_gla_b(const _Float16* KV, const float* DEC, bf16* ST) {
    for (int g = obid() * 512 + otid(); g < 64 * 2048; g += ogdim() * 512) {
        const int chain = g >> 11, idx = g & 2047, d = idx & 31, dir = chain & 1;
        float S = 0.f;
#pragma unroll 1
        for (int s0 = 0; s0 < 68; s0 += 17) {
            float kvv[17], dc[17]; int uu[17];
#pragma unroll
            for (int x = 0; x < 17; ++x) { const int step = s0 + x; const int cc = dir ? (step < 4 ? 3 - step : 71 - step) : step; uu[x] = chain * 68 + cc;
                kvv[x] = (float)KV[(size_t)uu[x] * 2048 + idx]; dc[x] = DEC[(size_t)uu[x] * 32 + d]; }
#pragma unroll
            for (int x = 0; x < 17; ++x) { ST[(size_t)uu[x] * 2048 + idx] = (bf16)f2bf(S); S = dc[x] * S + kvv[x]; }
        }
    }
}
__device__ __forceinline__ void phase_gla_c(const bf16* P, const bf16* ST, _Float16* YO) {
    const int tid = otid(), wave = __builtin_amdgcn_readfirstlane(tid >> 6), lane = tid & 63, r = lane & 15, kq = lane >> 4, h = wave >> 1, dir = wave & 1;
    for (int unit = obid(); unit < 544; unit += ogdim()) {
        const int b = unit / 68, cc = unit % 68; const int row0 = cc < 4 ? ML + b * CTXL + cc * 64 : b * SEQ + (cc - 4) * 64;
        const int u = ((b * 4 + h) * 2 + dir) * 68 + cc;
        bf16x8 af[4];
#pragma unroll
        for (int eb = 0; eb < 4; ++eb) af[eb] = *(const bf16x8*)(ST + (size_t)u * 2048 + (16 * eb + r) * 32 + 8 * kq);
#pragma unroll
        for (int ib = 0; ib < 4; ++ib) {
            const bf16x8 qf = *(const bf16x8*)(P + (size_t)(row0 + 16 * ib + r) * DINP + (dir ? PC_GK : PC_GQ) + h * 32 + 8 * kq);
            _Float16* op = YO + ((size_t)(2 + dir) * MA + row0 + 16 * ib + r) * 256 + h * 64 + 4 * kq;
#pragma unroll
            for (int eb = 0; eb < 4; ++eb) { f32x4 acc = (f32x4){0.f, 0.f, 0.f, 0.f};
                acc = __builtin_amdgcn_mfma_f32_16x16x32_bf16(af[eb], qf, acc, 0, 0, 0);
                const h4 old = *(const h4*)(op + 16 * eb);
                *(h4*)(op + 16 * eb) = (h4){(_Float16)((float)old[0] + acc[0]), (_Float16)((float)old[1] + acc[1]), (_Float16)((float)old[2] + acc[2]), (_Float16)((float)old[3] + acc[3])}; }
        }
    }
}

__device__ __forceinline__ void phase_swa(const Args& a, int l, const bf16* P, bf16* MIX, bool with_ctx, LAS unsigned char* lds) {
    LAS bf16* Ks = (LAS bf16*)lds;
    LAS bf16* Vt = Ks + 64 * 72;
    const int tid = otid(), wave = __builtin_amdgcn_readfirstlane(tid >> 6), lane = tid & 63, li = lane & 15, lq = lane >> 4;
    const int nunits = with_ctx ? 1088 : 1024;
    for (int u = obid(); u < nunits; u += ogdim()) {
        const bool isctx = u >= 1024;
        int b, kvh, blk;
        if (!isctx) { b = u >> 7; kvh = (u >> 6) & 1; blk = u & 63; } else { const int v = u - 1024; b = v >> 3; kvh = (v >> 2) & 1; blk = v & 3; }
        const int g = wave >> 1, half = wave & 1, hq = kvh * 4 + g;
        const int qtok0 = blk * 64 + half * 32, qrow0 = isctx ? ML + b * CTXL + qtok0 : b * SEQ + qtok0;
        bf16x8 qf[2][2];
#pragma unroll
        for (int qb = 0; qb < 2; ++qb)
#pragma unroll
            for (int ks = 0; ks < 2; ++ks) qf[qb][ks] = *(const bf16x8*)(P + (size_t)(qrow0 + 16 * qb + li) * DINP + PC_SQ + hq * 64 + 32 * ks + 8 * lq);
        f32x4 Oa[4][2];
#pragma unroll
        for (int x = 0; x < 4; ++x)
#pragma unroll
            for (int y = 0; y < 2; ++y) Oa[x][y] = (f32x4){0.f, 0.f, 0.f, 0.f};
        const float sinkv = a.in[I_SINK][l * 8 + hq];
        float mrun[2], lrun[2];
#pragma unroll
        for (int qb = 0; qb < 2; ++qb) { mrun[qb] = sinkv; lrun[qb] = lq == 0 ? 1.0f : 0.f; }
        int lo = 0, nlocal = 0;
        if (!isctx) { lo = 64 * blk - 128; if (lo < 0) lo = 0; int hi = 64 * blk + 192; if (hi > SEQ) hi = SEQ; nlocal = (hi - lo) >> 6; }
        const int ntiles = nlocal + 4;
        for (int t = 0; t < ntiles; ++t) {
            const bool local = t < nlocal; const int ktok0 = local ? lo + 64 * t : 64 * (t - nlocal); const int krow0 = local ? b * SEQ + ktok0 : ML + b * CTXL + ktok0;
            __syncthreads();
            {   const int key = tid >> 3, ch = tid & 7; const bf16* src = P + (size_t)(krow0 + key) * DINP;
                const v4u kv = *(const v4u*)(src + PC_SK + kvh * 64 + 8 * ch); *(LAS v4u*)(Ks + key * 72 + 8 * ch) = kv;
                const v4u v8 = *(const v4u*)(src + PC_SV + kvh * 64 + 8 * ch);
                LAS bf16* vd = Vt + (8 * ch) * 68 + key;
                vd[0 * 68] = (bf16)(v8.x & 0xffffu); vd[1 * 68] = (bf16)(v8.x >> 16); vd[2 * 68] = (bf16)(v8.y & 0xffffu); vd[3 * 68] = (bf16)(v8.y >> 16);
                vd[4 * 68] = (bf16)(v8.z & 0xffffu); vd[5 * 68] = (bf16)(v8.z >> 16); vd[6 * 68] = (bf16)(v8.w & 0xffffu); vd[7 * 68] = (bf16)(v8.w >> 16); }
            __syncthreads();
            const bool rel = !local || (ktok0 + 63 >= qtok0 - 128 && ktok0 <= qtok0 + 31 + 128);
            if (rel) {
#pragma unroll
                for (int qb = 0; qb < 2; ++qb) {
                    f32x4 s[4];
#pragma unroll
                    for (int kb = 0; kb < 4; ++kb) { s[kb] = (f32x4){0.f, 0.f, 0.f, 0.f};
#pragma unroll
                        for (int ks = 0; ks < 2; ++ks) { const bf16x8 kf = *(const LAS bf16x8*)(Ks + (16 * kb + li) * 72 + 32 * ks + 8 * lq);
                            s[kb] = __builtin_amdgcn_mfma_f32_16x16x32_bf16(kf, qf[qb][ks], s[kb], 0, 0, 0); } }
                    if (local) { const int qt = qtok0 + 16 * qb + li;
#pragma unroll
                        for (int kb = 0; kb < 4; ++kb)
#pragma unroll
                            for (int j = 0; j < 4; ++j) { const int dlt = ktok0 + 16 * kb + 4 * lq + j - qt; if (dlt > 128 || dlt < -128) s[kb][j] = -INFINITY; } }
                    float mx = -INFINITY;
#pragma unroll
                    for (int kb = 0; kb < 4; ++kb) mx = fmaxf(mx, fmaxf(fmaxf(s[kb][0], s[kb][1]), fmaxf(s[kb][2], s[kb][3])));
                    mx = fmaxf(mx, __shfl_xor(mx, 16)); mx = fmaxf(mx, __shfl_xor(mx, 32));
                    const float mnew = fmaxf(mrun[qb], mx), corr = __expf(mrun[qb] - mnew); mrun[qb] = mnew;
                    float ls = 0.f;
#pragma unroll
                    for (int kb = 0; kb < 4; ++kb)
#pragma unroll
                        for (int j = 0; j < 4; ++j) { const float p = __expf(s[kb][j] - mnew); s[kb][j] = p; ls += p; }
                    lrun[qb] = lrun[qb] * corr + ls;
#pragma unroll
                    for (int db = 0; db < 4; ++db) Oa[db][qb] = Oa[db][qb] * corr;
#pragma unroll
                    for (int kk = 0; kk < 2; ++kk) {
                        v4u pw; pw.x = pk2(s[2 * kk][0], s[2 * kk][1]); pw.y = pk2(s[2 * kk][2], s[2 * kk][3]); pw.z = pk2(s[2 * kk + 1][0], s[2 * kk + 1][1]); pw.w = pk2(s[2 * kk + 1][2], s[2 * kk + 1][3]);
                        const bf16x8 pf = __builtin_bit_cast(bf16x8, pw);
#pragma unroll
                        for (int db = 0; db < 4; ++db) { const LAS bf16* vp = Vt + (16 * db + li) * 68 + 32 * kk + 4 * lq;
                            const v2u va = *(const LAS v2u*)vp, vb = *(const LAS v2u*)(vp + 16);
                            const bf16x8 vf = __builtin_bit_cast(bf16x8, (v4u){va.x, va.y, vb.x, vb.y});
                            Oa[db][qb] = __builtin_amdgcn_mfma_f32_16x16x32_bf16(vf, pf, Oa[db][qb], 0, 0, 0); }
                    }
                }
            }
        }
#pragma unroll
        for (int qb = 0; qb < 2; ++qb) { float lt = lrun[qb]; lt += __shfl_xor(lt, 16); lt += __shfl_xor(lt, 32); const float inv = 1.0f / lt;
            bf16* op = MIX + (size_t)(qrow0 + 16 * qb + li) * 1024 + 256 + hq * 64 + 4 * lq;
#pragma unroll
            for (int db = 0; db < 4; ++db) { const f32x4 o = Oa[db][qb] * inv; v2u w; w.x = pk2(o.x, o.y); w.y = pk2(o.z, o.w); *(v2u*)(op + 16 * db) = w; } }
    }
}

__device__ __forceinline__ void phase_assemble(const Args& a, int l, const bf16* P, const _Float16* RF, const _Float16* LO, const _Float16* YO, bf16* MIX, int nrows) {
    const int lane = otid() & 63, gw = obid() * 8 + (otid() >> 6), NGW = ogdim() * 8, c = 4 * lane;
    const f32x4 ng = *(const f32x4*)(a.in[I_GNORM] + l * 256 + c), ka = *(const f32x4*)(a.in[I_KA] + l * 256 + c), rk = *(const f32x4*)(a.in[I_RK] + l * 256 + c);
    const f32x4 gg = *(const f32x4*)(a.in[I_GNG] + l * 256 + c), gb = *(const f32x4*)(a.in[I_GNB] + l * 256 + c);
    for (int row = gw; row < nrows; row += NGW) {
        {
            const h4 of = *(const h4*)(YO + ((size_t)2 * MA + row) * 256 + c), ob = *(const h4*)(YO + ((size_t)3 * MA + row) * 256 + c);
            f32x4 o; float ss = 0.f;
#pragma unroll
            for (int e = 0; e < 4; ++e) { o[e] = (float)of[e] + (float)ob[e]; ss += o[e] * o[e]; }
            ss += __shfl_xor(ss, 1); ss += __shfl_xor(ss, 2); ss += __shfl_xor(ss, 4); ss += __shfl_xor(ss, 8);
            const float rms = 1.0f / sqrtf(ss * (1.0f / 64.0f) + LN_EPS);
            const v2u g2 = *(const v2u*)(P + (size_t)row * DINP + PC_GG + c);
            const float ga[4] = {bflo(g2.x), bfhi(g2.x), bflo(g2.y), bfhi(g2.y)}; float r[4];
#pragma unroll
            for (int e = 0; e < 4; ++e) r[e] = o[e] * rms * ng[e] * (ga[e] * sigmoidf_(ga[e]));
            v2u w; w.x = pk2(r[0], r[1]); w.y = pk2(r[2], r[3]); *(v2u*)(MIX + (size_t)row * 1024 + c) = w; }
        {
            const h4 yf = *(const h4*)(YO + ((size_t)0 * MA + row) * 256 + c), yb = *(const h4*)(YO + ((size_t)1 * MA + row) * 256 + c);
            const _Float16* rf = RF + (size_t)row * 1024 + c; const _Float16* lo = LO + (size_t)row * 1536 + c;
            const h4 r4 = *(const h4*)(rf + RF_R), k4 = *(const h4*)(rf + RF_K), v4 = *(const h4*)(rf + RF_V);
            const h4 af = *(const h4*)(lo + LC_A), ab = *(const h4*)(lo + LC_A + 256), g4 = *(const h4*)(lo + LC_G);
            f32x4 y; float s1 = 0.f, bon = 0.f;
#pragma unroll
            for (int e = 0; e < 4; ++e) { y[e] = (float)yf[e] + (float)yb[e]; s1 += y[e];
                bon += (float)r4[e] * (float)k4[e] * (1.0f + (0.5f * ((float)af[e] + (float)ab[e]) - 1.0f) * ka[e]) * rk[e]; }
            s1 += __shfl_xor(s1, 1); s1 += __shfl_xor(s1, 2); s1 += __shfl_xor(s1, 4); s1 += __shfl_xor(s1, 8);
            bon += __shfl_xor(bon, 1); bon += __shfl_xor(bon, 2); bon += __shfl_xor(bon, 4); bon += __shfl_xor(bon, 8);
            const float mu = s1 * (1.0f / 64.0f); float s2 = 0.f;
#pragma unroll
            for (int e = 0; e < 4; ++e) { y[e] -= mu; s2 += y[e] * y[e]; }
            s2 += __shfl_xor(s2, 1); s2 += __shfl_xor(s2, 2); s2 += __shfl_xor(s2, 4); s2 += __shfl_xor(s2, 8);
            const float rstd = 1.0f / sqrtf(s2 * (1.0f / 64.0f) + 64e-5f); float r[4];
#pragma unroll
            for (int e = 0; e < 4; ++e) r[e] = (y[e] * rstd * gg[e] + gb[e] + bon * (float)v4[e]) * (float)g4[e];
            v2u w; w.x = pk2(r[0], r[1]); w.y = pk2(r[2], r[3]); *(v2u*)(MIX + (size_t)row * 1024 + 768 + c) = w; }
    }
}

#define XB_TMO      128
#define XB_XCNT(j)  (256  + 64 * (j))
#define XB_XSUB(j)  (1280 + 64 * (j))
#define XB_XGEN(j)  (2304 + 64 * (j))
#define XB_TOP      3328
#define XB_TOPGEN   3392
#define XCD_BAR_WORDS 3456
#define XB_SPIN_CAP (1u << 18)

__device__ __forceinline__ unsigned xb_ld(unsigned* p)              { return __hip_atomic_load(p, __ATOMIC_RELAXED, __HIP_MEMORY_SCOPE_AGENT); }
__device__ __forceinline__ unsigned xb_add(unsigned* p, unsigned v) { return __hip_atomic_fetch_add(p, v, __ATOMIC_RELAXED, __HIP_MEMORY_SCOPE_AGENT); }
__device__ __forceinline__ unsigned xb_xcc_id() { return (unsigned)__builtin_amdgcn_s_getreg((3 << 11) | 20) & 0xFu; }
#define XB_SPIN(cond, bar) do { unsigned _sp = 0; while (cond) { __builtin_amdgcn_s_sleep(1); \
    if ((++_sp & 255u) == 0u) { if (xb_ld(&(bar)[XB_TMO])) break; if (_sp > XB_SPIN_CAP) { atomicAdd(&(bar)[XB_TMO], 1u); break; } } } } while (0)

struct XcdBarrier {
    unsigned* bar; unsigned x;
    volatile LAS unsigned* st;
};

__device__ __forceinline__ XcdBarrier xcd_barrier_post(unsigned* bar, volatile LAS unsigned* st) {
    XcdBarrier b; b.bar = bar; b.x = xb_xcc_id(); b.st = st;
    if (threadIdx.x == 0) (void)xb_add(&bar[XB_XCNT(b.x)], 1u);
    return b;
}
__device__ __forceinline__ void xcd_barrier_complete(unsigned* bar, unsigned x, unsigned& nloc, unsigned& nx) {
    const unsigned G = gridDim.x * gridDim.y * gridDim.z;
    unsigned sum, cnt, mine, sp = 0u;
    for (;;) {
        sum = 0u; cnt = 0u; mine = 0u;
#pragma unroll
        for (unsigned j = 0; j < 16; ++j) { const unsigned c = xb_ld(&bar[XB_XCNT(j)]); sum += c; cnt += (c > 0u) ? 1u : 0u; mine = (j == x) ? c : mine; }
        if (sum == G) break;
        __builtin_amdgcn_s_sleep(1);
        if ((++sp & 255u) == 0u) { if (xb_ld(&bar[XB_TMO])) break; if (sp > XB_SPIN_CAP) { atomicAdd(&bar[XB_TMO], 1u); break; } }
    }
    nloc = mine > 0u ? mine : 1u; nx = cnt > 0u ? cnt : 1u;
}

__device__ __forceinline__ void xcd_barrier(const XcdBarrier& b) {
    asm volatile("s_waitcnt vmcnt(0)" ::: "memory");
    __syncthreads();
    if (threadIdx.x == 0) {
        unsigned* bar = b.bar;
        __builtin_amdgcn_s_waitcnt(0);
        unsigned nloc = b.st[0], nx = b.st[1];
        if (nloc == 0u) { xcd_barrier_complete(bar, b.x, nloc, nx); b.st[0] = nloc; b.st[1] = nx; }
        const unsigned old = xb_add(&bar[XB_XSUB(b.x)], 1u);
        const unsigned gen = old / nloc;
        if (old + 1u == (gen + 1u) * nloc) {
            __builtin_amdgcn_fence(__ATOMIC_RELEASE, "agent");
            asm volatile("s_waitcnt vmcnt(0)" ::: "memory");
            const unsigned og = xb_add(&bar[XB_TOP], 1u);
            const unsigned tg = og / nx;
            if (og + 1u == (tg + 1u) * nx) xb_add(&bar[XB_TOPGEN], 1u);
            else XB_SPIN(xb_ld(&bar[XB_TOPGEN]) == tg, bar);
            __builtin_amdgcn_fence(__ATOMIC_ACQUIRE, "agent");
            xb_add(&bar[XB_XGEN(b.x)], 1u);
            asm volatile("s_waitcnt vmcnt(0)" ::: "memory");
        } else {
            XB_SPIN(xb_ld(&bar[XB_XGEN(b.x)]) == gen, bar);
            __builtin_amdgcn_fence(__ATOMIC_ACQUIRE, "agent");
            asm volatile("s_waitcnt vmcnt(0)" ::: "memory");
        }
    }
    __syncthreads();
}

#define GSYNC() do { XcdBarrier xb_; xb_.bar = (unsigned*)a.ws; xb_.x = xb_xcc_id(); xb_.st = (volatile LAS unsigned*)(lds + 133120); xcd_barrier(xb_); } while (0)
#ifndef REP_RWKV
#define REP_RWKV 1
#endif
#ifndef REP_GLA
#define REP_GLA 1
#endif
#ifndef REP_SWA
#define REP_SWA 1
#endif
#ifndef REP_UP
#define REP_UP 1
#endif
__global__ void __launch_bounds__(512, 2) mega_fwd(Args a) {
    extern __shared__ __attribute__((aligned(16))) unsigned char lds_raw[];
    cg::grid_group grid = cg::this_grid();
    LAS unsigned char* lds = (LAS unsigned char*)lds_raw;
    unsigned char* ws = a.ws;
    float* MOD = (float*)(ws + WS_MOD);
    float* XL = a.out; float* XC = (float*)(ws + WS_XC);
    bf16* U = (bf16*)(ws + WS_U); bf16* HID = (bf16*)(ws + WS_HID);
    _Float16* LO = (_Float16*)(ws + WS_LO); _Float16* RF = (_Float16*)(ws + WS_RF); _Float16* YO = (_Float16*)(ws + WS_YO);

    { volatile LAS unsigned* st = (volatile LAS unsigned*)(lds + 133120); if (threadIdx.x < 2) st[threadIdx.x] = 0u; }
    __syncthreads();
    (void)xcd_barrier_post((unsigned*)ws, (volatile LAS unsigned*)(lds + 133120));
    phase_adaln(a, MOD, lds);
    __syncthreads();
    phase_convert(a, 0, ws, lds);
    grid.sync();
    phase_mod0(a, MOD, U);
    GSYNC();
    for (int l = 0; l < DEPTH; ++l) {
        const bool last = (l == DEPTH - 1);
        asm volatile("" : "+s"(ws));
        const float* modl = MOD + (size_t)l * 9 * 9216;
        const float* lng = a.in[I_LNG] + l * 3 * 1024; const float* lnb = a.in[I_LNB] + l * 3 * 1024;
        for (int rep = 0; rep < REP_UP; ++rep) { pg8::Gemm g{U, (const bf16*)(ws + WS_WGU1), MA, 2 * DFF, 1024}; pg8::StaticOrder S; S.init(MA, 2 * DFF, ogdim(), obid());
          pg8::EpiSwiglu E{HID, DFF}; pg8::gemm_phase<pg8::EpiSwiglu, pg8::StaticOrder, true, true>(lds, g, S, E); }
        GSYNC();
        { pg8::Gemm g{HID, (const bf16*)(ws + WS_WD1), MA, 1024, DFF}; pg8::StaticOrder S; S.init(MA, 1024, ogdim(), obid());
          pg8::EpiResid E{l == 0 ? a.in[I_X] : XL, l == 0 ? a.in[I_CTX] : XC, XL, XC, modl + 2 * 1024, ALPHA, 0.5f};
          pg8::gemm_phase<pg8::EpiResid, pg8::StaticOrder, true, true>(lds, g, S, E); }
        GSYNC();
        phase_ln(XL, XC, lng, lnb, modl + 3 * 1024, U, MA, true);
        GSYNC();
        { pg8::Gemm g{U, (const bf16*)(ws + WS_WIN), MA, DINP, 1024}; pg8::StaticOrder S; S.init(MA, DINP, ogdim(), obid());
          pg8::EpiStore E{HID, DINP}; pg8::gemm_phase<pg8::EpiStore, pg8::StaticOrder, true, true>(lds, g, S, E); }
        GSYNC();
        phase_features(a, l, HID, RF, U, lds);
        GSYNC();
        { pg8::Gemm g{U, (const bf16*)(ws + WS_WLORA), MA, LORA_N, LORA_K}; pg8::StaticOrder S; S.init(MA, LORA_N, ogdim(), obid());
          pg8::EpiLora E{LO, a.in[I_W0] + l * 512, a.in[I_A0] + l * 512, a.in[I_GBIAS] + l * 256};
          pg8::gemm_phase<pg8::EpiLora, pg8::StaticOrder, true, true>(lds, g, S, E); }
        GSYNC();
        phase_gla_a(l, HID, LO, YO, (_Float16*)(ws + WS_KV), (float*)(ws + WS_DEC), lds);
        __syncthreads();
        for (int rep = 0; rep < REP_SWA; ++rep) { phase_swa(a, l, HID, U, !last, lds); __syncthreads(); }
        GSYNC();
        phase_gla_b((const _Float16*)(ws + WS_KV), (const float*)(ws + WS_DEC), (bf16*)(ws + WS_ST));
        for (int rep = 0; rep < REP_RWKV; ++rep) { phase_rwkv(a, l, RF, LO, YO, lds); __syncthreads(); }
        GSYNC();
        phase_gla_c(HID, (const bf16*)(ws + WS_ST), YO);
        GSYNC();
        phase_assemble(a, l, HID, RF, LO, YO, U, last ? ML : MA);
        GSYNC();
        const int Mo = last ? ML : MA;
        { pg8::Gemm g{U, (const bf16*)(ws + WS_WOUT), Mo, 1024, 1024}; pg8::StaticOrder S; S.init(Mo, 1024, ogdim(), obid());
          pg8::EpiResid E{XL, XC, XL, XC, modl + 5 * 1024, ALPHA, 1.0f};
          pg8::gemm_phase<pg8::EpiResid, pg8::StaticOrder, true, true>(lds, g, S, E); }
        GSYNC();
        phase_ln(XL, XC, lng + 1024, lnb + 1024, modl + 6 * 1024, U, Mo, true);
        GSYNC();
        { pg8::Gemm g{U, (const bf16*)(ws + WS_WGU2), Mo, 2 * DFF, 1024}; pg8::StaticOrder S; S.init(Mo, 2 * DFF, ogdim(), obid());
          pg8::EpiSwiglu E{HID, DFF}; pg8::gemm_phase<pg8::EpiSwiglu, pg8::StaticOrder, true, true>(lds, g, S, E); }
        GSYNC();
        { pg8::Gemm g{HID, (const bf16*)(ws + WS_WD2), Mo, 1024, DFF}; pg8::StaticOrder S; S.init(Mo, 1024, ogdim(), obid());
          pg8::EpiResid E{XL, XC, XL, XC, modl + 8 * 1024, ALPHA, 0.5f};
          pg8::gemm_phase<pg8::EpiResid, pg8::StaticOrder, true, true>(lds, g, S, E); }
        GSYNC();
        phase_ln(XL, XC, lng + 2048, lnb + 2048, MOD + (size_t)(last ? l : l + 1) * 9 * 9216, U, Mo, !last);
        if (!last) { __syncthreads(); phase_convert(a, l + 1, ws, lds); }
        GSYNC();
    }
}

extern "C" void kernel_launch(void* const* d_in, const int* in_sizes, int n_in, void* d_out, int out_size, void* d_ws, size_t ws_size, hipStream_t stream) {
    static int grid = 0;
    if (grid == 0) {
        if (n_in != 31 || out_size != ML * DM || ws_size < WS_END) { fprintf(stderr, "kernel_launch: unexpected problem (n_in %d, out %d, ws %zu need %zu)\n", n_in, out_size, ws_size, (size_t)WS_END); grid = -1; return; }
        int dev = 0, cus = 0, per_cu = 0;
        hipGetDevice(&dev); hipDeviceGetAttribute(&cus, hipDeviceAttributeMultiprocessorCount, dev);
        if (hipFuncSetAttribute((const void*)mega_fwd, hipFuncAttributeMaxDynamicSharedMemorySize, LDS_BYTES) != hipSuccess) { fprintf(stderr, "kernel_launch: hipFuncSetAttribute failed\n"); grid = -1; return; }
        if (hipOccupancyMaxActiveBlocksPerMultiprocessor(&per_cu, (const void*)mega_fwd, 512, LDS_BYTES) != hipSuccess || per_cu < 1) { fprintf(stderr, "kernel_launch: occupancy query says %d\n", per_cu); per_cu = 1; }
        (void)hipGetLastError();
        grid = cus * per_cu;
    }
    if (grid < 0) return;
    if (hipMemsetAsync(d_ws, 0, 65536, stream) != hipSuccess) { fprintf(stderr, "kernel_launch: memset failed\n"); return; }
    Args a{};
    for (int i = 0; i < 31; ++i) a.in[i] = (const float*)d_in[i];
    a.out = (float*)d_out; a.ws = (unsigned char*)d_ws;
    void* args[] = {&a};
    const hipError_t e = hipLaunchCooperativeKernel((const void*)mega_fwd, dim3(grid), dim3(512), args, LDS_BYTES, stream);
    if (e != hipSuccess) fprintf(stderr, "kernel_launch: cooperative launch failed: %s (grid %d)\n", hipGetErrorString(e), grid);
}
```

```cpp
#include <hip/hip_runtime.h>
#include <hip/hip_cooperative_groups.h>
#include <cstdio>
#include <cstdint>
namespace cg = cooperative_groups;
namespace pg8 {
#define PG8_LAS __attribute__((address_space(3)))
typedef unsigned short bf16_t;
typedef short bf16x8 __attribute__((ext_vector_type(8)));
typedef float f32x4 __attribute__((ext_vector_type(4)));
typedef unsigned u32x4 __attribute__((ext_vector_type(4)));
constexpr int BM = 256, BK = 64, HALF = 128, HTB = HALF * BK * 2  , STAGE_BYTES = 8 * HTB, NXCD = 8, WGM = 8;

__host__ __device__ __forceinline__ int lds_byte(int r, int c) { const int st = (r >> 4) * 2 + (c >> 5), rr = r & 15, cc = c & 31, ob = rr * 64 + cc * 2; return st * 1024 + (ob ^ (((ob >> 9) & 1) << 5)); }
__host__ __device__ __forceinline__ void stage_rc(int b, int& R, int& C) { const int st = b / 1024, sb = b % 1024, swz = sb ^ (((sb >> 9) & 1) << 5); R = (st >> 1) * 16 + swz / 64; C = (st & 1) * 32 + (swz % 64) / 2; }
__host__ __device__ __forceinline__ int perm32(int rho) { const int n = rho >> 4, i = rho & 15; return 8 * (i >> 2) + 4 * n + (i & 3); }

struct Unit { int pm, pn; };
struct Gemm { const bf16_t* A; const bf16_t* Bt; int M, N, K; };

struct StaticOrder {
    int nM, nN, nwg, G, c;
    __host__ __device__ void init(int M, int N, int G_, int c_) { nM = M / BM; nN = N / BM; nwg = nM * nN; G = G_; c = c_; }
    __host__ __device__ bool next(int i, Unit& u) const {
        const long L = (long)i * G + c; if (L >= nwg) return false;
        int wgid = (int)L; { const int q = nwg / NXCD, r = nwg % NXCD, xcd = wgid % NXCD, off = wgid / NXCD; wgid = (xcd < r ? xcd * (q + 1) : r * (q + 1) + (xcd - r) * q) + off; }
        const int nig = WGM * nN, gid = wgid / nig, fm = gid * WGM, gsz = (nM - fm) < WGM ? (nM - fm) : WGM;
        u.pm = fm + ((wgid % nig) % gsz); u.pn = (wgid % nig) / gsz; return true;
    }
    __device__ __forceinline__ void a_ready(const Unit&) const {}
    __device__ __forceinline__ void done(const Unit&) const {}
};

__device__ __forceinline__ unsigned cvt_pk_bf16(float lo, float hi) { unsigned r; asm volatile("v_cvt_pk_bf16_f32 %0, %1, %2" : "=v"(r) : "v"(lo), "v"(hi)); return r; }
typedef _Float16 f16x8 __attribute__((ext_vector_type(8)));
typedef unsigned u32x2 __attribute__((ext_vector_type(2)));
__device__ __forceinline__ float fast_sigmoid(float x) { return __builtin_amdgcn_rcpf(1.0f + __expf(-x)); }
__device__ __forceinline__ float log_sigmoid(float x) { return fminf(x, 0.f) - __logf(1.0f + __expf(-fabsf(x))); }

struct EpiSwiglu {
    static constexpr bool PERM = true, AFTER_DRAIN = false;
    bf16_t* O; int ldc;
    __device__ __forceinline__ void operator()(const f32x4 (&acc)[2][2][4][2], const Unit& u, int wr, int wc, int fr, int fq) const {
        const int row0 = u.pm * BM + wr * 64 + fr, col0 = u.pn * HALF + wc * 32 + 8 * fq;
#pragma unroll
        for (int ai = 0; ai < 2; ++ai)
#pragma unroll
            for (int m = 0; m < 4; ++m) {
                bf16_t* rowp = O + (size_t)(row0 + ai * HALF + m * 16) * ldc + col0;
                float h[8];
#pragma unroll
                for (int n = 0; n < 2; ++n)
#pragma unroll
                    for (int e = 0; e < 4; ++e) { const float g = acc[ai][0][m][n][e], up = acc[ai][1][m][n][e]; h[4 * n + e] = g * fast_sigmoid(g) * up; }
                u32x4 w; w.x = cvt_pk_bf16(h[0], h[1]); w.y = cvt_pk_bf16(h[2], h[3]); w.z = cvt_pk_bf16(h[4], h[5]); w.w = cvt_pk_bf16(h[6], h[7]);
                *(u32x4*)rowp = w;
            }
    }
};
struct EpiStore {
    static constexpr bool PERM = true, AFTER_DRAIN = false;
    bf16_t* O; int ldc;
    __device__ __forceinline__ void operator()(const f32x4 (&acc)[2][2][4][2], const Unit& u, int wr, int wc, int fr, int fq) const {
        const int row0 = u.pm * BM + wr * 64 + fr, col0 = u.pn * BM + wc * 32 + 8 * fq;
#pragma unroll
        for (int ai = 0; ai < 2; ++ai)
#pragma unroll
            for (int m = 0; m < 4; ++m) {
                bf16_t* rowp = O + (size_t)(row0 + ai * HALF + m * 16) * ldc + col0;
#pragma unroll
                for (int bj = 0; bj < 2; ++bj) { const f32x4 v0 = acc[ai][bj][m][0], v1 = acc[ai][bj][m][1];
                    u32x4 w; w.x = cvt_pk_bf16(v0[0], v0[1]); w.y = cvt_pk_bf16(v0[2], v0[3]); w.z = cvt_pk_bf16(v1[0], v1[1]); w.w = cvt_pk_bf16(v1[2], v1[3]);
                    *(u32x4*)(rowp + bj * HALF) = w; }
            }
    }
};
struct EpiResid {
    static constexpr bool PERM = false, AFTER_DRAIN = false;
    const float* src_lat; const float* src_ctx; float* dst_lat; float* dst_ctx; const float* gate  ; float alpha, coef;
    const float* stats; const float* lg; const float* lb; int use_ln;
    __device__ __forceinline__ void operator()(const f32x4 (&acc)[2][2][4][2], const Unit& u, int wr, int wc, int fr, int fq) const {
        const bool ctx = u.pm >= 128; const int bi = ctx ? 8 : (u.pm >> 4);
        const float* src = ctx ? src_ctx + (size_t)(u.pm - 128) * BM * 1024 : src_lat + (size_t)u.pm * BM * 1024;
        float* dst = ctx ? dst_ctx + (size_t)(u.pm - 128) * BM * 1024 : dst_lat + (size_t)u.pm * BM * 1024;
        const float* gp = gate + (size_t)bi * 9216;
        const int col0 = u.pn * BM + wc * 32 + 4 * fq;
        float mean[2][4], rstd[2][4];
#pragma unroll
        for (int ai = 0; ai < 2; ++ai)
#pragma unroll
            for (int m = 0; m < 4; ++m) { mean[ai][m] = 0.f; rstd[ai][m] = 1.f;
                if (use_ln) { typedef float f32x2s __attribute__((ext_vector_type(2))); const f32x2s st = *(const f32x2s*)(stats + 2 * (size_t)(u.pm * BM + ai * HALF + wr * 64 + m * 16 + fr)); mean[ai][m] = st.x; rstd[ai][m] = st.y; } }
#pragma unroll
        for (int bj = 0; bj < 2; ++bj)
#pragma unroll
            for (int n = 0; n < 2; ++n) { const int cc = col0 + bj * HALF + n * 16;
                const f32x4 gv = *(const f32x4*)(gp + cc) * coef; f32x4 ga = (f32x4){alpha, alpha, alpha, alpha}, ba = (f32x4){0.f, 0.f, 0.f, 0.f};
                if (use_ln) { ga = *(const f32x4*)(lg + cc) * alpha; ba = *(const f32x4*)(lb + cc) * alpha; }
#pragma unroll
                for (int ai = 0; ai < 2; ++ai)
#pragma unroll
                    for (int m = 0; m < 4; ++m) { const size_t off = (size_t)(ai * HALF + wr * 64 + m * 16 + fr) * 1024 + cc;
                        const f32x4 sv = *(const f32x4*)(src + off);
                        *(f32x4*)(dst + off) = (sv - mean[ai][m]) * rstd[ai][m] * ga + ba + gv * acc[ai][bj][m][n]; }
                asm volatile("" ::: "memory"); }
    }
};
struct EpiLora {
    static constexpr bool PERM = true, AFTER_DRAIN = false;
    _Float16* O; const float* w0; const float* a0; const float* gbias;
    template <int MODE> __device__ __forceinline__ void tile(const f32x4 (&acc)[2][2][4][2], const Unit& u, int wr, int wc, int fr, int fq, const float* bias) const {
        const int row0 = u.pm * BM + wr * 64 + fr, lc0 = wc * 32 + 8 * fq;
        float bv[2][8];
#pragma unroll
        for (int bj = 0; bj < 2; ++bj)
#pragma unroll
            for (int e = 0; e < 8; ++e) bv[bj][e] = (MODE == 2) ? 0.f : bias[lc0 + bj * HALF + e];
#pragma unroll
        for (int ai = 0; ai < 2; ++ai)
#pragma unroll
            for (int m = 0; m < 4; ++m) {
                _Float16* rowp = O + (size_t)(row0 + ai * HALF + m * 16) * 1536 + u.pn * BM + lc0;
#pragma unroll
                for (int bj = 0; bj < 2; ++bj) {
                    f16x8 o;
#pragma unroll
                    for (int e = 0; e < 8; ++e) { const float x = acc[ai][bj][m][e >> 2][e & 3] + bv[bj][e]; float r;
                        if (MODE == 0) r = __expf(-__expf(log_sigmoid(x) - 0.5f));
                        else if (MODE == 1) r = fast_sigmoid(x);
                        else if (MODE == 2) r = x;
                        else r = log_sigmoid(x) * (1.0f / 16.0f);
                        o[e] = (_Float16)r; }
                    *(f16x8*)(rowp + bj * HALF) = o;
                }
            }
    }
    __device__ __forceinline__ void operator()(const f32x4 (&acc)[2][2][4][2], const Unit& u, int wr, int wc, int fr, int fq) const {
        const int pn = u.pn;
        if (pn < 2) tile<0>(acc, u, wr, wc, fr, fq, w0 + pn * 256);
        else if (pn < 4) tile<1>(acc, u, wr, wc, fr, fq, a0 + (pn - 2) * 256);
        else if (pn == 4) tile<2>(acc, u, wr, wc, fr, fq, gbias);
        else tile<3>(acc, u, wr, wc, fr, fq, gbias);
    }
};

template <class Epi, class Sched, bool ALIGN_EPI = false, bool SP2 = false>
__device__ __forceinline__ void gemm_phase(PG8_LAS unsigned char* lds, const Gemm g, const Sched& S, const Epi& E) {
    int tid_ = threadIdx.x; asm volatile("" : "+v"(tid_)); const int tid = tid_, wid = __builtin_amdgcn_readfirstlane(tid >> 6), lane = tid & 63, wr = wid >> 2, wc = wid & 3, fr = lane & 15, fq = lane >> 4;
    const int K = g.K, nt = K / BK;
    unsigned voffA[2], voffB[2];
#pragma unroll
    for (int i = 0; i < 2; ++i) { int R, C; stage_rc(tid * 16 + i * 8192, R, C); const int Rb = Epi::PERM ? ((R & ~31) + perm32(R & 31)) : R;
        voffA[i] = (unsigned)(R * K + C) * 2u; voffB[i] = (unsigned)(Rb * K + C) * 2u; }
    const size_t kstep = (size_t)(BK * 2);
    const size_t hstep = (size_t)HALF * K * 2;
    const size_t tstep = 2 * hstep;
    const unsigned ldsw = (unsigned)wid * 1024u;
    const int aoff = lds_byte(wr * 64 + fr, fq * 8), boff = lds_byte(wc * 32 + fr, fq * 8);
#define PG8_SA(b, h) (((b) * 2 + (h)) * HTB)
#define PG8_SB(b, h) ((4 + (b) * 2 + (h)) * HTB)
#define PG8_STAGE(bufoff, gbase, voff) do { _Pragma("unroll") for (int _i = 0; _i < 2; ++_i) \
        __builtin_amdgcn_global_load_lds((const unsigned*)((const char*)(gbase) + (voff)[_i]), (PG8_LAS unsigned*)(lds + (bufoff) + ldsw + _i * 8192), 16, 0, 0); } while (0)
#define PG8_LDA(dst, b, h) do { _Pragma("unroll") for (int m = 0; m < 4; ++m) _Pragma("unroll") for (int k = 0; k < 2; ++k) dst[m][k] = *(const PG8_LAS bf16x8*)(lds + PG8_SA(b, h) + aoff + m * 2048 + k * 1024); } while (0)
#define PG8_LDB(dst, b, h) do { _Pragma("unroll") for (int n = 0; n < 2; ++n) _Pragma("unroll") for (int k = 0; k < 2; ++k) dst[n][k] = *(const PG8_LAS bf16x8*)(lds + PG8_SB(b, h) + boff + n * 2048 + k * 1024); } while (0)
#define PG8_MMA(ai, bj, At, Bt) do { __builtin_amdgcn_s_setprio(1); _Pragma("unroll") for (int m = 0; m < 4; ++m) _Pragma("unroll") for (int n = 0; n < 2; ++n) _Pragma("unroll") for (int k = 0; k < 2; ++k) \
        acc[ai][bj][m][n] = __builtin_amdgcn_mfma_f32_16x16x32_bf16(Bt[n][k], At[m][k], acc[ai][bj][m][n], 0, 0, 0); __builtin_amdgcn_s_setprio(0); } while (0)
#define PG8_WAIT_V(n) asm volatile("s_waitcnt vmcnt(" #n ")" ::: "memory")
#define PG8_WAIT_L(n) asm volatile("s_waitcnt lgkmcnt(" #n ")" ::: "memory")
#define PG8_BAR __builtin_amdgcn_s_barrier()
#define PG8_SCHED __builtin_amdgcn_sched_barrier(0)
    Unit cur, nxt; int ui = 0;
    if (!S.next(0, cur)) return;
    f32x4 acc[2][2][4][2];
#pragma unroll
    for (int a = 0; a < 2; ++a)
#pragma unroll
        for (int b = 0; b < 2; ++b)
#pragma unroll
            for (int m = 0; m < 4; ++m)
#pragma unroll
                for (int n = 0; n < 2; ++n) acc[a][b][m][n] = (f32x4){0.f, 0.f, 0.f, 0.f};
    bf16x8 At[4][2], B0[2][2], B1[2][2];
    const char* cA = (const char*)g.A + (size_t)cur.pm * tstep; const char* cB = (const char*)g.Bt + (size_t)cur.pn * tstep;
    S.a_ready(cur);
    if constexpr (SP2) {
        PG8_STAGE(PG8_SB(0, 0), cB, voffB); PG8_STAGE(PG8_SB(0, 1), cB + hstep, voffB); PG8_STAGE(PG8_SA(0, 0), cA, voffA); PG8_STAGE(PG8_SA(0, 1), cA + hstep, voffA);
        if (wr == 1) PG8_BAR;
        PG8_WAIT_V(2); PG8_BAR;
        PG8_STAGE(PG8_SB(1, 0), cB + kstep, voffB); PG8_STAGE(PG8_SA(1, 0), cA + kstep, voffA); PG8_STAGE(PG8_SB(1, 1), cB + hstep + kstep, voffB);
        PG8_WAIT_V(6); PG8_BAR;
    } else {
        PG8_STAGE(PG8_SB(0, 0), cB, voffB); PG8_STAGE(PG8_SA(0, 0), cA, voffA); PG8_STAGE(PG8_SB(0, 1), cB + hstep, voffB); PG8_STAGE(PG8_SA(0, 1), cA + hstep, voffA);
        if (wr == 1) PG8_BAR;
        PG8_WAIT_V(4); PG8_BAR;
        PG8_STAGE(PG8_SB(1, 0), cB + kstep, voffB); PG8_STAGE(PG8_SA(1, 0), cA + kstep, voffA); PG8_STAGE(PG8_SB(1, 1), cB + hstep + kstep, voffB);
        PG8_WAIT_V(6); PG8_BAR;
    }
    for (;;) {
        const bool has_next = S.next(ui + 1, nxt);
        const char* nA = has_next ? (const char*)g.A + (size_t)nxt.pm * tstep : cA; const char* nB = has_next ? (const char*)g.Bt + (size_t)nxt.pn * tstep : cB;
        for (int t = 0; t < nt; t += 2) {
            const bool last = (t == nt - 2);
            const char* a1 = cA + (size_t)(t + 1) * kstep;
            const char* a2 = last ? nA : cA + (size_t)(t + 2) * kstep; const char* b2 = last ? nB : cB + (size_t)(t + 2) * kstep;
            const char* a3 = a2 + kstep; const char* b3 = b2 + kstep;
            if (last && has_next) S.a_ready(nxt);
            if constexpr (SP2) {
            PG8_LDB(B0, 0, 0); PG8_LDB(B1, 0, 1); PG8_SCHED; PG8_LDA(At, 0, 0); PG8_STAGE(PG8_SA(1, 1), a1 + hstep, voffA);
            PG8_WAIT_V(8); PG8_WAIT_L(0); PG8_BAR; PG8_MMA(0, 0, At, B0); PG8_MMA(0, 1, At, B1); PG8_BAR; PG8_SCHED;
            PG8_LDA(At, 0, 1); PG8_STAGE(PG8_SB(0, 0), b2, voffB); PG8_STAGE(PG8_SB(0, 1), b2 + hstep, voffB); PG8_STAGE(PG8_SA(0, 0), a2, voffA);
            PG8_WAIT_V(8); PG8_WAIT_L(0); PG8_BAR; PG8_MMA(1, 0, At, B0); PG8_MMA(1, 1, At, B1); PG8_BAR; PG8_SCHED;
            PG8_LDB(B0, 1, 0); PG8_LDB(B1, 1, 1); PG8_SCHED; PG8_LDA(At, 1, 0); PG8_STAGE(PG8_SA(0, 1), a2 + hstep, voffA);
            PG8_WAIT_V(8); PG8_WAIT_L(0); PG8_BAR; PG8_MMA(0, 0, At, B0); PG8_MMA(0, 1, At, B1); PG8_BAR; PG8_SCHED;
            PG8_LDA(At, 1, 1); PG8_STAGE(PG8_SB(1, 0), b3, voffB); PG8_STAGE(PG8_SB(1, 1), b3 + hstep, voffB); PG8_STAGE(PG8_SA(1, 0), a3, voffA);
            PG8_WAIT_V(8); PG8_WAIT_L(0); PG8_BAR; PG8_MMA(1, 0, At, B0); PG8_MMA(1, 1, At, B1); PG8_BAR; PG8_SCHED;
            } else {
            PG8_LDB(B0, 0, 0); PG8_SCHED; PG8_LDA(At, 0, 0); PG8_STAGE(PG8_SA(1, 1), a1 + hstep, voffA);
            PG8_WAIT_L(8); PG8_BAR; PG8_WAIT_L(0); PG8_MMA(0, 0, At, B0); PG8_BAR; PG8_SCHED;
            PG8_LDB(B1, 0, 1); PG8_STAGE(PG8_SB(0, 0), b2, voffB);
            PG8_BAR; PG8_WAIT_L(0); PG8_MMA(0, 1, At, B1); PG8_BAR;
            PG8_LDA(At, 0, 1); PG8_STAGE(PG8_SA(0, 0), a2, voffA);
            PG8_BAR; PG8_WAIT_L(0); PG8_MMA(1, 0, At, B0); PG8_BAR; PG8_SCHED;
            PG8_STAGE(PG8_SB(0, 1), b2 + hstep, voffB);
            PG8_WAIT_V(6); PG8_BAR; PG8_MMA(1, 1, At, B1); PG8_BAR;
            PG8_LDB(B0, 1, 0); PG8_SCHED; PG8_LDA(At, 1, 0); PG8_STAGE(PG8_SA(0, 1), a2 + hstep, voffA);
            PG8_WAIT_L(8); PG8_BAR; PG8_WAIT_L(0); PG8_MMA(0, 0, At, B0); PG8_BAR; PG8_SCHED;
            PG8_LDB(B1, 1, 1); PG8_STAGE(PG8_SB(1, 0), b3, voffB);
            PG8_BAR; PG8_WAIT_L(0); PG8_MMA(0, 1, At, B1); PG8_BAR;
            PG8_LDA(At, 1, 1); PG8_STAGE(PG8_SA(1, 0), a3, voffA);
            PG8_BAR; PG8_WAIT_L(0); PG8_MMA(1, 0, At, B0); PG8_BAR; PG8_SCHED;
            PG8_STAGE(PG8_SB(1, 1), b3 + hstep, voffB);
            PG8_WAIT_V(6); PG8_BAR; PG8_MMA(1, 1, At, B1); PG8_BAR;
            }
        }
        if constexpr (ALIGN_EPI) { if (wr == 0) PG8_BAR; }
        if constexpr (!Epi::AFTER_DRAIN) { E(acc, cur, wr, wc, fr, fq); S.done(cur); }
        if (!has_next) break;
#pragma unroll
        for (int a = 0; a < 2; ++a)
#pragma unroll
            for (int b = 0; b < 2; ++b)
#pragma unroll
                for (int m = 0; m < 4; ++m)
#pragma unroll
                    for (int n = 0; n < 2; ++n) acc[a][b][m][n] = (f32x4){0.f, 0.f, 0.f, 0.f};
        cur = nxt; cA = nA; cB = nB; ++ui;
        if constexpr (ALIGN_EPI) { if (wr == 1) PG8_BAR; }
    }
    PG8_WAIT_V(0);
    if constexpr (!ALIGN_EPI) { if (wr == 0) PG8_BAR; }
    PG8_BAR;
    if constexpr (Epi::AFTER_DRAIN) { E.fused(acc, cur, wr, wc, fr, fq, lds, wid, lane); S.done(cur); }
#undef PG8_SA
#undef PG8_SB
#undef PG8_STAGE
#undef PG8_LDA
#undef PG8_LDB
#undef PG8_MMA
#undef PG8_WAIT_V
#undef PG8_WAIT_L
#undef PG8_BAR
#undef PG8_SCHED
}
}

#define LAS __attribute__((address_space(3)))
typedef unsigned short bf16;
typedef float f32x4 __attribute__((ext_vector_type(4)));
typedef float f32x2 __attribute__((ext_vector_type(2)));
typedef short bf16x8 __attribute__((ext_vector_type(8)));
typedef short bf16x4 __attribute__((ext_vector_type(4)));
typedef unsigned v4u __attribute__((ext_vector_type(4)));
typedef unsigned v2u __attribute__((ext_vector_type(2)));
typedef _Float16 h2 __attribute__((ext_vector_type(2)));
typedef _Float16 h4 __attribute__((ext_vector_type(4)));
typedef _Float16 h8 __attribute__((ext_vector_type(8)));

constexpr int DM = 1024, NBATCH = 8, SEQ = 4096, CTXL = 256, DEPTH = 4, DFF = 2816, DIN = 2720, DINP = 2816;
constexpr int ML = NBATCH * SEQ, MC = NBATCH * CTXL, MA = ML + MC;
constexpr int LORA_K = 512, LORA_N = 1536;
constexpr float ALPHA = 1.681792830507429f;
constexpr float LN_EPS = 1e-6f;
constexpr int PC_GQ = 0, PC_GK = 128, PC_GV = 256, PC_GG = 512, PC_ZF = 768, PC_SQ = 800, PC_SK = 1312, PC_SV = 1440, PC_RW = 1568;
constexpr int LC_DEC = 0, LC_A = 512, LC_G = 1024, LC_LG = 1280;
constexpr int RF_R = 0, RF_K = 256, RF_V = 512, RF_KK = 768;

constexpr size_t MiB = 1u << 20;
constexpr size_t WS_STATS = 131072;
constexpr size_t WS_MOD = 1 * MiB;
constexpr size_t WS_WGU1 = 3 * MiB;
constexpr size_t WS_WD1 = WS_WGU1 + 11 * MiB;
constexpr size_t WS_WGU2 = WS_WD1 + 6 * MiB;
constexpr size_t WS_WD2 = WS_WGU2 + 11 * MiB;
constexpr size_t WS_WIN = WS_WD2 + 6 * MiB;
constexpr size_t WS_WOUT = WS_WIN + 6 * MiB;
constexpr size_t WS_WLORA = WS_WOUT + 2 * MiB;
constexpr size_t WS_XC = WS_WLORA + 2 * MiB;
constexpr size_t WS_U = WS_XC + 8 * MiB;
constexpr size_t WS_HID = WS_U + 68 * MiB;
constexpr size_t WS_LO = WS_HID + 187 * MiB;
constexpr size_t WS_RF = WS_LO + 102 * MiB;
constexpr size_t WS_YO = WS_RF + 68 * MiB;
constexpr size_t WS_KV = WS_YO + 68 * MiB;
constexpr size_t WS_ST = WS_KV + 17 * MiB;
constexpr size_t WS_DEC = WS_ST + 17 * MiB;
constexpr size_t WS_END = WS_DEC + 1 * MiB;
constexpr int LDS_BYTES = 135168;

struct Args { const float* in[31]; float* out; unsigned char* ws; };
enum { I_X = 0, I_C, I_CTX, I_CCTX, I_WADA, I_BADA, I_F1G, I_F1U, I_F1D, I_F2G, I_F2U, I_F2D, I_LNG, I_LNB, I_WIN, I_WOUT, I_GUP, I_GBIAS, I_GNORM, I_SINK,
       I_MU, I_W0, I_WUP, I_A0, I_AUP, I_GUPR, I_KK, I_KA, I_RK, I_GNG, I_GNB };

__device__ __forceinline__ unsigned f2bf(float f) { unsigned u = __builtin_bit_cast(unsigned, f); return (u + 0x7fffu + ((u >> 16) & 1u)) >> 16; }
__device__ __forceinline__ unsigned pk2(float lo, float hi) { return f2bf(lo) | (f2bf(hi) << 16); }
__device__ __forceinline__ float bf2f(unsigned short u) { return __builtin_bit_cast(float, (unsigned)u << 16); }
__device__ __forceinline__ float bflo(unsigned u) { return __builtin_bit_cast(float, u << 16); }
__device__ __forceinline__ float bfhi(unsigned u) { return __builtin_bit_cast(float, u & 0xffff0000u); }
__device__ __forceinline__ float sigmoidf_(float x) { return 1.0f / (1.0f + __expf(-x)); }
__device__ __forceinline__ int otid() { int t = threadIdx.x; asm volatile("" : "+v"(t)); return t; }
__device__ __forceinline__ int obid() { int t = blockIdx.x; asm volatile("" : "+s"(t)); return t; }
__device__ __forceinline__ int ogdim() { int t = gridDim.x; asm volatile("" : "+s"(t)); return t; }
#define LDS_WAIT() asm volatile("s_waitcnt lgkmcnt(0)" ::: "memory")
template <int CTRL> __device__ __forceinline__ float dpp_f(float x) { return __builtin_bit_cast(float, __builtin_amdgcn_update_dpp(0, __builtin_bit_cast(int, x), CTRL, 0xF, 0xF, false)); }
__device__ __forceinline__ float allred16(float x) {
    x += dpp_f<0x128>(x); x += dpp_f<0x124>(x); x += dpp_f<0x122>(x); x += dpp_f<0x121>(x); return x;
}
__device__ __forceinline__ float wave_sum(float v) {
#pragma unroll
    for (int o = 1; o < 64; o <<= 1) v += __shfl_xor(v, o);
    return v;
}

__device__ __forceinline__ void phase_adaln(const Args& a, float* MOD, LAS unsigned char* lds) {
    LAS float* s = (LAS float*)lds;
    LAS float* red = s + 9 * 1024;
    const int tid = otid();
    for (int i = tid; i < 9 * 1024; i += 512) { const int bi = i >> 10, k = i & 1023; const float c = bi < 8 ? a.in[I_C][bi * 1024 + k] : a.in[I_CCTX][k]; s[i] = c * sigmoidf_(c); }
    __syncthreads();
    for (int unit = obid(); unit < 288; unit += ogdim()) {
        const int l = unit / 72, cb = unit % 72, col = cb * 128 + (tid & 127), kq = tid >> 7;
        const float* w = a.in[I_WADA] + (size_t)l * 1024 * 9216 + col;
        float acc[9];
#pragma unroll
        for (int bi = 0; bi < 9; ++bi) acc[bi] = 0.f;
#pragma unroll 8
        for (int k = kq * 256; k < kq * 256 + 256; ++k) { const float wv = w[(size_t)k * 9216];
#pragma unroll
            for (int bi = 0; bi < 9; ++bi) acc[bi] += s[bi * 1024 + k] * wv; }
#pragma unroll
        for (int bi = 0; bi < 9; ++bi) red[tid * 9 + bi] = acc[bi];
        __syncthreads();
        if (kq == 0) { const float bb = a.in[I_BADA][l * 9216 + col];
#pragma unroll
            for (int bi = 0; bi < 9; ++bi) { const float v = red[tid * 9 + bi] + red[(tid + 128) * 9 + bi] + red[(tid + 256) * 9 + bi] + red[(tid + 384) * 9 + bi] + bb;
                MOD[(size_t)(l * 9 + bi) * 9216 + col] = v; } }
        __syncthreads();
    }
}

__device__ __forceinline__ void transpose_item(const float* W, int K, int N, bf16* WT, int kb, int nb, int drow0, LAS float* scr, int lane) {
    const int k0 = 64 * kb, n0 = 32 * nb;
#pragma unroll 8
    for (int i = 0; i < 32; ++i) { const int kk = 2 * i + (lane >> 5); scr[kk * 33 + (lane & 31)] = W[(size_t)(k0 + kk) * N + n0 + (lane & 31)]; }
    LDS_WAIT(); asm volatile("" ::: "memory");
    const int c = lane & 7;
#pragma unroll
    for (int j = 0; j < 4; ++j) { const int n = (lane >> 3) + 8 * j; const LAS float* sp = scr + (8 * c) * 33 + n;
        v4u o; o.x = pk2(sp[0 * 33], sp[1 * 33]); o.y = pk2(sp[2 * 33], sp[3 * 33]); o.z = pk2(sp[4 * 33], sp[5 * 33]); o.w = pk2(sp[6 * 33], sp[7 * 33]);
        *(v4u*)(WT + (size_t)(drow0 + n) * K + k0 + 8 * c) = o; }
    LDS_WAIT(); asm volatile("" ::: "memory");
}
__device__ __forceinline__ void phase_convert(const Args& a, int l, unsigned char* ws, LAS unsigned char* lds) {
    const int tid = otid(), lane = tid & 63, wave = __builtin_amdgcn_readfirstlane(tid >> 6);
    LAS float* scr = (LAS float*)(lds + wave * 8704);
    const int gw = obid() * 8 + wave, NGW = ogdim() * 8;
    constexpr int I_GU = 16 * 88, I_D = 44 * 32, I_IN = 16 * 85, I_OUT = 16 * 32;
    constexpr int NIT = 4 * I_GU + 2 * I_D + I_IN + I_OUT;
    for (int it = gw; it < NIT; it += NGW) {
        int r = it;
        if (r < 4 * I_GU) { const int which = r / I_GU; r -= which * I_GU; const int kb = r / 88, nb = r % 88;
            const float* W = a.in[which == 0 ? I_F1G : which == 1 ? I_F1U : which == 2 ? I_F2G : I_F2U] + (size_t)l * 1024 * DFF;
            bf16* WT = (bf16*)(ws + (which < 2 ? WS_WGU1 : WS_WGU2));
            const int n0 = 32 * nb, drow0 = (n0 >> 7) * 256 + (which & 1) * 128 + (n0 & 127);
            transpose_item(W, 1024, DFF, WT, kb, nb, drow0, scr, lane); continue; }
        r -= 4 * I_GU;
        if (r < 2 * I_D) { const int which = r / I_D; r -= which * I_D; const int kb = r / 32, nb = r % 32;
            const float* W = a.in[which == 0 ? I_F1D : I_F2D] + (size_t)l * DFF * 1024;
            transpose_item(W, DFF, 1024, (bf16*)(ws + (which == 0 ? WS_WD1 : WS_WD2)), kb, nb, 32 * nb, scr, lane); continue; }
        r -= 2 * I_D;
        if (r < I_IN) { const int kb = r / 85, nb = r % 85;
            transpose_item(a.in[I_WIN] + (size_t)l * 1024 * DIN, 1024, DIN, (bf16*)(ws + WS_WIN), kb, nb, 32 * nb, scr, lane); continue; }
        r -= I_IN;
        { const int kb = r / 32, nb = r % 32; transpose_item(a.in[I_WOUT] + (size_t)l * 1024 * 1024, 1024, 1024, (bf16*)(ws + WS_WOUT), kb, nb, 32 * nb, scr, lane); }
    }
    const int gt = obid() * 512 + tid, NGT = ogdim() * 512;
    for (int i = gt; i < 96 * 1024 / 8; i += NGT) *(v4u*)((bf16*)(ws + WS_WIN) + (size_t)DIN * 1024 + (size_t)i * 8) = (v4u){0u, 0u, 0u, 0u};
    const float* wup = a.in[I_WUP] + (size_t)l * 2 * 64 * 256; const float* aup = a.in[I_AUP] + (size_t)l * 2 * 64 * 256;
    const float* gup = a.in[I_GUPR] + (size_t)l * 128 * 256; const float* ggu = a.in[I_GUP] + (size_t)l * 2 * 16 * 128;
    for (int ci = gt; ci < LORA_N * LORA_K / 8; ci += NGT) {
        const int n = ci >> 6, k8 = (ci & 63) * 8; float v[8];
#pragma unroll
        for (int e = 0; e < 8; ++e) v[e] = 0.f;
        const float* src = nullptr; int stride = 0;
        if (n < 256)       { if (k8 < 64)                 { src = wup + (size_t)k8 * 256 + n; stride = 256; } }
        else if (n < 512)  { if (k8 >= 64 && k8 < 128)    { src = wup + 64 * 256 + (size_t)(k8 - 64) * 256 + (n - 256); stride = 256; } }
        else if (n < 768)  { if (k8 >= 128 && k8 < 192)   { src = aup + (size_t)(k8 - 128) * 256 + (n - 512); stride = 256; } }
        else if (n < 1024) { if (k8 >= 192 && k8 < 256)   { src = aup + 64 * 256 + (size_t)(k8 - 192) * 256 + (n - 768); stride = 256; } }
        else if (n < 1280) { if (k8 >= 256 && k8 < 384)   { src = gup + (size_t)(k8 - 256) * 256 + (n - 1024); stride = 256; } }
        else if (n < 1408) { if (k8 >= 384 && k8 < 400)   { src = ggu + (size_t)(k8 - 384) * 128 + (n - 1280); stride = 128; } }
        else               { if (k8 >= 400 && k8 < 416)   { src = ggu + 16 * 128 + (size_t)(k8 - 400) * 128 + (n - 1408); stride = 128; } }
        if (src) {
#pragma unroll
            for (int e = 0; e < 8; ++e) v[e] = src[(size_t)e * stride]; }
        v4u o; o.x = pk2(v[0], v[1]); o.y = pk2(v[2], v[3]); o.z = pk2(v[4], v[5]); o.w = pk2(v[6], v[7]);
        *(v4u*)((bf16*)(ws + WS_WLORA) + (size_t)n * LORA_K + k8) = o;
    }
}

__device__ __forceinline__ float* xrow_ptr(float* xlat, float* xctx, int row) { return row < ML ? xlat + (size_t)row * 1024 : xctx + (size_t)(row - ML) * 1024; }
__device__ __forceinline__ int row_bi(int row) { return row < ML ? (row >> 12) : 8; }

__device__ __forceinline__ void phase_mod0(const Args& a, const float* MOD, bf16* U) {
    const int lane = otid() & 63, gw = obid() * 8 + (otid() >> 6), NGW = ogdim() * 8;
    for (int row = gw; row < MA; row += NGW) {
        const float* xr = row < ML ? a.in[I_X] + (size_t)row * 1024 : a.in[I_CTX] + (size_t)(row - ML) * 1024;
        const float* mp = MOD + (size_t)row_bi(row) * 9216;
#pragma unroll
        for (int j = 0; j < 4; ++j) { const int c = 4 * lane + 256 * j; const f32x4 v = *(const f32x4*)(xr + c), sh = *(const f32x4*)(mp + c), sc = *(const f32x4*)(mp + 1024 + c);
            const f32x4 o = v * (sc + 1.0f) + sh; v2u w; w.x = pk2(o.x, o.y); w.y = pk2(o.z, o.w); *(v2u*)(U + (size_t)row * 1024 + c) = w; }
    }
}
__device__ __forceinline__ void phase_ln(float* xlat, float* xctx, const float* lng, const float* lnb, const float* modn, bf16* U, int nrows, bool write_u, float* stats, bool write_x) {
    const int lane = otid() & 63, gw = obid() * 8 + (otid() >> 6), NGW = ogdim() * 8;
    for (int row = gw; row < nrows; row += NGW) {
        float* xr = xrow_ptr(xlat, xctx, row);
        f32x4 v[4]; float s = 0.f;
#pragma unroll
        for (int j = 0; j < 4; ++j) { v[j] = *(const f32x4*)(xr + 4 * lane + 256 * j); s += (v[j].x + v[j].y) + (v[j].z + v[j].w); }
        const float mean = wave_sum(s) * (1.0f / 1024.0f); float s2 = 0.f;
#pragma unroll
        for (int j = 0; j < 4; ++j) { v[j] = v[j] - mean; s2 += (v[j].x * v[j].x + v[j].y * v[j].y) + (v[j].z * v[j].z + v[j].w * v[j].w); }
        const float rstd = 1.0f / sqrtf(wave_sum(s2) * (1.0f / 1024.0f) + LN_EPS);
        const float* mp = modn + (size_t)row_bi(row) * 9216;
        if (lane == 0) *(f32x2*)(stats + 2 * (size_t)row) = (f32x2){mean, rstd};
#pragma unroll
        for (int j = 0; j < 4; ++j) { const int c = 4 * lane + 256 * j; const f32x4 h = v[j] * rstd * *(const f32x4*)(lng + c) + *(const f32x4*)(lnb + c);
            if (write_x) *(f32x4*)(xr + c) = h;
            if (write_u) { const f32x4 sh = *(const f32x4*)(mp + c), sc = *(const f32x4*)(mp + 1024 + c); const f32x4 o = h * (sc + 1.0f) + sh;
                v2u w; w.x = pk2(o.x, o.y); w.y = pk2(o.z, o.w); *(v2u*)(U + (size_t)row * 1024 + c) = w; } }
    }
}

__device__ __forceinline__ void phase_features(const Args& a, int l, bf16* P, _Float16* RF, bf16* AP, LAS unsigned char* lds) {
    LAS f32x2* tab = (LAS f32x2*)lds;
    const int tid = otid(), lane = tid & 63;
    for (int i = tid; i < 1024; i += 512) { const int pos = i >> 4, fi = i & 15; const float inv = exp2f(-(float)fi * (13.287712379549449f / 16.0f)); const float ang = (float)pos * inv;
        tab[i] = (f32x2){cosf(ang), sinf(ang)}; }
    __syncthreads();
    const float* mu = a.in[I_MU] + l * 1152; const float* kkw = a.in[I_KK] + l * 256;
    const int gw = obid() * 8 + (tid >> 6), NGW = ogdim() * 8;
    for (int row = gw; row < MA; row += NGW) {
        const bool lat = row < ML; const int t = lat ? (row & 4095) : ((row - ML) & 255); const int len = lat ? SEQ : CTXL;
        bf16* pr = P + (size_t)row * DINP;
        const float hp = t > 0 ? 0.5f : 0.f, hn = t < len - 1 ? 0.5f : 0.f;
        const bf16* rw = pr + PC_RW; const bf16* rwp = t > 0 ? rw - DINP : rw; const bf16* rwn = t < len - 1 ? rw + DINP : rw;
        _Float16* rf = RF + (size_t)row * 1024; bf16* ap = AP + (size_t)row * LORA_K;
#pragma unroll
        for (int j = 0; j < 9; ++j) {
            const int col = 2 * (lane + 64 * j);
            const unsigned uc = *(const unsigned*)(rw + col), up = *(const unsigned*)(rwp + col), un = *(const unsigned*)(rwn + col);
            const f32x2 m2 = *(const f32x2*)(mu + col);
            const float c0 = bflo(uc), c1 = bfhi(uc);
            const float f0 = c0 + m2.x * (hp * bflo(up) + hn * bflo(un) - c0), f1 = c1 + m2.y * (hp * bfhi(up) + hn * bfhi(un) - c1);
            if (j < 2) { *(h2*)(rf + RF_R + col) = (h2){(_Float16)f0, (_Float16)f1}; }
            else if (j < 4) { const int kc = col - 256; *(h2*)(rf + RF_K + kc) = (h2){(_Float16)f0, (_Float16)f1};
                const f32x2 kw = *(const f32x2*)(kkw + kc); const float q0 = f0 * kw.x, q1 = f1 * kw.y; float ss = q0 * q0 + q1 * q1;
#pragma unroll
                for (int o = 1; o < 32; o <<= 1) ss += __shfl_xor(ss, o);
                const float inv = 1.0f / fmaxf(sqrtf(ss), 1e-12f);
                *(h2*)(rf + RF_KK + kc) = (h2){(_Float16)(q0 * inv), (_Float16)(q1 * inv)}; }
            else if (j < 6) { *(h2*)(rf + RF_V + (col - 512)) = (h2){(_Float16)f0, (_Float16)f1}; }
            else if (j == 6) { *(unsigned*)(ap + (col - 768)) = pk2(tanhf(f0), tanhf(f1)); }
            else if (j == 7) { *(unsigned*)(ap + 128 + (col - 896)) = pk2(f0, f1); }
            else { *(unsigned*)(ap + 256 + (col - 1024)) = pk2(sigmoidf_(f0), sigmoidf_(f1)); }
        }
        { unsigned z = 0u; if (lane < 16) z = *(const unsigned*)(pr + PC_ZF + 2 * lane); *(unsigned*)(ap + 384 + 2 * lane) = z; }
#pragma unroll
        for (int j = 0; j < 5; ++j) {
            const int head = 2 * j + (lane >> 5), pi = lane & 31, fi = pi & 15;
            const int d1 = pi < 16 ? pi : 16 + pi, pos = pi < 16 ? (t >> 6) : (t & 63);
            bf16* hb = pr + (head < 8 ? PC_SQ + head * 64 : PC_SK + (head - 8) * 64);
            const float x1 = bf2f(hb[d1]), x2 = bf2f(hb[d1 + 16]);
            float o1 = x1, o2 = x2;
            if (lat) { const f32x2 cs = tab[pos * 16 + fi]; o1 = x1 * cs.x - x2 * cs.y; o2 = x1 * cs.y + x2 * cs.x; }
            if (head < 8) { o1 *= 0.125f; o2 *= 0.125f; }
            if (lat || head < 8) { hb[d1] = (bf16)f2bf(o1); hb[d1 + 16] = (bf16)f2bf(o2); }
        }
    }
}

__device__ __forceinline__ void phase_rwkv(const Args& a, int l, const _Float16* RF, const _Float16* LO, _Float16* YO, LAS unsigned char* lds) {
    constexpr int T = 32, SF = 336, NCH = (CTXL + SEQ) / T;
    LAS float* buf = (LAS float*)lds; LAS float* ybuf = buf + 2 * T * SF;
    const int tid = otid(), wave = __builtin_amdgcn_readfirstlane(tid >> 6), lane = tid & 63;
    for (int unit = obid(); unit < 256; unit += ogdim()) {
        const int chain = unit >> 2, rq = unit & 3, b = chain >> 3, h = (chain >> 1) & 3, dir = chain & 1;
        _Float16* Y = YO + (size_t)dir * MA * 256;
        const int ltid = tid - 256, lstep = ltid >> 3, lkq = ltid & 7, cols = h * 64 + 8 * lkq;
        float ka[8];
        if (wave >= 4) {
#pragma unroll
            for (int e = 0; e < 8; ++e) ka[e] = a.in[I_KA][l * 256 + cols + e]; }
        auto step_row = [&](int s) -> int { if (s < CTXL) return ML + b * CTXL + (dir ? CTXL - 1 - s : s); const int tq = s - CTXL; return b * SEQ + (dir ? SEQ - 1 - tq : tq); };
        h8 s0r, s0k, s0v, s0q, s0w, s0a, s1r, s1k, s1v, s1q, s1w, s1a, s2r, s2k, s2v, s2q, s2w, s2a;
#define RW_LOAD(c, R8, K8, V8, Q8, W8, A8) do { const int row_ = step_row((c) * T + lstep); \
            const _Float16* rf_ = RF + (size_t)row_ * 1024 + cols; const _Float16* lo_ = LO + (size_t)row_ * 1536 + dir * 256 + cols; \
            R8 = *(const h8*)(rf_ + RF_R); K8 = *(const h8*)(rf_ + RF_K); V8 = *(const h8*)(rf_ + RF_V); Q8 = *(const h8*)(rf_ + RF_KK); \
            W8 = *(const h8*)(lo_ + LC_DEC); A8 = *(const h8*)(lo_ + LC_A); } while (0)
#define RW_WRITE(c, R8, K8, V8, Q8, W8, A8) do { LAS float* d_ = buf + ((c) & 1) * T * SF + lstep * SF + 8 * lkq; \
            _Pragma("unroll") for (int e = 0; e < 8; ++e) { const float kk_ = (float)Q8[e], av_ = (float)A8[e], kv_ = (float)K8[e]; \
                d_[e] = kk_; d_[64 + e] = (float)W8[e]; d_[128 + e] = kk_ * av_; d_[192 + e] = kv_ * (1.0f + (av_ - 1.0f) * ka[e]); d_[256 + e] = (float)R8[e]; } \
            if ((lkq >> 1) == rq) { LAS float* dv_ = buf + ((c) & 1) * T * SF + lstep * SF + 320 + (lkq & 1) * 8; \
                _Pragma("unroll") for (int e = 0; e < 8; ++e) dv_[e] = (float)V8[e]; } } while (0)
        auto flush_y = [&](int c) {
            const int row = step_row(c * T + lstep);
            const LAS float* yb = ybuf + (c & 1) * T * 16 + lstep * 16 + 2 * lkq;
            *(h2*)(Y + (size_t)row * 256 + h * 64 + rq * 16 + 2 * lkq) = (h2){(_Float16)yb[0], (_Float16)yb[1]};
        };
        f32x4 S = (f32x4){0.f, 0.f, 0.f, 0.f};
        const int kg = lane & 15, ri = wave * 4 + (lane >> 4);
#define RW_BAR() do { asm volatile("s_waitcnt lgkmcnt(0)" ::: "memory"); __builtin_amdgcn_s_barrier(); asm volatile("" ::: "memory"); } while (0)
#define LSET(c, P) RW_LOAD(c, P##r, P##k, P##v, P##q, P##w, P##a)
#define WSET(c, P) RW_WRITE(c, P##r, P##k, P##v, P##q, P##w, P##a)
        if (wave >= 4) {
            LSET(0, s0); WSET(0, s0); LSET(1, s1); LSET(2, s2);
            RW_BAR();
            for (int c = 0; c < NCH; c += 3) {
                if (c + 3 < NCH) LSET(c + 3, s0);
                if (c + 1 < NCH) WSET(c + 1, s1);
                if (c > 0) flush_y(c - 1);
                RW_BAR();
                if (c + 1 < NCH) {
                    if (c + 4 < NCH) LSET(c + 4, s1);
                    if (c + 2 < NCH) WSET(c + 2, s2);
                    flush_y(c);
                    RW_BAR();
                }
                if (c + 2 < NCH) {
                    if (c + 5 < NCH) LSET(c + 5, s2);
                    if (c + 3 < NCH) WSET(c + 3, s0);
                    flush_y(c + 1);
                    RW_BAR();
                }
            }
        } else {
            RW_BAR();
            for (int c = 0; c < NCH; ++c) {
                const LAS float* bc = buf + (c & 1) * T * SF + 4 * kg; const LAS float* vb = buf + (c & 1) * T * SF + 320 + ri;
                LAS float* yw = (kg == 0) ? (ybuf + (c & 1) * T * 16 + ri) : (ybuf + 2 * T * 16 + lane);
                f32x4 Akk, Aw, Ab, Akd, Ar, Bkk, Bw, Bb, Bkd, Br, Ckk, Cw, Cb, Ckd, Cr; float Av, Bv, Cv;
                const unsigned bca = (unsigned)(uintptr_t)bc, vba = (unsigned)(uintptr_t)vb, ywa = (unsigned)(uintptr_t)yw;
#define RW_LD(X, s_) asm volatile("ds_read_b128 %0, %7 offset:%9\n\tds_read_b128 %1, %7 offset:%10\n\tds_read_b128 %2, %7 offset:%11\n\tds_read_b128 %3, %7 offset:%12\n\tds_read_b128 %4, %7 offset:%13\n\tds_read_b32 %5, %8 offset:%9" \
                    : "=&v"(X##kk), "=&v"(X##w), "=&v"(X##b), "=&v"(X##kd), "=&v"(X##r), "=&v"(X##v), "+v"(S) : "v"(bca), "v"(vba), "n"((s_) * SF * 4), "n"((s_) * SF * 4 + 256), "n"((s_) * SF * 4 + 512), "n"((s_) * SF * 4 + 768), "n"((s_) * SF * 4 + 1024))
#define RW_WAIT(X) asm volatile("s_waitcnt lgkmcnt(0)" : "+v"(X##kk), "+v"(X##w), "+v"(X##b), "+v"(X##kd), "+v"(X##r), "+v"(X##v), "+v"(S))
#define RW_YW(s_, Y_) asm volatile("ds_write_b32 %0, %1 offset:%2" :: "v"(ywa), "v"(Y_), "n"((s_) * 64) : "memory")
#define RW_DOT(V_, W_) ((V_.x * W_.x + V_.y * W_.y) + (V_.z * W_.z + V_.w * W_.w))
#define RW_BODY(s_, X, Xn, Xnn, Xp) do { if ((s_) < T) { float yp_ = 0.f; \
                    if ((s_) > 0) yp_ = allred16(RW_DOT(S, Xp##r)); \
                    const f32x4 u_ = S * X##w + X##kd * X##v; const float sa_ = allred16(RW_DOT(S, X##kk)); S = u_ - X##b * sa_; \
                    if ((s_) + 1 < T) RW_WAIT(Xn); if ((s_) > 0) RW_YW((s_) - 1, yp_); if ((s_) + 2 < T) RW_LD(Xnn, (s_) + 2); } } while (0)
                RW_LD(A, 0); RW_LD(B, 1); RW_WAIT(A);
#pragma unroll
                for (int s = 0; s < T + 2; s += 3) { RW_BODY(s, A, B, C, C); RW_BODY(s + 1, B, C, A, A); RW_BODY(s + 2, C, A, B, B); }
                { const float yl_ = allred16(RW_DOT(S, Br)); RW_YW(T - 1, yl_); }
                static_assert(T == 32, "the tail above assumes (T - 1) % 3 == 1");
#undef RW_WAIT
#undef RW_YW
#undef RW_LD
#undef RW_DOT
#undef RW_BODY
                RW_BAR();
            }
        }
#undef LSET
#undef WSET
#undef RW_BAR
        if (wave >= 4) flush_y(NCH - 1);
        __syncthreads();
    }
#undef RW_LOAD
#undef RW_WRITE
}

template <int CTRL> __device__ __forceinline__ float dpp0_f(float x) { return __builtin_bit_cast(float, __builtin_amdgcn_update_dpp(0, __builtin_bit_cast(int, x), CTRL, 0xF, 0xF, true)); }
__device__ __forceinline__ void phase_gla_a(int l, bf16* P, const _Float16* LO, _Float16* YO, _Float16* KV, float* DEC, LAS unsigned char* lds) {
    LAS bf16* Vt = (LAS bf16*)lds;
    LAS bf16* KhT = Vt + 4 * 64 * 72;
    const int tid = otid(), wave = __builtin_amdgcn_readfirstlane(tid >> 6), lane = tid & 63, r = lane & 15, kq = lane >> 4, h = wave >> 1, dir = wave & 1;
    LAS bf16* Vh = Vt + h * 64 * 72; LAS bf16* Kw = KhT + wave * 32 * 72;
    for (int unit = obid(); unit < 544; unit += ogdim()) {
        const int b = unit / 68, cc = unit % 68; const int row0 = cc < 4 ? ML + b * CTXL + cc * 64 : b * SEQ + (cc - 4) * 64;
        const int u = ((b * 4 + h) * 2 + dir) * 68 + cc;
        __syncthreads();
        {   const int j = tid >> 3, c8 = tid & 7; const bf16* src = P + (size_t)(row0 + j) * DINP + PC_GV;
#pragma unroll
            for (int q = 0; q < 4; ++q) { const int col = 8 * (c8 + 8 * q); const v4u v8 = *(const v4u*)(src + col);
                LAS bf16* vd = Vt + (col >> 6) * 64 * 72 + (col & 63) * 72 + j;
                vd[0 * 72] = (bf16)(v8.x & 0xffffu); vd[1 * 72] = (bf16)(v8.x >> 16); vd[2 * 72] = (bf16)(v8.y & 0xffffu); vd[3 * 72] = (bf16)(v8.y >> 16);
                vd[4 * 72] = (bf16)(v8.z & 0xffffu); vd[5 * 72] = (bf16)(v8.z >> 16); vd[6 * 72] = (bf16)(v8.w & 0xffffu); vd[7 * 72] = (bf16)(v8.w >> 16); } }
        v4u q8[4], k8[4]; h8 g8[4];
#pragma unroll
        for (int ib = 0; ib < 4; ++ib) { const size_t row = (size_t)(row0 + 16 * ib + r);
            q8[ib] = *(const v4u*)(P + row * DINP + PC_GQ + h * 32 + 8 * kq); k8[ib] = *(const v4u*)(P + row * DINP + PC_GK + h * 32 + 8 * kq);
            g8[ib] = *(const h8*)(LO + row * 1536 + LC_LG + dir * 128 + h * 32 + 8 * kq); }
        __syncthreads();
        float pre[4][8], G[8];
#pragma unroll
        for (int e = 0; e < 8; ++e) { float carry = 0.f;
#pragma unroll
            for (int ib = 0; ib < 4; ++ib) { const float g = (float)g8[ib][e]; float x = g;
                x += dpp0_f<0x111>(x); x += dpp0_f<0x112>(x); x += dpp0_f<0x114>(x); x += dpp0_f<0x118>(x);
                pre[ib][e] = x + carry; carry += allred16(g); }
            G[e] = carry; }
        bf16x8 qf[4], kf[4];
#pragma unroll
        for (int ib = 0; ib < 4; ++ib) { float qs[8], ks[8], kh[8];
            const unsigned qu[4] = {q8[ib].x, q8[ib].y, q8[ib].z, q8[ib].w}, ku[4] = {k8[ib].x, k8[ib].y, k8[ib].z, k8[ib].w};
#pragma unroll
            for (int e = 0; e < 8; ++e) { const float qv = (e & 1) ? bfhi(qu[e >> 1]) : bflo(qu[e >> 1]), kv = (e & 1) ? bfhi(ku[e >> 1]) : bflo(ku[e >> 1]);
                const float bb = dir ? (G[e] - pre[ib][e] + (float)g8[ib][e]) : pre[ib][e];
                qs[e] = qv * 0.17677669529663687f * __expf(bb); ks[e] = kv * __expf(-bb); kh[e] = kv * __expf(G[e] - bb);
                Kw[(8 * kq + e) * 72 + 16 * ib + r] = (bf16)f2bf(kh[e]); }
            v4u qw, kw; qw.x = pk2(qs[0], qs[1]); qw.y = pk2(qs[2], qs[3]); qw.z = pk2(qs[4], qs[5]); qw.w = pk2(qs[6], qs[7]);
            kw.x = pk2(ks[0], ks[1]); kw.y = pk2(ks[2], ks[3]); kw.z = pk2(ks[4], ks[5]); kw.w = pk2(ks[6], ks[7]);
            qf[ib] = __builtin_bit_cast(bf16x8, qw); kf[ib] = __builtin_bit_cast(bf16x8, kw);
            *(v4u*)(P + (size_t)(row0 + 16 * ib + r) * DINP + (dir ? PC_GK : PC_GQ) + h * 32 + 8 * kq) = qw; }
        if (r == 0) {
#pragma unroll
            for (int e = 0; e < 8; ++e) DEC[(size_t)u * 32 + 8 * kq + e] = __expf(G[e]); }
        LDS_WAIT(); asm volatile("" ::: "memory");
#pragma unroll
        for (int ib = 0; ib < 4; ++ib) {
            f32x4 oT[4];
#pragma unroll
            for (int eb = 0; eb < 4; ++eb) oT[eb] = (f32x4){0.f, 0.f, 0.f, 0.f};
#pragma unroll
            for (int kk = 0; kk < 2; ++kk) {
                const bool any = dir ? (2 * kk + 1 >= ib) : (2 * kk <= ib);
                if (any) {
                    f32x4 sb[2];
#pragma unroll
                    for (int x = 0; x < 2; ++x) { const int jb = 2 * kk + x; sb[x] = (f32x4){0.f, 0.f, 0.f, 0.f};
                        const bool need = dir ? (jb >= ib) : (jb <= ib);
                        if (need) { sb[x] = __builtin_amdgcn_mfma_f32_16x16x32_bf16(kf[jb], qf[ib], sb[x], 0, 0, 0);
                            if (jb == ib) {
#pragma unroll
                                for (int reg = 0; reg < 4; ++reg) { const int jj = 4 * kq + reg; const bool keep = dir ? (jj >= r) : (jj <= r); if (!keep) sb[x][reg] = 0.f; } } } }
                    v4u pw; pw.x = pk2(sb[0][0], sb[0][1]); pw.y = pk2(sb[0][2], sb[0][3]); pw.z = pk2(sb[1][0], sb[1][1]); pw.w = pk2(sb[1][2], sb[1][3]);
                    const bf16x8 pf = __builtin_bit_cast(bf16x8, pw);
#pragma unroll
                    for (int eb = 0; eb < 4; ++eb) { const LAS bf16* vp = Vh + (16 * eb + r) * 72 + 32 * kk + 4 * kq;
                        const v2u va = *(const LAS v2u*)vp, vb = *(const LAS v2u*)(vp + 16);
                        const bf16x8 vf = __builtin_bit_cast(bf16x8, (v4u){va.x, va.y, vb.x, vb.y});
                        oT[eb] = __builtin_amdgcn_mfma_f32_16x16x32_bf16(vf, pf, oT[eb], 0, 0, 0); }
                }
            }
            _Float16* op = YO + ((size_t)(2 + dir) * MA + row0 + 16 * ib + r) * 256 + h * 64 + 4 * kq;
#pragma unroll
            for (int eb = 0; eb < 4; ++eb) *(h4*)(op + 16 * eb) = (h4){(_Float16)oT[eb][0], (_Float16)oT[eb][1], (_Float16)oT[eb][2], (_Float16)oT[eb][3]};
        }
        f32x4 kvt[4][2];
#pragma unroll
        for (int eb = 0; eb < 4; ++eb) { kvt[eb][0] = (f32x4){0.f, 0.f, 0.f, 0.f}; kvt[eb][1] = (f32x4){0.f, 0.f, 0.f, 0.f}; }
#pragma unroll
        for (int kk = 0; kk < 2; ++kk) {
            bf16x8 bfr[2];
#pragma unroll
            for (int nb = 0; nb < 2; ++nb) bfr[nb] = *(const LAS bf16x8*)(Kw + (16 * nb + r) * 72 + 32 * kk + 8 * kq);
#pragma unroll
            for (int eb = 0; eb < 4; ++eb) { const bf16x8 afr = *(const LAS bf16x8*)(Vh + (16 * eb + r) * 72 + 32 * kk + 8 * kq);
                kvt[eb][0] = __builtin_amdgcn_mfma_f32_16x16x32_bf16(afr, bfr[0], kvt[eb][0], 0, 0, 0);
                kvt[eb][1] = __builtin_amdgcn_mfma_f32_16x16x32_bf16(afr, bfr[1], kvt[eb][1], 0, 0, 0); } }
        _Float16* kvp = KV + (size_t)u * 2048;
#pragma unroll
        for (int eb = 0; eb < 4; ++eb)
#pragma unroll
            for (int nb = 0; nb < 2; ++nb)
#pragma unroll
                for (int reg = 0; reg < 4; ++reg) kvp[(16 * eb + 4 * kq + reg) * 32 + 16 * nb + r] = (_Float16)kvt[eb][nb][reg];
    }
}
__device__ __forceinline__ void phase_gla_b(const _Float16* KV, const float* DEC, bf16* ST) {
    for (int g = obid() * 512 + otid(); g < 64 * 2048; g += ogdim() * 512) {
        const int chain = g >> 11, idx = g & 2047, d = idx & 31, dir = chain & 1;
        float S = 0.f;
#pragma unroll 1
        for (int s0 = 0; s0 < 68; s0 += 17) {
            float kvv[17], dc[17]; int uu[17];
#pragma unroll
            for (int x = 0; x < 17; ++x) { const int step = s0 + x; const int cc = dir ? (step < 4 ? 3 - step : 71 - step) : step; uu[x] = chain * 68 + cc;
                kvv[x] = (float)KV[(size_t)uu[x] * 2048 + idx]; dc[x] = DEC[(size_t)uu[x] * 32 + d]; }
#pragma unroll
            for (int x = 0; x < 17; ++x) { ST[(size_t)uu[x] * 2048 + idx] = (bf16)f2bf(S); S = dc[x] * S + kvv[x]; }
        }
    }
}
__device__ __forceinline__ void phase_gla_c(const bf16* P, const bf16* ST, _Float16* YO) {
    const int tid = otid(), wave = __builtin_amdgcn_readfirstlane(tid >> 6), lane = tid & 63, r = lane & 15, kq = lane >> 4, h = wave >> 1, dir = wave & 1;
    for (int unit = obid(); unit < 544; unit += ogdim()) {
        const int b = unit / 68, cc = unit % 68; const int row0 = cc < 4 ? ML + b * CTXL + cc * 64 : b * SEQ + (cc - 4) * 64;
        const int u = ((b * 4 + h) * 2 + dir) * 68 + cc;
        bf16x8 af[4];
#pragma unroll
        for (int eb = 0; eb < 4; ++eb) af[eb] = *(const bf16x8*)(ST + (size_t)u * 2048 + (16 * eb + r) * 32 + 8 * kq);
#pragma unroll
        for (int ib = 0; ib < 4; ++ib) {
            const bf16x8 qf = *(const bf16x8*)(P + (size_t)(row0 + 16 * ib + r) * DINP + (dir ? PC_GK : PC_GQ) + h * 32 + 8 * kq);
            _Float16* op = YO + ((size_t)(2 + dir) * MA + row0 + 16 * ib + r) * 256 + h * 64 + 4 * kq;
#pragma unroll
            for (int eb = 0; eb < 4; ++eb) { f32x4 acc = (f32x4){0.f, 0.f, 0.f, 0.f};
                acc = __builtin_amdgcn_mfma_f32_16x16x32_bf16(af[eb], qf, acc, 0, 0, 0);
                const h4 old = *(const h4*)(op + 16 * eb);
                *(h4*)(op + 16 * eb) = (h4){(_Float16)((float)old[0] + acc[0]), (_Float16)((float)old[1] + acc[1]), (_Float16)((float)old[2] + acc[2]), (_Float16)((float)old[3] + acc[3])}; }
        }
    }
}

__device__ __forceinline__ void phase_swa(const Args& a, int l, const bf16* P, bf16* MIX, bool with_ctx, LAS unsigned char* lds) {
    LAS bf16* Ks = (LAS bf16*)lds;
    LAS bf16* Vt = Ks + 64 * 72;
    const int tid = otid(), wave = __builtin_amdgcn_readfirstlane(tid >> 6), lane = tid & 63, li = lane & 15, lq = lane >> 4;
    const int nunits = with_ctx ? 1088 : 1024;
    for (int u = obid(); u < nunits; u += ogdim()) {
        const bool isctx = u >= 1024;
        int b, kvh, blk;
        if (!isctx) { b = u >> 7; kvh = (u >> 6) & 1; blk = u & 63; } else { const int v = u - 1024; b = v >> 3; kvh = (v >> 2) & 1; blk = v & 3; }
        const int g = wave >> 1, half = wave & 1, hq = kvh * 4 + g;
        const int qtok0 = blk * 64 + half * 32, qrow0 = isctx ? ML + b * CTXL + qtok0 : b * SEQ + qtok0;
        bf16x8 qf[2][2];
#pragma unroll
        for (int qb = 0; qb < 2; ++qb)
#pragma unroll
            for (int ks = 0; ks < 2; ++ks) qf[qb][ks] = *(const bf16x8*)(P + (size_t)(qrow0 + 16 * qb + li) * DINP + PC_SQ + hq * 64 + 32 * ks + 8 * lq);
        f32x4 Oa[4][2];
#pragma unroll
        for (int x = 0; x < 4; ++x)
#pragma unroll
            for (int y = 0; y < 2; ++y) Oa[x][y] = (f32x4){0.f, 0.f, 0.f, 0.f};
        const float sinkv = a.in[I_SINK][l * 8 + hq];
        float mrun[2], lrun[2];
#pragma unroll
        for (int qb = 0; qb < 2; ++qb) { mrun[qb] = sinkv; lrun[qb] = lq == 0 ? 1.0f : 0.f; }
        int lo = 0, nlocal = 0;
        if (!isctx) { lo = 64 * blk - 128; if (lo < 0) lo = 0; int hi = 64 * blk + 192; if (hi > SEQ) hi = SEQ; nlocal = (hi - lo) >> 6; }
        const int ntiles = nlocal + 4;
        for (int t = 0; t < ntiles; ++t) {
            const bool local = t < nlocal; const int ktok0 = local ? lo + 64 * t : 64 * (t - nlocal); const int krow0 = local ? b * SEQ + ktok0 : ML + b * CTXL + ktok0;
            __syncthreads();
            {   const int key = tid >> 3, ch = tid & 7; const bf16* src = P + (size_t)(krow0 + key) * DINP;
                const v4u kv = *(const v4u*)(src + PC_SK + kvh * 64 + 8 * ch); *(LAS v4u*)(Ks + key * 72 + 8 * ch) = kv;
                const v4u v8 = *(const v4u*)(src + PC_SV + kvh * 64 + 8 * ch);
                LAS bf16* vd = Vt + (8 * ch) * 68 + key;
                vd[0 * 68] = (bf16)(v8.x & 0xffffu); vd[1 * 68] = (bf16)(v8.x >> 16); vd[2 * 68] = (bf16)(v8.y & 0xffffu); vd[3 * 68] = (bf16)(v8.y >> 16);
                vd[4 * 68] = (bf16)(v8.z & 0xffffu); vd[5 * 68] = (bf16)(v8.z >> 16); vd[6 * 68] = (bf16)(v8.w & 0xffffu); vd[7 * 68] = (bf16)(v8.w >> 16); }
            __syncthreads();
            const bool rel = !local || (ktok0 + 63 >= qtok0 - 128 && ktok0 <= qtok0 + 31 + 128);
            if (rel) {
#pragma unroll
                for (int qb = 0; qb < 2; ++qb) {
                    f32x4 s[4];
#pragma unroll
                    for (int kb = 0; kb < 4; ++kb) { s[kb] = (f32x4){0.f, 0.f, 0.f, 0.f};
#pragma unroll
                        for (int ks = 0; ks < 2; ++ks) { const bf16x8 kf = *(const LAS bf16x8*)(Ks + (16 * kb + li) * 72 + 32 * ks + 8 * lq);
                            s[kb] = __builtin_amdgcn_mfma_f32_16x16x32_bf16(kf, qf[qb][ks], s[kb], 0, 0, 0); } }
                    if (local) { const int qt = qtok0 + 16 * qb + li;
#pragma unroll
                        for (int kb = 0; kb < 4; ++kb)
#pragma unroll
                            for (int j = 0; j < 4; ++j) { const int dlt = ktok0 + 16 * kb + 4 * lq + j - qt; if (dlt > 128 || dlt < -128) s[kb][j] = -INFINITY; } }
                    float mx = -INFINITY;
#pragma unroll
                    for (int kb = 0; kb < 4; ++kb) mx = fmaxf(mx, fmaxf(fmaxf(s[kb][0], s[kb][1]), fmaxf(s[kb][2], s[kb][3])));
                    mx = fmaxf(mx, __shfl_xor(mx, 16)); mx = fmaxf(mx, __shfl_xor(mx, 32));
                    const float mnew = fmaxf(mrun[qb], mx), corr = __expf(mrun[qb] - mnew); mrun[qb] = mnew;
                    float ls = 0.f;
#pragma unroll
                    for (int kb = 0; kb < 4; ++kb)
#pragma unroll
                        for (int j = 0; j < 4; ++j) { const float p = __expf(s[kb][j] - mnew); s[kb][j] = p; ls += p; }
                    lrun[qb] = lrun[qb] * corr + ls;
#pragma unroll
                    for (int db = 0; db < 4; ++db) Oa[db][qb] = Oa[db][qb] * corr;
#pragma unroll
                    for (int kk = 0; kk < 2; ++kk) {
                        v4u pw; pw.x = pk2(s[2 * kk][0], s[2 * kk][1]); pw.y = pk2(s[2 * kk][2], s[2 * kk][3]); pw.z = pk2(s[2 * kk + 1][0], s[2 * kk + 1][1]); pw.w = pk2(s[2 * kk + 1][2], s[2 * kk + 1][3]);
                        const bf16x8 pf = __builtin_bit_cast(bf16x8, pw);
#pragma unroll
                        for (int db = 0; db < 4; ++db) { const LAS bf16* vp = Vt + (16 * db + li) * 68 + 32 * kk + 4 * lq;
                            const v2u va = *(const LAS v2u*)vp, vb = *(const LAS v2u*)(vp + 16);
                            const bf16x8 vf = __builtin_bit_cast(bf16x8, (v4u){va.x, va.y, vb.x, vb.y});
                            Oa[db][qb] = __builtin_amdgcn_mfma_f32_16x16x32_bf16(vf, pf, Oa[db][qb], 0, 0, 0); }
                    }
                }
            }
        }
#pragma unroll
        for (int qb = 0; qb < 2; ++qb) { float lt = lrun[qb]; lt += __shfl_xor(lt, 16); lt += __shfl_xor(lt, 32); const float inv = 1.0f / lt;
            bf16* op = MIX + (size_t)(qrow0 + 16 * qb + li) * 1024 + 256 + hq * 64 + 4 * lq;
#pragma unroll
            for (int db = 0; db < 4; ++db) { const f32x4 o = Oa[db][qb] * inv; v2u w; w.x = pk2(o.x, o.y); w.y = pk2(o.z, o.w); *(v2u*)(op + 16 * db) = w; } }
    }
}

__device__ __forceinline__ void phase_assemble(const Args& a, int l, const bf16* P, const _Float16* RF, const _Float16* LO, const _Float16* YO, bf16* MIX, int nrows) {
    const int lane = otid() & 63, gw = obid() * 8 + (otid() >> 6), NGW = ogdim() * 8, c = 4 * lane;
    const f32x4 ng = *(const f32x4*)(a.in[I_GNORM] + l * 256 + c), ka = *(const f32x4*)(a.in[I_KA] + l * 256 + c), rk = *(const f32x4*)(a.in[I_RK] + l * 256 + c);
    const f32x4 gg = *(const f32x4*)(a.in[I_GNG] + l * 256 + c), gb = *(const f32x4*)(a.in[I_GNB] + l * 256 + c);
    for (int row = gw; row < nrows; row += NGW) {
        {
            const h4 of = *(const h4*)(YO + ((size_t)2 * MA + row) * 256 + c), ob = *(const h4*)(YO + ((size_t)3 * MA + row) * 256 + c);
            f32x4 o; float ss = 0.f;
#pragma unroll
            for (int e = 0; e < 4; ++e) { o[e] = (float)of[e] + (float)ob[e]; ss += o[e] * o[e]; }
            ss += __shfl_xor(ss, 1); ss += __shfl_xor(ss, 2); ss += __shfl_xor(ss, 4); ss += __shfl_xor(ss, 8);
            const float rms = 1.0f / sqrtf(ss * (1.0f / 64.0f) + LN_EPS);
            const v2u g2 = *(const v2u*)(P + (size_t)row * DINP + PC_GG + c);
            const float ga[4] = {bflo(g2.x), bfhi(g2.x), bflo(g2.y), bfhi(g2.y)}; float r[4];
#pragma unroll
            for (int e = 0; e < 4; ++e) r[e] = o[e] * rms * ng[e] * (ga[e] * sigmoidf_(ga[e]));
            v2u w; w.x = pk2(r[0], r[1]); w.y = pk2(r[2], r[3]); *(v2u*)(MIX + (size_t)row * 1024 + c) = w; }
        {
            const h4 yf = *(const h4*)(YO + ((size_t)0 * MA + row) * 256 + c), yb = *(const h4*)(YO + ((size_t)1 * MA + row) * 256 + c);
            const _Float16* rf = RF + (size_t)row * 1024 + c; const _Float16* lo = LO + (size_t)row * 1536 + c;
            const h4 r4 = *(const h4*)(rf + RF_R), k4 = *(const h4*)(rf + RF_K), v4 = *(const h4*)(rf + RF_V);
            const h4 af = *(const h4*)(lo + LC_A), ab = *(const h4*)(lo + LC_A + 256), g4 = *(const h4*)(lo + LC_G);
            f32x4 y; float s1 = 0.f, bon = 0.f;
#pragma unroll
            for (int e = 0; e < 4; ++e) { y[e] = (float)yf[e] + (float)yb[e]; s1 += y[e];
                bon += (float)r4[e] * (float)k4[e] * (1.0f + (0.5f * ((float)af[e] + (float)ab[e]) - 1.0f) * ka[e]) * rk[e]; }
            s1 += __shfl_xor(s1, 1); s1 += __shfl_xor(s1, 2); s1 += __shfl_xor(s1, 4); s1 += __shfl_xor(s1, 8);
            bon += __shfl_xor(bon, 1); bon += __shfl_xor(bon, 2); bon += __shfl_xor(bon, 4); bon += __shfl_xor(bon, 8);
            const float mu = s1 * (1.0f / 64.0f); float s2 = 0.f;
#pragma unroll
            for (int e = 0; e < 4; ++e) { y[e] -= mu; s2 += y[e] * y[e]; }
            s2 += __shfl_xor(s2, 1); s2 += __shfl_xor(s2, 2); s2 += __shfl_xor(s2, 4); s2 += __shfl_xor(s2, 8);
            const float rstd = 1.0f / sqrtf(s2 * (1.0f / 64.0f) + 64e-5f); float r[4];
#pragma unroll
            for (int e = 0; e < 4; ++e) r[e] = (y[e] * rstd * gg[e] + gb[e] + bon * (float)v4[e]) * (float)g4[e];
            v2u w; w.x = pk2(r[0], r[1]); w.y = pk2(r[2], r[3]); *(v2u*)(MIX + (size_t)row * 1024 + 768 + c) = w; }
    }
}

#define XB_TMO      128
#define XB_XCNT(j)  (256  + 64 * (j))
#define XB_XSUB(j)  (1280 + 64 * (j))
#define XB_XGEN(j)  (2304 + 64 * (j))
#define XB_TOP      3328
#define XB_TOPGEN   3392
#define XCD_BAR_WORDS 3456
#define XB_SPIN_CAP (1u << 18)

__device__ __forceinline__ unsigned xb_ld(unsigned* p)              { return __hip_atomic_load(p, __ATOMIC_RELAXED, __HIP_MEMORY_SCOPE_AGENT); }
__device__ __forceinline__ unsigned xb_add(unsigned* p, unsigned v) { return __hip_atomic_fetch_add(p, v, __ATOMIC_RELAXED, __HIP_MEMORY_SCOPE_AGENT); }
__device__ __forceinline__ unsigned xb_xcc_id() { return (unsigned)__builtin_amdgcn_s_getreg((3 << 11) | 20) & 0xFu; }
#define XB_SPIN(cond, bar) do { unsigned _sp = 0; while (cond) { __builtin_amdgcn_s_sleep(1); \
    if ((++_sp & 255u) == 0u) { if (xb_ld(&(bar)[XB_TMO])) break; if (_sp > XB_SPIN_CAP) { atomicAdd(&(bar)[XB_TMO], 1u); break; } } } } while (0)

struct XcdBarrier {
    unsigned* bar; unsigned x;
    volatile LAS unsigned* st;
};

__device__ __forceinline__ XcdBarrier xcd_barrier_post(unsigned* bar, volatile LAS unsigned* st) {
    XcdBarrier b; b.bar = bar; b.x = xb_xcc_id(); b.st = st;
    if (threadIdx.x == 0) (void)xb_add(&bar[XB_XCNT(b.x)], 1u);
    return b;
}
__device__ __forceinline__ void xcd_barrier_complete(unsigned* bar, unsigned x, unsigned& nloc, unsigned& nx) {
    const unsigned G = gridDim.x * gridDim.y * gridDim.z;
    unsigned sum, cnt, mine, sp = 0u;
    for (;;) {
        sum = 0u; cnt = 0u; mine = 0u;
#pragma unroll
        for (unsigned j = 0; j < 16; ++j) { const unsigned c = xb_ld(&bar[XB_XCNT(j)]); sum += c; cnt += (c > 0u) ? 1u : 0u; mine = (j == x) ? c : mine; }
        if (sum == G) break;
        __builtin_amdgcn_s_sleep(1);
        if ((++sp & 255u) == 0u) { if (xb_ld(&bar[XB_TMO])) break; if (sp > XB_SPIN_CAP) { atomicAdd(&bar[XB_TMO], 1u); break; } }
    }
    nloc = mine > 0u ? mine : 1u; nx = cnt > 0u ? cnt : 1u;
}

__device__ __forceinline__ void xcd_barrier(const XcdBarrier& b) {
    asm volatile("s_waitcnt vmcnt(0)" ::: "memory");
    __syncthreads();
    if (threadIdx.x == 0) {
        unsigned* bar = b.bar;
        __builtin_amdgcn_s_waitcnt(0);
        unsigned nloc = b.st[0], nx = b.st[1];
        if (nloc == 0u) { xcd_barrier_complete(bar, b.x, nloc, nx); b.st[0] = nloc; b.st[1] = nx; }
        const unsigned old = xb_add(&bar[XB_XSUB(b.x)], 1u);
        const unsigned gen = old / nloc;
        if (old + 1u == (gen + 1u) * nloc) {
            __builtin_amdgcn_fence(__ATOMIC_RELEASE, "agent");
            asm volatile("s_waitcnt vmcnt(0)" ::: "memory");
            const unsigned og = xb_add(&bar[XB_TOP], 1u);
            const unsigned tg = og / nx;
            if (og + 1u == (tg + 1u) * nx) xb_add(&bar[XB_TOPGEN], 1u);
            else XB_SPIN(xb_ld(&bar[XB_TOPGEN]) == tg, bar);
            __builtin_amdgcn_fence(__ATOMIC_ACQUIRE, "agent");
            xb_add(&bar[XB_XGEN(b.x)], 1u);
            asm volatile("s_waitcnt vmcnt(0)" ::: "memory");
        } else {
            XB_SPIN(xb_ld(&bar[XB_XGEN(b.x)]) == gen, bar);
            __builtin_amdgcn_fence(__ATOMIC_ACQUIRE, "agent");
            asm volatile("s_waitcnt vmcnt(0)" ::: "memory");
        }
    }
    __syncthreads();
}

#define GSYNC() do { XcdBarrier xb_; xb_.bar = (unsigned*)a.ws; xb_.x = xb_xcc_id(); xb_.st = (volatile LAS unsigned*)(lds + 133120); xcd_barrier(xb_); } while (0)
#ifndef REP_RWKV
#define REP_RWKV 1
#endif
#ifndef REP_GLA
#define REP_GLA 1
#endif
#ifndef REP_SWA
#define REP_SWA 1
#endif
#ifndef REP_UP
#define REP_UP 1
#endif
__global__ void __launch_bounds__(512, 2) mega_fwd(Args a) {
    extern __shared__ __attribute__((aligned(16))) unsigned char lds_raw[];
    cg::grid_group grid = cg::this_grid();
    LAS unsigned char* lds = (LAS unsigned char*)lds_raw;
    unsigned char* ws = a.ws;
    float* MOD = (float*)(ws + WS_MOD); float* STATS = (float*)(ws + WS_STATS);
    float* XL = a.out; float* XC = (float*)(ws + WS_XC);
    bf16* U = (bf16*)(ws + WS_U); bf16* HID = (bf16*)(ws + WS_HID);
    _Float16* LO = (_Float16*)(ws + WS_LO); _Float16* RF = (_Float16*)(ws + WS_RF); _Float16* YO = (_Float16*)(ws + WS_YO);

    { volatile LAS unsigned* st = (volatile LAS unsigned*)(lds + 133120); if (threadIdx.x < 2) st[threadIdx.x] = 0u; }
    __syncthreads();
    (void)xcd_barrier_post((unsigned*)ws, (volatile LAS unsigned*)(lds + 133120));
    phase_adaln(a, MOD, lds);
    __syncthreads();
    phase_convert(a, 0, ws, lds);
    grid.sync();
    phase_mod0(a, MOD, U);
    GSYNC();
    for (int l = 0; l < DEPTH; ++l) {
        const bool last = (l == DEPTH - 1);
        asm volatile("" : "+s"(ws));
        const float* modl = MOD + (size_t)l * 9 * 9216;
        const float* lng = a.in[I_LNG] + l * 3 * 1024; const float* lnb = a.in[I_LNB] + l * 3 * 1024;
        for (int rep = 0; rep < REP_UP; ++rep) { pg8::Gemm g{U, (const bf16*)(ws + WS_WGU1), MA, 2 * DFF, 1024}; pg8::StaticOrder S; S.init(MA, 2 * DFF, ogdim(), obid());
          pg8::EpiSwiglu E{HID, DFF}; pg8::gemm_phase<pg8::EpiSwiglu, pg8::StaticOrder, true, true>(lds, g, S, E); }
        GSYNC();
        { pg8::Gemm g{HID, (const bf16*)(ws + WS_WD1), MA, 1024, DFF}; pg8::StaticOrder S; S.init(MA, 1024, ogdim(), obid());
          pg8::EpiResid E{l == 0 ? a.in[I_X] : XL, l == 0 ? a.in[I_CTX] : XC, XL, XC, modl + 2 * 1024, ALPHA, 0.5f, STATS, lng - 1024, lnb - 1024, l > 0 ? 1 : 0};
          pg8::gemm_phase<pg8::EpiResid, pg8::StaticOrder, true, true>(lds, g, S, E); }
        GSYNC();
        phase_ln(XL, XC, lng, lnb, modl + 3 * 1024, U, MA, true, STATS, false);
        GSYNC();
        { pg8::Gemm g{U, (const bf16*)(ws + WS_WIN), MA, DINP, 1024}; pg8::StaticOrder S; S.init(MA, DINP, ogdim(), obid());
          pg8::EpiStore E{HID, DINP}; pg8::gemm_phase<pg8::EpiStore, pg8::StaticOrder, true, true>(lds, g, S, E); }
        GSYNC();
        phase_features(a, l, HID, RF, U, lds);
        GSYNC();
        { pg8::Gemm g{U, (const bf16*)(ws + WS_WLORA), MA, LORA_N, LORA_K}; pg8::StaticOrder S; S.init(MA, LORA_N, ogdim(), obid());
          pg8::EpiLora E{LO, a.in[I_W0] + l * 512, a.in[I_A0] + l * 512, a.in[I_GBIAS] + l * 256};
          pg8::gemm_phase<pg8::EpiLora, pg8::StaticOrder, true, true>(lds, g, S, E); }
        GSYNC();
        phase_gla_a(l, HID, LO, YO, (_Float16*)(ws + WS_KV), (float*)(ws + WS_DEC), lds);
        __syncthreads();
        for (int rep = 0; rep < REP_SWA; ++rep) { phase_swa(a, l, HID, U, !last, lds); __syncthreads(); }
        GSYNC();
        phase_gla_b((const _Float16*)(ws + WS_KV), (const float*)(ws + WS_DEC), (bf16*)(ws + WS_ST));
        for (int rep = 0; rep < REP_RWKV; ++rep) { phase_rwkv(a, l, RF, LO, YO, lds); __syncthreads(); }
        GSYNC();
        phase_gla_c(HID, (const bf16*)(ws + WS_ST), YO);
        GSYNC();
        phase_assemble(a, l, HID, RF, LO, YO, U, last ? ML : MA);
        GSYNC();
        const int Mo = last ? ML : MA;
        { pg8::Gemm g{U, (const bf16*)(ws + WS_WOUT), Mo, 1024, 1024}; pg8::StaticOrder S; S.init(Mo, 1024, ogdim(), obid());
          pg8::EpiResid E{XL, XC, XL, XC, modl + 5 * 1024, ALPHA, 1.0f, STATS, lng, lnb, 1};
          pg8::gemm_phase<pg8::EpiResid, pg8::StaticOrder, true, true>(lds, g, S, E); }
        GSYNC();
        phase_ln(XL, XC, lng + 1024, lnb + 1024, modl + 6 * 1024, U, Mo, true, STATS, false);
        GSYNC();
        { pg8::Gemm g{U, (const bf16*)(ws + WS_WGU2), Mo, 2 * DFF, 1024}; pg8::StaticOrder S; S.init(Mo, 2 * DFF, ogdim(), obid());
          pg8::EpiSwiglu E{HID, DFF}; pg8::gemm_phase<pg8::EpiSwiglu, pg8::StaticOrder, true, true>(lds, g, S, E); }
        GSYNC();
        { pg8::Gemm g{HID, (const bf16*)(ws + WS_WD2), Mo, 1024, DFF}; pg8::StaticOrder S; S.init(Mo, 1024, ogdim(), obid());
          pg8::EpiResid E{XL, XC, XL, XC, modl + 8 * 1024, ALPHA, 0.5f, STATS, lng + 1024, lnb + 1024, 1};
          pg8::gemm_phase<pg8::EpiResid, pg8::StaticOrder, true, true>(lds, g, S, E); }
        GSYNC();
        phase_ln(XL, XC, lng + 2048, lnb + 2048, MOD + (size_t)(last ? l : l + 1) * 9 * 9216, U, Mo, !last, STATS, last);
        if (!last) { __syncthreads(); phase_convert(a, l + 1, ws, lds); }
        GSYNC();
    }
}

extern "C" void kernel_launch(void* const* d_in, const int* in_sizes, int n_in, void* d_out, int out_size, void* d_ws, size_t ws_size, hipStream_t stream) {
    static int grid = 0;
    if (grid == 0) {
        if (n_in != 31 || out_size != ML * DM || ws_size < WS_END) { fprintf(stderr, "kernel_launch: unexpected problem (n_in %d, out %d, ws %zu need %zu)\n", n_in, out_size, ws_size, (size_t)WS_END); grid = -1; return; }
        int dev = 0, cus = 0, per_cu = 0;
        hipGetDevice(&dev); hipDeviceGetAttribute(&cus, hipDeviceAttributeMultiprocessorCount, dev);
        if (hipFuncSetAttribute((const void*)mega_fwd, hipFuncAttributeMaxDynamicSharedMemorySize, LDS_BYTES) != hipSuccess) { fprintf(stderr, "kernel_launch: hipFuncSetAttribute failed\n"); grid = -1; return; }
        if (hipOccupancyMaxActiveBlocksPerMultiprocessor(&per_cu, (const void*)mega_fwd, 512, LDS_BYTES) != hipSuccess || per_cu < 1) { fprintf(stderr, "kernel_launch: occupancy query says %d\n", per_cu); per_cu = 1; }
        (void)hipGetLastError();
        grid = cus * per_cu;
    }
    if (grid < 0) return;
    if (hipMemsetAsync(d_ws, 0, 65536, stream) != hipSuccess) { fprintf(stderr, "kernel_launch: memset failed\n"); return; }
    Args a{};
    for (int i = 0; i < 31; ++i) a.in[i] = (const float*)d_in[i];
    a.out = (float*)d_out; a.ws = (unsigned char*)d_ws;
    void* args[] = {&a};
    const hipError_t e = hipLaunchCooperativeKernel((const void*)mega_fwd, dim3(grid), dim3(512), args, LDS_BYTES, stream);
    if (e != hipSuccess) fprintf(stderr, "kernel_launch: cooperative launch failed: %s (grid %d)\n", hipGetErrorString(e), grid);
}
```

```cpp
#include <hip/hip_runtime.h>
#include <hip/hip_cooperative_groups.h>
#include <cstdio>
#include <cstdint>
namespace cg = cooperative_groups;
namespace pg8 {
#define PG8_LAS __attribute__((address_space(3)))
typedef unsigned short bf16_t;
typedef short bf16x8 __attribute__((ext_vector_type(8)));
typedef float f32x4 __attribute__((ext_vector_type(4)));
typedef unsigned u32x4 __attribute__((ext_vector_type(4)));
constexpr int BM = 256, BK = 64, HALF = 128, HTB = HALF * BK * 2  , STAGE_BYTES = 8 * HTB, NXCD = 8, WGM = 8;

__host__ __device__ __forceinline__ int lds_byte(int r, int c) { const int st = (r >> 4) * 2 + (c >> 5), rr = r & 15, cc = c & 31, ob = rr * 64 + cc * 2; return st * 1024 + (ob ^ (((ob >> 9) & 1) << 5)); }
__host__ __device__ __forceinline__ void stage_rc(int b, int& R, int& C) { const int st = b / 1024, sb = b % 1024, swz = sb ^ (((sb >> 9) & 1) << 5); R = (st >> 1) * 16 + swz / 64; C = (st & 1) * 32 + (swz % 64) / 2; }
__host__ __device__ __forceinline__ int perm32(int rho) { const int n = rho >> 4, i = rho & 15; return 8 * (i >> 2) + 4 * n + (i & 3); }

struct Unit { int pm, pn; };
struct Gemm { const bf16_t* A; const bf16_t* Bt; int M, N, K; };

struct StaticOrder {
    int nM, nN, nwg, G, c;
    __host__ __device__ void init(int M, int N, int G_, int c_) { nM = M / BM; nN = N / BM; nwg = nM * nN; G = G_; c = c_; }
    __host__ __device__ bool next(int i, Unit& u) const {
        const long L = (long)i * G + c; if (L >= nwg) return false;
        int wgid = (int)L; { const int q = nwg / NXCD, r = nwg % NXCD, xcd = wgid % NXCD, off = wgid / NXCD; wgid = (xcd < r ? xcd * (q + 1) : r * (q + 1) + (xcd - r) * q) + off; }
        const int nig = WGM * nN, gid = wgid / nig, fm = gid * WGM, gsz = (nM - fm) < WGM ? (nM - fm) : WGM;
        u.pm = fm + ((wgid % nig) % gsz); u.pn = (wgid % nig) / gsz; return true;
    }
    __device__ __forceinline__ void a_ready(const Unit&) const {}
    __device__ __forceinline__ void done(const Unit&) const {}
};

__device__ __forceinline__ unsigned cvt_pk_bf16(float lo, float hi) { unsigned r; asm volatile("v_cvt_pk_bf16_f32 %0, %1, %2" : "=v"(r) : "v"(lo), "v"(hi)); return r; }
typedef _Float16 f16x8 __attribute__((ext_vector_type(8)));
typedef unsigned u32x2 __attribute__((ext_vector_type(2)));
__device__ __forceinline__ float fast_sigmoid(float x) { return __builtin_amdgcn_rcpf(1.0f + __expf(-x)); }
__device__ __forceinline__ float log_sigmoid(float x) { return fminf(x, 0.f) - __logf(1.0f + __expf(-fabsf(x))); }

struct EpiSwiglu {
    static constexpr bool PERM = true, AFTER_DRAIN = false;
    bf16_t* O; int ldc;
    __device__ __forceinline__ void operator()(const f32x4 (&acc)[2][2][4][2], const Unit& u, int wr, int wc, int fr, int fq) const {
        const int row0 = u.pm * BM + wr * 64 + fr, col0 = u.pn * HALF + wc * 32 + 8 * fq;
#pragma unroll
        for (int ai = 0; ai < 2; ++ai)
#pragma unroll
            for (int m = 0; m < 4; ++m) {
                bf16_t* rowp = O + (size_t)(row0 + ai * HALF + m * 16) * ldc + col0;
                float h[8];
#pragma unroll
                for (int n = 0; n < 2; ++n)
#pragma unroll
                    for (int e = 0; e < 4; ++e) { const float g = acc[ai][0][m][n][e], up = acc[ai][1][m][n][e]; h[4 * n + e] = g * fast_sigmoid(g) * up; }
                u32x4 w; w.x = cvt_pk_bf16(h[0], h[1]); w.y = cvt_pk_bf16(h[2], h[3]); w.z = cvt_pk_bf16(h[4], h[5]); w.w = cvt_pk_bf16(h[6], h[7]);
                *(u32x4*)rowp = w;
            }
    }
};
struct EpiStore {
    static constexpr bool PERM = true, AFTER_DRAIN = false;
    bf16_t* O; int ldc;
    __device__ __forceinline__ void operator()(const f32x4 (&acc)[2][2][4][2], const Unit& u, int wr, int wc, int fr, int fq) const {
        const int row0 = u.pm * BM + wr * 64 + fr, col0 = u.pn * BM + wc * 32 + 8 * fq;
#pragma unroll
        for (int ai = 0; ai < 2; ++ai)
#pragma unroll
            for (int m = 0; m < 4; ++m) {
                bf16_t* rowp = O + (size_t)(row0 + ai * HALF + m * 16) * ldc + col0;
#pragma unroll
                for (int bj = 0; bj < 2; ++bj) { const f32x4 v0 = acc[ai][bj][m][0], v1 = acc[ai][bj][m][1];
                    u32x4 w; w.x = cvt_pk_bf16(v0[0], v0[1]); w.y = cvt_pk_bf16(v0[2], v0[3]); w.z = cvt_pk_bf16(v1[0], v1[1]); w.w = cvt_pk_bf16(v1[2], v1[3]);
                    *(u32x4*)(rowp + bj * HALF) = w; }
            }
    }
};
struct EpiResid {
    static constexpr bool PERM = false, AFTER_DRAIN = false;
    const float* src_lat; const float* src_ctx; float* dst_lat; float* dst_ctx; const float* gate  ; float alpha, coef;
    const float* stats; const float* lg; const float* lb; int use_ln;
    __device__ __forceinline__ void operator()(const f32x4 (&acc)[2][2][4][2], const Unit& u, int wr, int wc, int fr, int fq) const {
        const bool ctx = u.pm >= 128; const int bi = ctx ? 8 : (u.pm >> 4);
        const float* src = ctx ? src_ctx + (size_t)(u.pm - 128) * BM * 1024 : src_lat + (size_t)u.pm * BM * 1024;
        float* dst = ctx ? dst_ctx + (size_t)(u.pm - 128) * BM * 1024 : dst_lat + (size_t)u.pm * BM * 1024;
        const float* gp = gate + (size_t)bi * 9216;
        const int col0 = u.pn * BM + wc * 32 + 4 * fq;
        float mean[2][4], rstd[2][4];
#pragma unroll
        for (int ai = 0; ai < 2; ++ai)
#pragma unroll
            for (int m = 0; m < 4; ++m) { mean[ai][m] = 0.f; rstd[ai][m] = 1.f;
                if (use_ln) { typedef float f32x2s __attribute__((ext_vector_type(2))); const f32x2s st = *(const f32x2s*)(stats + 2 * (size_t)(u.pm * BM + ai * HALF + wr * 64 + m * 16 + fr)); mean[ai][m] = st.x; rstd[ai][m] = st.y; } }
#pragma unroll
        for (int bj = 0; bj < 2; ++bj)
#pragma unroll
            for (int n = 0; n < 2; ++n) { const int cc = col0 + bj * HALF + n * 16;
                const f32x4 gv = *(const f32x4*)(gp + cc) * coef; f32x4 ga = (f32x4){alpha, alpha, alpha, alpha}, ba = (f32x4){0.f, 0.f, 0.f, 0.f};
                if (use_ln) { ga = *(const f32x4*)(lg + cc) * alpha; ba = *(const f32x4*)(lb + cc) * alpha; }
#pragma unroll
                for (int ai = 0; ai < 2; ++ai)
#pragma unroll
                    for (int m = 0; m < 4; ++m) { const size_t off = (size_t)(ai * HALF + wr * 64 + m * 16 + fr) * 1024 + cc;
                        const f32x4 sv = *(const f32x4*)(src + off);
                        *(f32x4*)(dst + off) = (sv - mean[ai][m]) * rstd[ai][m] * ga + ba + gv * acc[ai][bj][m][n]; }
                asm volatile("" ::: "memory"); }
    }
};
struct EpiLora {
    static constexpr bool PERM = true, AFTER_DRAIN = false;
    _Float16* O; const float* w0; const float* a0; const float* gbias;
    template <int MODE> __device__ __forceinline__ void tile(const f32x4 (&acc)[2][2][4][2], const Unit& u, int wr, int wc, int fr, int fq, const float* bias) const {
        const int row0 = u.pm * BM + wr * 64 + fr, lc0 = wc * 32 + 8 * fq;
        float bv[2][8];
#pragma unroll
        for (int bj = 0; bj < 2; ++bj)
#pragma unroll
            for (int e = 0; e < 8; ++e) bv[bj][e] = (MODE == 2) ? 0.f : bias[lc0 + bj * HALF + e];
#pragma unroll
        for (int ai = 0; ai < 2; ++ai)
#pragma unroll
            for (int m = 0; m < 4; ++m) {
                _Float16* rowp = O + (size_t)(row0 + ai * HALF + m * 16) * 1536 + u.pn * BM + lc0;
#pragma unroll
                for (int bj = 0; bj < 2; ++bj) {
                    f16x8 o;
#pragma unroll
                    for (int e = 0; e < 8; ++e) { const float x = acc[ai][bj][m][e >> 2][e & 3] + bv[bj][e]; float r;
                        if (MODE == 0) r = __expf(-__expf(log_sigmoid(x) - 0.5f));
                        else if (MODE == 1) r = fast_sigmoid(x);
                        else if (MODE == 2) r = x;
                        else r = log_sigmoid(x) * (1.0f / 16.0f);
                        o[e] = (_Float16)r; }
                    *(f16x8*)(rowp + bj * HALF) = o;
                }
            }
    }
    __device__ __forceinline__ void operator()(const f32x4 (&acc)[2][2][4][2], const Unit& u, int wr, int wc, int fr, int fq) const {
        const int pn = u.pn;
        if (pn < 2) tile<0>(acc, u, wr, wc, fr, fq, w0 + pn * 256);
        else if (pn < 4) tile<1>(acc, u, wr, wc, fr, fq, a0 + (pn - 2) * 256);
        else if (pn == 4) tile<2>(acc, u, wr, wc, fr, fq, gbias);
        else tile<3>(acc, u, wr, wc, fr, fq, gbias);
    }
};

template <class Epi, class Sched, bool ALIGN_EPI = false, bool SP2 = false>
__device__ __forceinline__ void gemm_phase(PG8_LAS unsigned char* lds, const Gemm g, const Sched& S, const Epi& E) {
    int tid_ = threadIdx.x; asm volatile("" : "+v"(tid_)); const int tid = tid_, wid = __builtin_amdgcn_readfirstlane(tid >> 6), lane = tid & 63, wr = wid >> 2, wc = wid & 3, fr = lane & 15, fq = lane >> 4;
    const int K = g.K, nt = K / BK;
    unsigned voffA[2], voffB[2];
#pragma unroll
    for (int i = 0; i < 2; ++i) { int R, C; stage_rc(tid * 16 + i * 8192, R, C); const int Rb = Epi::PERM ? ((R & ~31) + perm32(R & 31)) : R;
        voffA[i] = (unsigned)(R * K + C) * 2u; voffB[i] = (unsigned)(Rb * K + C) * 2u; }
    const size_t kstep = (size_t)(BK * 2);
    const size_t hstep = (size_t)HALF * K * 2;
    const size_t tstep = 2 * hstep;
    const unsigned ldsw = (unsigned)wid * 1024u;
    const int aoff = lds_byte(wr * 64 + fr, fq * 8), boff = lds_byte(wc * 32 + fr, fq * 8);
#define PG8_SA(b, h) (((b) * 2 + (h)) * HTB)
#define PG8_SB(b, h) ((4 + (b) * 2 + (h)) * HTB)
#define PG8_STAGE(bufoff, gbase, voff) do { _Pragma("unroll") for (int _i = 0; _i < 2; ++_i) \
        __builtin_amdgcn_global_load_lds((const unsigned*)((const char*)(gbase) + (voff)[_i]), (PG8_LAS unsigned*)(lds + (bufoff) + ldsw + _i * 8192), 16, 0, 0); } while (0)
#define PG8_LDA(dst, b, h) do { _Pragma("unroll") for (int m = 0; m < 4; ++m) _Pragma("unroll") for (int k = 0; k < 2; ++k) dst[m][k] = *(const PG8_LAS bf16x8*)(lds + PG8_SA(b, h) + aoff + m * 2048 + k * 1024); } while (0)
#define PG8_LDB(dst, b, h) do { _Pragma("unroll") for (int n = 0; n < 2; ++n) _Pragma("unroll") for (int k = 0; k < 2; ++k) dst[n][k] = *(const PG8_LAS bf16x8*)(lds + PG8_SB(b, h) + boff + n * 2048 + k * 1024); } while (0)
#define PG8_MMA(ai, bj, At, Bt) do { __builtin_amdgcn_s_setprio(1); _Pragma("unroll") for (int m = 0; m < 4; ++m) _Pragma("unroll") for (int n = 0; n < 2; ++n) _Pragma("unroll") for (int k = 0; k < 2; ++k) \
        acc[ai][bj][m][n] = __builtin_amdgcn_mfma_f32_16x16x32_bf16(Bt[n][k], At[m][k], acc[ai][bj][m][n], 0, 0, 0); __builtin_amdgcn_s_setprio(0); } while (0)
#define PG8_WAIT_V(n) asm volatile("s_waitcnt vmcnt(" #n ")" ::: "memory")
#define PG8_WAIT_L(n) asm volatile("s_waitcnt lgkmcnt(" #n ")" ::: "memory")
#define PG8_BAR __builtin_amdgcn_s_barrier()
#define PG8_SCHED __builtin_amdgcn_sched_barrier(0)
    Unit cur, nxt; int ui = 0;
    if (!S.next(0, cur)) return;
    f32x4 acc[2][2][4][2];
#pragma unroll
    for (int a = 0; a < 2; ++a)
#pragma unroll
        for (int b = 0; b < 2; ++b)
#pragma unroll
            for (int m = 0; m < 4; ++m)
#pragma unroll
                for (int n = 0; n < 2; ++n) acc[a][b][m][n] = (f32x4){0.f, 0.f, 0.f, 0.f};
    bf16x8 At[4][2], B0[2][2], B1[2][2];
    const char* cA = (const char*)g.A + (size_t)cur.pm * tstep; const char* cB = (const char*)g.Bt + (size_t)cur.pn * tstep;
    S.a_ready(cur);
    if constexpr (SP2) {
        PG8_STAGE(PG8_SB(0, 0), cB, voffB); PG8_STAGE(PG8_SB(0, 1), cB + hstep, voffB); PG8_STAGE(PG8_SA(0, 0), cA, voffA); PG8_STAGE(PG8_SA(0, 1), cA + hstep, voffA);
        if (wr == 1) PG8_BAR;
        PG8_WAIT_V(2); PG8_BAR;
        PG8_STAGE(PG8_SB(1, 0), cB + kstep, voffB); PG8_STAGE(PG8_SA(1, 0), cA + kstep, voffA); PG8_STAGE(PG8_SB(1, 1), cB + hstep + kstep, voffB);
        PG8_WAIT_V(6); PG8_BAR;
    } else {
        PG8_STAGE(PG8_SB(0, 0), cB, voffB); PG8_STAGE(PG8_SA(0, 0), cA, voffA); PG8_STAGE(PG8_SB(0, 1), cB + hstep, voffB); PG8_STAGE(PG8_SA(0, 1), cA + hstep, voffA);
        if (wr == 1) PG8_BAR;
        PG8_WAIT_V(4); PG8_BAR;
        PG8_STAGE(PG8_SB(1, 0), cB + kstep, voffB); PG8_STAGE(PG8_SA(1, 0), cA + kstep, voffA); PG8_STAGE(PG8_SB(1, 1), cB + hstep + kstep, voffB);
        PG8_WAIT_V(6); PG8_BAR;
    }
    for (;;) {
        const bool has_next = S.next(ui + 1, nxt);
        const char* nA = has_next ? (const char*)g.A + (size_t)nxt.pm * tstep : cA; const char* nB = has_next ? (const char*)g.Bt + (size_t)nxt.pn * tstep : cB;
        for (int t = 0; t < nt; t += 2) {
            const bool last = (t == nt - 2);
            const char* a1 = cA + (size_t)(t + 1) * kstep;
            const char* a2 = last ? nA : cA + (size_t)(t + 2) * kstep; const char* b2 = last ? nB : cB + (size_t)(t + 2) * kstep;
            const char* a3 = a2 + kstep; const char* b3 = b2 + kstep;
            if (last && has_next) S.a_ready(nxt);
            if constexpr (SP2) {
            PG8_LDB(B0, 0, 0); PG8_LDB(B1, 0, 1); PG8_SCHED; PG8_LDA(At, 0, 0); PG8_STAGE(PG8_SA(1, 1), a1 + hstep, voffA);
            PG8_WAIT_V(8); PG8_WAIT_L(0); PG8_BAR; PG8_MMA(0, 0, At, B0); PG8_MMA(0, 1, At, B1); PG8_BAR; PG8_SCHED;
            PG8_LDA(At, 0, 1); PG8_STAGE(PG8_SB(0, 0), b2, voffB); PG8_STAGE(PG8_SB(0, 1), b2 + hstep, voffB); PG8_STAGE(PG8_SA(0, 0), a2, voffA);
            PG8_WAIT_V(8); PG8_WAIT_L(0); PG8_BAR; PG8_MMA(1, 0, At, B0); PG8_MMA(1, 1, At, B1); PG8_BAR; PG8_SCHED;
            PG8_LDB(B0, 1, 0); PG8_LDB(B1, 1, 1); PG8_SCHED; PG8_LDA(At, 1, 0); PG8_STAGE(PG8_SA(0, 1), a2 + hstep, voffA);
            PG8_WAIT_V(8); PG8_WAIT_L(0); PG8_BAR; PG8_MMA(0, 0, At, B0); PG8_MMA(0, 1, At, B1); PG8_BAR; PG8_SCHED;
            PG8_LDA(At, 1, 1); PG8_STAGE(PG8_SB(1, 0), b3, voffB); PG8_STAGE(PG8_SB(1, 1), b3 + hstep, voffB); PG8_STAGE(PG8_SA(1, 0), a3, voffA);
            PG8_WAIT_V(8); PG8_WAIT_L(0); PG8_BAR; PG8_MMA(1, 0, At, B0); PG8_MMA(1, 1, At, B1); PG8_BAR; PG8_SCHED;
            } else {
            PG8_LDB(B0, 0, 0); PG8_SCHED; PG8_LDA(At, 0, 0); PG8_STAGE(PG8_SA(1, 1), a1 + hstep, voffA);
            PG8_WAIT_L(8); PG8_BAR; PG8_WAIT_L(0); PG8_MMA(0, 0, At, B0); PG8_BAR; PG8_SCHED;
            PG8_LDB(B1, 0, 1); PG8_STAGE(PG8_SB(0, 0), b2, voffB);
            PG8_BAR; PG8_WAIT_L(0); PG8_MMA(0, 1, At, B1); PG8_BAR;
            PG8_LDA(At, 0, 1); PG8_STAGE(PG8_SA(0, 0), a2, voffA);
            PG8_BAR; PG8_WAIT_L(0); PG8_MMA(1, 0, At, B0); PG8_BAR; PG8_SCHED;
            PG8_STAGE(PG8_SB(0, 1), b2 + hstep, voffB);
            PG8_WAIT_V(6); PG8_BAR; PG8_MMA(1, 1, At, B1); PG8_BAR;
            PG8_LDB(B0, 1, 0); PG8_SCHED; PG8_LDA(At, 1, 0); PG8_STAGE(PG8_SA(0, 1), a2 + hstep, voffA);
            PG8_WAIT_L(8); PG8_BAR; PG8_WAIT_L(0); PG8_MMA(0, 0, At, B0); PG8_BAR; PG8_SCHED;
            PG8_LDB(B1, 1, 1); PG8_STAGE(PG8_SB(1, 0), b3, voffB);
            PG8_BAR; PG8_WAIT_L(0); PG8_MMA(0, 1, At, B1); PG8_BAR;
            PG8_LDA(At, 1, 1); PG8_STAGE(PG8_SA(1, 0), a3, voffA);
            PG8_BAR; PG8_WAIT_L(0); PG8_MMA(1, 0, At, B0); PG8_BAR; PG8_SCHED;
            PG8_STAGE(PG8_SB(1, 1), b3 + hstep, voffB);
            PG8_WAIT_V(6); PG8_BAR; PG8_MMA(1, 1, At, B1); PG8_BAR;
            }
        }
        if constexpr (ALIGN_EPI) { if (wr == 0) PG8_BAR; }
        if constexpr (!Epi::AFTER_DRAIN) { E(acc, cur, wr, wc, fr, fq); S.done(cur); }
        if (!has_next) break;
#pragma unroll
        for (int a = 0; a < 2; ++a)
#pragma unroll
            for (int b = 0; b < 2; ++b)
#pragma unroll
                for (int m = 0; m < 4; ++m)
#pragma unroll
                    for (int n = 0; n < 2; ++n) acc[a][b][m][n] = (f32x4){0.f, 0.f, 0.f, 0.f};
        cur = nxt; cA = nA; cB = nB; ++ui;
        if constexpr (ALIGN_EPI) { if (wr == 1) PG8_BAR; }
    }
    PG8_WAIT_V(0);
    if constexpr (!ALIGN_EPI) { if (wr == 0) PG8_BAR; }
    PG8_BAR;
    if constexpr (Epi::AFTER_DRAIN) { E.fused(acc, cur, wr, wc, fr, fq, lds, wid, lane); S.done(cur); }
#undef PG8_SA
#undef PG8_SB
#undef PG8_STAGE
#undef PG8_LDA
#undef PG8_LDB
#undef PG8_MMA
#undef PG8_WAIT_V
#undef PG8_WAIT_L
#undef PG8_BAR
#undef PG8_SCHED
}
}

#define LAS __attribute__((address_space(3)))
typedef unsigned short bf16;
typedef float f32x4 __attribute__((ext_vector_type(4)));
typedef float f32x2 __attribute__((ext_vector_type(2)));
typedef short bf16x8 __attribute__((ext_vector_type(8)));
typedef short bf16x4 __attribute__((ext_vector_type(4)));
typedef unsigned v4u __attribute__((ext_vector_type(4)));
typedef unsigned v2u __attribute__((ext_vector_type(2)));
typedef _Float16 h2 __attribute__((ext_vector_type(2)));
typedef _Float16 h4 __attribute__((ext_vector_type(4)));
typedef _Float16 h8 __attribute__((ext_vector_type(8)));

constexpr int DM = 1024, NBATCH = 8, SEQ = 4096, CTXL = 256, DEPTH = 4, DFF = 2816, DIN = 2720, DINP = 2816;
constexpr int ML = NBATCH * SEQ, MC = NBATCH * CTXL, MA = ML + MC;
constexpr int LORA_K = 512, LORA_N = 1536;
constexpr float ALPHA = 1.681792830507429f;
constexpr float LN_EPS = 1e-6f;
constexpr int PC_GQ = 0, PC_GK = 128, PC_GV = 256, PC_GG = 512, PC_ZF = 768, PC_SQ = 800, PC_SK = 1312, PC_SV = 1440, PC_RW = 1568;
constexpr int LC_DEC = 0, LC_A = 512, LC_G = 1024, LC_LG = 1280;
constexpr int RF_R = 0, RF_K = 256, RF_V = 512, RF_KK = 768;

constexpr size_t MiB = 1u << 20;
constexpr size_t WS_STATS = 131072;
constexpr size_t WS_MOD = 1 * MiB;
constexpr size_t WS_WGU1 = 3 * MiB;
constexpr size_t WS_WD1 = WS_WGU1 + 11 * MiB;
constexpr size_t WS_WGU2 = WS_WD1 + 6 * MiB;
constexpr size_t WS_WD2 = WS_WGU2 + 11 * MiB;
constexpr size_t WS_WIN = WS_WD2 + 6 * MiB;
constexpr size_t WS_WOUT = WS_WIN + 6 * MiB;
constexpr size_t WS_WLORA = WS_WOUT + 2 * MiB;
constexpr size_t WS_XC = WS_WLORA + 2 * MiB;
constexpr size_t WS_U = WS_XC + 8 * MiB;
constexpr size_t WS_HID = WS_U + 68 * MiB;
constexpr size_t WS_LO = WS_HID + 187 * MiB;
constexpr size_t WS_RF = WS_LO + 102 * MiB;
constexpr size_t WS_YO = WS_RF + 68 * MiB;
constexpr size_t WS_KV = WS_YO + 68 * MiB;
constexpr size_t WS_ST = WS_KV + 17 * MiB;
constexpr size_t WS_DEC = WS_ST + 17 * MiB;
constexpr size_t WS_END = WS_DEC + 1 * MiB;
constexpr int LDS_BYTES = 135168;

struct Args { const float* in[31]; float* out; unsigned char* ws; };
enum { I_X = 0, I_C, I_CTX, I_CCTX, I_WADA, I_BADA, I_F1G, I_F1U, I_F1D, I_F2G, I_F2U, I_F2D, I_LNG, I_LNB, I_WIN, I_WOUT, I_GUP, I_GBIAS, I_GNORM, I_SINK,
       I_MU, I_W0, I_WUP, I_A0, I_AUP, I_GUPR, I_KK, I_KA, I_RK, I_GNG, I_GNB };

__device__ __forceinline__ unsigned f2bf(float f) { unsigned u = __builtin_bit_cast(unsigned, f); return (u + 0x7fffu + ((u >> 16) & 1u)) >> 16; }
__device__ __forceinline__ unsigned pk2(float lo, float hi) { return f2bf(lo) | (f2bf(hi) << 16); }
__device__ __forceinline__ float bf2f(unsigned short u) { return __builtin_bit_cast(float, (unsigned)u << 16); }
__device__ __forceinline__ float bflo(unsigned u) { return __builtin_bit_cast(float, u << 16); }
__device__ __forceinline__ float bfhi(unsigned u) { return __builtin_bit_cast(float, u & 0xffff0000u); }
__device__ __forceinline__ float sigmoidf_(float x) { return 1.0f / (1.0f + __expf(-x)); }
__device__ __forceinline__ int otid() { int t = threadIdx.x; asm volatile("" : "+v"(t)); return t; }
__device__ __forceinline__ int obid() { int t = blockIdx.x; asm volatile("" : "+s"(t)); return t; }
__device__ __forceinline__ int ogdim() { int t = gridDim.x; asm volatile("" : "+s"(t)); return t; }
#define LDS_WAIT() asm volatile("s_waitcnt lgkmcnt(0)" ::: "memory")
template <int CTRL> __device__ __forceinline__ float dpp_f(float x) { return __builtin_bit_cast(float, __builtin_amdgcn_update_dpp(0, __builtin_bit_cast(int, x), CTRL, 0xF, 0xF, false)); }
__device__ __forceinline__ float allred16(float x) {
    x += dpp_f<0x128>(x); x += dpp_f<0x124>(x); x += dpp_f<0x122>(x); x += dpp_f<0x121>(x); return x;
}
__device__ __forceinline__ float wave_sum(float v) {
#pragma unroll
    for (int o = 1; o < 64; o <<= 1) v += __shfl_xor(v, o);
    return v;
}

__device__ __forceinline__ void phase_adaln(const Args& a, float* MOD, LAS unsigned char* lds) {
    LAS float* s = (LAS float*)lds;
    LAS float* red = s + 9 * 1024;
    const int tid = otid();
    for (int i = tid; i < 9 * 1024; i += 512) { const int bi = i >> 10, k = i & 1023; const float c = bi < 8 ? a.in[I_C][bi * 1024 + k] : a.in[I_CCTX][k]; s[i] = c * sigmoidf_(c); }
    __syncthreads();
    for (int unit = obid(); unit < 288; unit += ogdim()) {
        const int l = unit / 72, cb = unit % 72, col = cb * 128 + (tid & 127), kq = tid >> 7;
        const float* w = a.in[I_WADA] + (size_t)l * 1024 * 9216 + col;
        float acc[9];
#pragma unroll
        for (int bi = 0; bi < 9; ++bi) acc[bi] = 0.f;
#pragma unroll 8
        for (int k = kq * 256; k < kq * 256 + 256; ++k) { const float wv = w[(size_t)k * 9216];
#pragma unroll
            for (int bi = 0; bi < 9; ++bi) acc[bi] += s[bi * 1024 + k] * wv; }
#pragma unroll
        for (int bi = 0; bi < 9; ++bi) red[tid * 9 + bi] = acc[bi];
        __syncthreads();
        if (kq == 0) { const float bb = a.in[I_BADA][l * 9216 + col];
#pragma unroll
            for (int bi = 0; bi < 9; ++bi) { const float v = red[tid * 9 + bi] + red[(tid + 128) * 9 + bi] + red[(tid + 256) * 9 + bi] + red[(tid + 384) * 9 + bi] + bb;
                MOD[(size_t)(l * 9 + bi) * 9216 + col] = v; } }
        __syncthreads();
    }
}

__device__ __forceinline__ void transpose_item(const float* W, int K, int N, bf16* WT, int kb, int nb, int drow0, LAS float* scr, int lane) {
    const int k0 = 64 * kb, n0 = 32 * nb;
#pragma unroll 8
    for (int i = 0; i < 32; ++i) { const int kk = 2 * i + (lane >> 5); scr[kk * 33 + (lane & 31)] = W[(size_t)(k0 + kk) * N + n0 + (lane & 31)]; }
    LDS_WAIT(); asm volatile("" ::: "memory");
    const int c = lane & 7;
#pragma unroll
    for (int j = 0; j < 4; ++j) { const int n = (lane >> 3) + 8 * j; const LAS float* sp = scr + (8 * c) * 33 + n;
        v4u o; o.x = pk2(sp[0 * 33], sp[1 * 33]); o.y = pk2(sp[2 * 33], sp[3 * 33]); o.z = pk2(sp[4 * 33], sp[5 * 33]); o.w = pk2(sp[6 * 33], sp[7 * 33]);
        *(v4u*)(WT + (size_t)(drow0 + n) * K + k0 + 8 * c) = o; }
    LDS_WAIT(); asm volatile("" ::: "memory");
}
__device__ __forceinline__ void phase_convert(const Args& a, int l, unsigned char* ws, LAS unsigned char* lds) {
    const int tid = otid(), lane = tid & 63, wave = __builtin_amdgcn_readfirstlane(tid >> 6);
    LAS float* scr = (LAS float*)(lds + wave * 8704);
    const int gw = obid() * 8 + wave, NGW = ogdim() * 8;
    constexpr int I_GU = 16 * 88, I_D = 44 * 32, I_IN = 16 * 85, I_OUT = 16 * 32;
    constexpr int NIT = 4 * I_GU + 2 * I_D + I_IN + I_OUT;
    for (int it = gw; it < NIT; it += NGW) {
        int r = it;
        if (r < 4 * I_GU) { const int which = r / I_GU; r -= which * I_GU; const int kb = r / 88, nb = r % 88;
            const float* W = a.in[which == 0 ? I_F1G : which == 1 ? I_F1U : which == 2 ? I_F2G : I_F2U] + (size_t)l * 1024 * DFF;
            bf16* WT = (bf16*)(ws + (which < 2 ? WS_WGU1 : WS_WGU2));
            const int n0 = 32 * nb, drow0 = (n0 >> 7) * 256 + (which & 1) * 128 + (n0 & 127);
            transpose_item(W, 1024, DFF, WT, kb, nb, drow0, scr, lane); continue; }
        r -= 4 * I_GU;
        if (r < 2 * I_D) { const int which = r / I_D; r -= which * I_D; const int kb = r / 32, nb = r % 32;
            const float* W = a.in[which == 0 ? I_F1D : I_F2D] + (size_t)l * DFF * 1024;
            transpose_item(W, DFF, 1024, (bf16*)(ws + (which == 0 ? WS_WD1 : WS_WD2)), kb, nb, 32 * nb, scr, lane); continue; }
        r -= 2 * I_D;
        if (r < I_IN) { const int kb = r / 85, nb = r % 85;
            transpose_item(a.in[I_WIN] + (size_t)l * 1024 * DIN, 1024, DIN, (bf16*)(ws + WS_WIN), kb, nb, 32 * nb, scr, lane); continue; }
        r -= I_IN;
        { const int kb = r / 32, nb = r % 32; transpose_item(a.in[I_WOUT] + (size_t)l * 1024 * 1024, 1024, 1024, (bf16*)(ws + WS_WOUT), kb, nb, 32 * nb, scr, lane); }
    }
    const int gt = obid() * 512 + tid, NGT = ogdim() * 512;
    for (int i = gt; i < 96 * 1024 / 8; i += NGT) *(v4u*)((bf16*)(ws + WS_WIN) + (size_t)DIN * 1024 + (size_t)i * 8) = (v4u){0u, 0u, 0u, 0u};
    const float* wup = a.in[I_WUP] + (size_t)l * 2 * 64 * 256; const float* aup = a.in[I_AUP] + (size_t)l * 2 * 64 * 256;
    const float* gup = a.in[I_GUPR] + (size_t)l * 128 * 256; const float* ggu = a.in[I_GUP] + (size_t)l * 2 * 16 * 128;
    for (int ci = gt; ci < LORA_N * LORA_K / 8; ci += NGT) {
        const int n = ci >> 6, k8 = (ci & 63) * 8; float v[8];
#pragma unroll
        for (int e = 0; e < 8; ++e) v[e] = 0.f;
        const float* src = nullptr; int stride = 0;
        if (n < 256)       { if (k8 < 64)                 { src = wup + (size_t)k8 * 256 + n; stride = 256; } }
        else if (n < 512)  { if (k8 >= 64 && k8 < 128)    { src = wup + 64 * 256 + (size_t)(k8 - 64) * 256 + (n - 256); stride = 256; } }
        else if (n < 768)  { if (k8 >= 128 && k8 < 192)   { src = aup + (size_t)(k8 - 128) * 256 + (n - 512); stride = 256; } }
        else if (n < 1024) { if (k8 >= 192 && k8 < 256)   { src = aup + 64 * 256 + (size_t)(k8 - 192) * 256 + (n - 768); stride = 256; } }
        else if (n < 1280) { if (k8 >= 256 && k8 < 384)   { src = gup + (size_t)(k8 - 256) * 256 + (n - 1024); stride = 256; } }
        else if (n < 1408) { if (k8 >= 384 && k8 < 400)   { src = ggu + (size_t)(k8 - 384) * 128 + (n - 1280); stride = 128; } }
        else               { if (k8 >= 400 && k8 < 416)   { src = ggu + 16 * 128 + (size_t)(k8 - 400) * 128 + (n - 1408); stride = 128; } }
        if (src) {
#pragma unroll
            for (int e = 0; e < 8; ++e) v[e] = src[(size_t)e * stride]; }
        v4u o; o.x = pk2(v[0], v[1]); o.y = pk2(v[2], v[3]); o.z = pk2(v[4], v[5]); o.w = pk2(v[6], v[7]);
        *(v4u*)((bf16*)(ws + WS_WLORA) + (size_t)n * LORA_K + k8) = o;
    }
}

__device__ __forceinline__ float* xrow_ptr(float* xlat, float* xctx, int row) { return row < ML ? xlat + (size_t)row * 1024 : xctx + (size_t)(row - ML) * 1024; }
__device__ __forceinline__ int row_bi(int row) { return row < ML ? (row >> 12) : 8; }

__device__ __forceinline__ void phase_mod0(const Args& a, const float* MOD, bf16* U) {
    const int lane = otid() & 63, gw = obid() * 8 + (otid() >> 6), NGW = ogdim() * 8;
    for (int row = gw; row < MA; row += NGW) {
        const float* xr = row < ML ? a.in[I_X] + (size_t)row * 1024 : a.in[I_CTX] + (size_t)(row - ML) * 1024;
        const float* mp = MOD + (size_t)row_bi(row) * 9216;
#pragma unroll
        for (int j = 0; j < 4; ++j) { const int c = 4 * lane + 256 * j; const f32x4 v = *(const f32x4*)(xr + c), sh = *(const f32x4*)(mp + c), sc = *(const f32x4*)(mp + 1024 + c);
            const f32x4 o = v * (sc + 1.0f) + sh; v2u w; w.x = pk2(o.x, o.y); w.y = pk2(o.z, o.w); *(v2u*)(U + (size_t)row * 1024 + c) = w; }
    }
}
__device__ __forceinline__ void phase_ln(float* xlat, float* xctx, const float* lng, const float* lnb, const float* modn, bf16* U, int nrows, bool write_u, float* stats, bool write_x) {
    const int lane = otid() & 63, gw = obid() * 8 + (otid() >> 6), NGW = ogdim() * 8;
    for (int row = gw; row < nrows; row += NGW) {
        float* xr = xrow_ptr(xlat, xctx, row);
        f32x4 v[4]; float s = 0.f;
#pragma unroll
        for (int j = 0; j < 4; ++j) { v[j] = *(const f32x4*)(xr + 4 * lane + 256 * j); s += (v[j].x + v[j].y) + (v[j].z + v[j].w); }
        const float mean = wave_sum(s) * (1.0f / 1024.0f); float s2 = 0.f;
#pragma unroll
        for (int j = 0; j < 4; ++j) { v[j] = v[j] - mean; s2 += (v[j].x * v[j].x + v[j].y * v[j].y) + (v[j].z * v[j].z + v[j].w * v[j].w); }
        const float rstd = 1.0f / sqrtf(wave_sum(s2) * (1.0f / 1024.0f) + LN_EPS);
        const float* mp = modn + (size_t)row_bi(row) * 9216;
        if (lane == 0) *(f32x2*)(stats + 2 * (size_t)row) = (f32x2){mean, rstd};
#pragma unroll
        for (int j = 0; j < 4; ++j) { const int c = 4 * lane + 256 * j; const f32x4 h = v[j] * rstd * *(const f32x4*)(lng + c) + *(const f32x4*)(lnb + c);
            if (write_x) *(f32x4*)(xr + c) = h;
            if (write_u) { const f32x4 sh = *(const f32x4*)(mp + c), sc = *(const f32x4*)(mp + 1024 + c); const f32x4 o = h * (sc + 1.0f) + sh;
                v2u w; w.x = pk2(o.x, o.y); w.y = pk2(o.z, o.w); *(v2u*)(U + (size_t)row * 1024 + c) = w; } }
    }
}

__device__ __forceinline__ void phase_features(const Args& a, int l, bf16* P, _Float16* RF, bf16* AP, LAS unsigned char* lds) {
    LAS f32x2* tab = (LAS f32x2*)lds;
    const int tid = otid(), lane = tid & 63;
    for (int i = tid; i < 1024; i += 512) { const int pos = i >> 4, fi = i & 15; const float inv = exp2f(-(float)fi * (13.287712379549449f / 16.0f)); const float ang = (float)pos * inv;
        tab[i] = (f32x2){cosf(ang), sinf(ang)}; }
    __syncthreads();
    const float* mu = a.in[I_MU] + l * 1152; const float* kkw = a.in[I_KK] + l * 256;
    const int gw = obid() * 8 + (tid >> 6), NGW = ogdim() * 8;
    for (int row = gw; row < MA; row += NGW) {
        const bool lat = row < ML; const int t = lat ? (row & 4095) : ((row - ML) & 255); const int len = lat ? SEQ : CTXL;
        bf16* pr = P + (size_t)row * DINP;
        const float hp = t > 0 ? 0.5f : 0.f, hn = t < len - 1 ? 0.5f : 0.f;
        const bf16* rw = pr + PC_RW; const bf16* rwp = t > 0 ? rw - DINP : rw; const bf16* rwn = t < len - 1 ? rw + DINP : rw;
        _Float16* rf = RF + (size_t)row * 1024; bf16* ap = AP + (size_t)row * LORA_K;
#pragma unroll
        for (int j = 0; j < 9; ++j) {
            const int col = 2 * (lane + 64 * j);
            const unsigned uc = *(const unsigned*)(rw + col), up = *(const unsigned*)(rwp + col), un = *(const unsigned*)(rwn + col);
            const f32x2 m2 = *(const f32x2*)(mu + col);
            const float c0 = bflo(uc), c1 = bfhi(uc);
            const float f0 = c0 + m2.x * (hp * bflo(up) + hn * bflo(un) - c0), f1 = c1 + m2.y * (hp * bfhi(up) + hn * bfhi(un) - c1);
            if (j < 2) { *(h2*)(rf + RF_R + col) = (h2){(_Float16)f0, (_Float16)f1}; }
            else if (j < 4) { const int kc = col - 256; *(h2*)(rf + RF_K + kc) = (h2){(_Float16)f0, (_Float16)f1};
                const f32x2 kw = *(const f32x2*)(kkw + kc); const float q0 = f0 * kw.x, q1 = f1 * kw.y; float ss = q0 * q0 + q1 * q1;
#pragma unroll
                for (int o = 1; o < 32; o <<= 1) ss += __shfl_xor(ss, o);
                const float inv = 1.0f / fmaxf(sqrtf(ss), 1e-12f);
                *(h2*)(rf + RF_KK + kc) = (h2){(_Float16)(q0 * inv), (_Float16)(q1 * inv)}; }
            else if (j < 6) { *(h2*)(rf + RF_V + (col - 512)) = (h2){(_Float16)f0, (_Float16)f1}; }
            else if (j == 6) { *(unsigned*)(ap + (col - 768)) = pk2(tanhf(f0), tanhf(f1)); }
            else if (j == 7) { *(unsigned*)(ap + 128 + (col - 896)) = pk2(f0, f1); }
            else { *(unsigned*)(ap + 256 + (col - 1024)) = pk2(sigmoidf_(f0), sigmoidf_(f1)); }
        }
        { unsigned z = 0u; if (lane < 16) z = *(const unsigned*)(pr + PC_ZF + 2 * lane); *(unsigned*)(ap + 384 + 2 * lane) = z; }
#pragma unroll
        for (int j = 0; j < 5; ++j) {
            const int head = 2 * j + (lane >> 5), pi = lane & 31, fi = pi & 15;
            const int d1 = pi < 16 ? pi : 16 + pi, pos = pi < 16 ? (t >> 6) : (t & 63);
            bf16* hb = pr + (head < 8 ? PC_SQ + head * 64 : PC_SK + (head - 8) * 64);
            const float x1 = bf2f(hb[d1]), x2 = bf2f(hb[d1 + 16]);
            float o1 = x1, o2 = x2;
            if (lat) { const f32x2 cs = tab[pos * 16 + fi]; o1 = x1 * cs.x - x2 * cs.y; o2 = x1 * cs.y + x2 * cs.x; }
            if (head < 8) { o1 *= 0.125f; o2 *= 0.125f; }
            if (lat || head < 8) { hb[d1] = (bf16)f2bf(o1); hb[d1 + 16] = (bf16)f2bf(o2); }
        }
    }
}

__device__ __forceinline__ void phase_rwkv(const Args& a, int l, const _Float16* RF, const _Float16* LO, _Float16* YO, LAS unsigned char* lds) {
    constexpr int T = 32, SF = 336, NCH = (CTXL + SEQ) / T;
    LAS float* buf = (LAS float*)lds; LAS float* ybuf = buf + 2 * T * SF;
    const int tid = otid(), wave = __builtin_amdgcn_readfirstlane(tid >> 6), lane = tid & 63;
    for (int unit = obid(); unit < 256; unit += ogdim()) {
        const int chain = unit >> 2, rq = unit & 3, b = chain >> 3, h = (chain >> 1) & 3, dir = chain & 1;
        _Float16* Y = YO + (size_t)dir * MA * 256;
        const int ltid = tid - 256, lstep = ltid >> 3, lkq = ltid & 7, cols = h * 64 + 8 * lkq;
        float ka[8];
        if (wave >= 4) {
#pragma unroll
            for (int e = 0; e < 8; ++e) ka[e] = a.in[I_KA][l * 256 + cols + e]; }
        auto step_row = [&](int s) -> int { if (s < CTXL) return ML + b * CTXL + (dir ? CTXL - 1 - s : s); const int tq = s - CTXL; return b * SEQ + (dir ? SEQ - 1 - tq : tq); };
        h8 s0r, s0k, s0v, s0q, s0w, s0a, s1r, s1k, s1v, s1q, s1w, s1a, s2r, s2k, s2v, s2q, s2w, s2a;
#define RW_LOAD(c, R8, K8, V8, Q8, W8, A8) do { const int row_ = step_row((c) * T + lstep); \
            const _Float16* rf_ = RF + (size_t)row_ * 1024 + cols; const _Float16* lo_ = LO + (size_t)row_ * 1536 + dir * 256 + cols; \
            R8 = *(const h8*)(rf_ + RF_R); K8 = *(const h8*)(rf_ + RF_K); V8 = *(const h8*)(rf_ + RF_V); Q8 = *(const h8*)(rf_ + RF_KK); \
            W8 = *(const h8*)(lo_ + LC_DEC); A8 = *(const h8*)(lo_ + LC_A); } while (0)
#define RW_WRITE(c, R8, K8, V8, Q8, W8, A8) do { LAS float* d_ = buf + ((c) & 1) * T * SF + lstep * SF + 8 * lkq; \
            _Pragma("unroll") for (int e = 0; e < 8; ++e) { const float kk_ = (float)Q8[e], av_ = (float)A8[e], kv_ = (float)K8[e]; \
                d_[e] = kk_; d_[64 + e] = (float)W8[e]; d_[128 + e] = kk_ * av_; d_[192 + e] = kv_ * (1.0f + (av_ - 1.0f) * ka[e]); d_[256 + e] = (float)R8[e]; } \
            if ((lkq >> 1) == rq) { LAS float* dv_ = buf + ((c) & 1) * T * SF + lstep * SF + 320 + (lkq & 1) * 8; \
                _Pragma("unroll") for (int e = 0; e < 8; ++e) dv_[e] = (float)V8[e]; } } while (0)
        auto flush_y = [&](int c) {
            const int row = step_row(c * T + lstep);
            const LAS float* yb = ybuf + (c & 1) * T * 16 + lstep * 16 + 2 * lkq;
            *(h2*)(Y + (size_t)row * 256 + h * 64 + rq * 16 + 2 * lkq) = (h2){(_Float16)yb[0], (_Float16)yb[1]};
        };
        f32x4 S = (f32x4){0.f, 0.f, 0.f, 0.f};
        const int kg = lane & 15, ri = wave * 4 + (lane >> 4);
#define RW_BAR() do { asm volatile("s_waitcnt lgkmcnt(0)" ::: "memory"); __builtin_amdgcn_s_barrier(); asm volatile("" ::: "memory"); } while (0)
#define LSET(c, P) RW_LOAD(c, P##r, P##k, P##v, P##q, P##w, P##a)
#define WSET(c, P) RW_WRITE(c, P##r, P##k, P##v, P##q, P##w, P##a)
        if (wave >= 4) {
            LSET(0, s0); WSET(0, s0); LSET(1, s1); LSET(2, s2);
            RW_BAR();
            for (int c = 0; c < NCH; c += 3) {
                if (c + 3 < NCH) LSET(c + 3, s0);
                if (c + 1 < NCH) WSET(c + 1, s1);
                if (c > 0) flush_y(c - 1);
                RW_BAR();
                if (c + 1 < NCH) {
                    if (c + 4 < NCH) LSET(c + 4, s1);
                    if (c + 2 < NCH) WSET(c + 2, s2);
                    flush_y(c);
                    RW_BAR();
                }
                if (c + 2 < NCH) {
                    if (c + 5 < NCH) LSET(c + 5, s2);
                    if (c + 3 < NCH) WSET(c + 3, s0);
                    flush_y(c + 1);
                    RW_BAR();
                }
            }
        } else {
            RW_BAR();
            for (int c = 0; c < NCH; ++c) {
                const LAS float* bc = buf + (c & 1) * T * SF + 4 * kg; const LAS float* vb = buf + (c & 1) * T * SF + 320 + ri;
                LAS float* yw = (kg == 0) ? (ybuf + (c & 1) * T * 16 + ri) : (ybuf + 2 * T * 16 + lane);
                f32x4 Akk, Aw, Ab, Akd, Ar, Bkk, Bw, Bb, Bkd, Br, Ckk, Cw, Cb, Ckd, Cr; float Av, Bv, Cv;
                const unsigned bca = (unsigned)(uintptr_t)bc, vba = (unsigned)(uintptr_t)vb, ywa = (unsigned)(uintptr_t)yw;
#define RW_LD(X, s_) asm volatile("ds_read_b128 %0, %7 offset:%9\n\tds_read_b128 %1, %7 offset:%10\n\tds_read_b128 %2, %7 offset:%11\n\tds_read_b128 %3, %7 offset:%12\n\tds_read_b128 %4, %7 offset:%13\n\tds_read_b32 %5, %8 offset:%9" \
                    : "=&v"(X##kk), "=&v"(X##w), "=&v"(X##b), "=&v"(X##kd), "=&v"(X##r), "=&v"(X##v), "+v"(S) : "v"(bca), "v"(vba), "n"((s_) * SF * 4), "n"((s_) * SF * 4 + 256), "n"((s_) * SF * 4 + 512), "n"((s_) * SF * 4 + 768), "n"((s_) * SF * 4 + 1024))
#define RW_WAIT(X) asm volatile("s_waitcnt lgkmcnt(0)" : "+v"(X##kk), "+v"(X##w), "+v"(X##b), "+v"(X##kd), "+v"(X##r), "+v"(X##v), "+v"(S))
#define RW_YW(s_, Y_) asm volatile("ds_write_b32 %0, %1 offset:%2" :: "v"(ywa), "v"(Y_), "n"((s_) * 64) : "memory")
#define RW_DOT(V_, W_) __builtin_fmaf(V_.w, W_.w, __builtin_fmaf(V_.z, W_.z, __builtin_fmaf(V_.y, W_.y, V_.x * W_.x)))
#define RW_BODY(s_, X, Xn, Xnn, Xp) do { if ((s_) < T) { float yp_ = 0.f; \
                    if ((s_) > 0) yp_ = allred16(RW_DOT(S, Xp##r)); \
                    const f32x4 u_ = S * X##w + X##kd * X##v; const float sa_ = allred16(RW_DOT(S, X##kk)); S = u_ - X##b * sa_; \
                    if ((s_) + 1 < T) RW_WAIT(Xn); if ((s_) > 0) RW_YW((s_) - 1, yp_); if ((s_) + 2 < T) RW_LD(Xnn, (s_) + 2); } } while (0)
                RW_LD(A, 0); RW_LD(B, 1); RW_WAIT(A);
#pragma unroll
                for (int s = 0; s < T + 2; s += 3) { RW_BODY(s, A, B, C, C); RW_BODY(s + 1, B, C, A, A); RW_BODY(s + 2, C, A, B, B); }
                { const float yl_ = allred16(RW_DOT(S, Br)); RW_YW(T - 1, yl_); }
                static_assert(T == 32, "the tail above assumes (T - 1) % 3 == 1");
#undef RW_WAIT
#undef RW_YW
#undef RW_LD
#undef RW_DOT
#undef RW_BODY
                RW_BAR();
            }
        }
#undef LSET
#undef WSET
#undef RW_BAR
        if (wave >= 4) flush_y(NCH - 1);
        __syncthreads();
    }
#undef RW_LOAD
#undef RW_WRITE
}

template <int CTRL> __device__ __forceinline__ float dpp0_f(float x) { return __builtin_bit_cast(float, __builtin_amdgcn_update_dpp(0, __builtin_bit_cast(int, x), CTRL, 0xF, 0xF, true)); }
__device__ __forceinline__ void phase_gla_a(int l, bf16* P, const _Float16* LO, _Float16* YO, _Float16* KV, float* DEC, LAS unsigned char* lds) {
    LAS bf16* Vt = (LAS bf16*)lds;
    LAS bf16* KhT = Vt + 4 * 64 * 72;
    const int tid = otid(), wave = __builtin_amdgcn_readfirstlane(tid >> 6), lane = tid & 63, r = lane & 15, kq = lane >> 4, h = wave >> 1, dir = wave & 1;
    LAS bf16* Vh = Vt + h * 64 * 72; LAS bf16* Kw = KhT + wave * 32 * 72;
    for (int unit = obid(); unit < 544; unit += ogdim()) {
        const int b = unit / 68, cc = unit % 68; const int row0 = cc < 4 ? ML + b * CTXL + cc * 64 : b * SEQ + (cc - 4) * 64;
        const int u = ((b * 4 + h) * 2 + dir) * 68 + cc;
        __syncthreads();
        {   const int j = tid >> 3, c8 = tid & 7; const bf16* src = P + (size_t)(row0 + j) * DINP + PC_GV;
#pragma unroll
            for (int q = 0; q < 4; ++q) { const int col = 8 * (c8 + 8 * q); const v4u v8 = *(const v4u*)(src + col);
                LAS bf16* vd = Vt + (col >> 6) * 64 * 72 + (col & 63) * 72 + j;
                vd[0 * 72] = (bf16)(v8.x & 0xffffu); vd[1 * 72] = (bf16)(v8.x >> 16); vd[2 * 72] = (bf16)(v8.y & 0xffffu); vd[3 * 72] = (bf16)(v8.y >> 16);
                vd[4 * 72] = (bf16)(v8.z & 0xffffu); vd[5 * 72] = (bf16)(v8.z >> 16); vd[6 * 72] = (bf16)(v8.w & 0xffffu); vd[7 * 72] = (bf16)(v8.w >> 16); } }
        v4u q8[4], k8[4]; h8 g8[4];
#pragma unroll
        for (int ib = 0; ib < 4; ++ib) { const size_t row = (size_t)(row0 + 16 * ib + r);
            q8[ib] = *(const v4u*)(P + row * DINP + PC_GQ + h * 32 + 8 * kq); k8[ib] = *(const v4u*)(P + row * DINP + PC_GK + h * 32 + 8 * kq);
            g8[ib] = *(const h8*)(LO + row * 1536 + LC_LG + dir * 128 + h * 32 + 8 * kq); }
        __syncthreads();
        float pre[4][8], G[8];
#pragma unroll
        for (int e = 0; e < 8; ++e) { float carry = 0.f;
#pragma unroll
            for (int ib = 0; ib < 4; ++ib) { const float g = (float)g8[ib][e]; float x = g;
                x += dpp0_f<0x111>(x); x += dpp0_f<0x112>(x); x += dpp0_f<0x114>(x); x += dpp0_f<0x118>(x);
                pre[ib][e] = x + carry; carry += allred16(g); }
            G[e] = carry; }
        bf16x8 qf[4], kf[4];
#pragma unroll
        for (int ib = 0; ib < 4; ++ib) { float qs[8], ks[8], kh[8];
            const unsigned qu[4] = {q8[ib].x, q8[ib].y, q8[ib].z, q8[ib].w}, ku[4] = {k8[ib].x, k8[ib].y, k8[ib].z, k8[ib].w};
#pragma unroll
            for (int e = 0; e < 8; ++e) { const float qv = (e & 1) ? bfhi(qu[e >> 1]) : bflo(qu[e >> 1]), kv = (e & 1) ? bfhi(ku[e >> 1]) : bflo(ku[e >> 1]);
                const float bb = dir ? (G[e] - pre[ib][e] + (float)g8[ib][e]) : pre[ib][e];
                qs[e] = qv * 0.17677669529663687f * __expf(bb); ks[e] = kv * __expf(-bb); kh[e] = kv * __expf(G[e] - bb);
                Kw[(8 * kq + e) * 72 + 16 * ib + r] = (bf16)f2bf(kh[e]); }
            v4u qw, kw; qw.x = pk2(qs[0], qs[1]); qw.y = pk2(qs[2], qs[3]); qw.z = pk2(qs[4], qs[5]); qw.w = pk2(qs[6], qs[7]);
            kw.x = pk2(ks[0], ks[1]); kw.y = pk2(ks[2], ks[3]); kw.z = pk2(ks[4], ks[5]); kw.w = pk2(ks[6], ks[7]);
            qf[ib] = __builtin_bit_cast(bf16x8, qw); kf[ib] = __builtin_bit_cast(bf16x8, kw);
            *(v4u*)(P + (size_t)(row0 + 16 * ib + r) * DINP + (dir ? PC_GK : PC_GQ) + h * 32 + 8 * kq) = qw; }
        if (r == 0) {
#pragma unroll
            for (int e = 0; e < 8; ++e) DEC[(size_t)u * 32 + 8 * kq + e] = __expf(G[e]); }
        LDS_WAIT(); asm volatile("" ::: "memory");
#pragma unroll
        for (int ib = 0; ib < 4; ++ib) {
            f32x4 oT[4];
#pragma unroll
            for (int eb = 0; eb < 4; ++eb) oT[eb] = (f32x4){0.f, 0.f, 0.f, 0.f};
#pragma unroll
            for (int kk = 0; kk < 2; ++kk) {
                const bool any = dir ? (2 * kk + 1 >= ib) : (2 * kk <= ib);
                if (any) {
                    f32x4 sb[2];
#pragma unroll
                    for (int x = 0; x < 2; ++x) { const int jb = 2 * kk + x; sb[x] = (f32x4){0.f, 0.f, 0.f, 0.f};
                        const bool need = dir ? (jb >= ib) : (jb <= ib);
                        if (need) { sb[x] = __builtin_amdgcn_mfma_f32_16x16x32_bf16(kf[jb], qf[ib], sb[x], 0, 0, 0);
                            if (jb == ib) {
#pragma unroll
                                for (int reg = 0; reg < 4; ++reg) { const int jj = 4 * kq + reg; const bool keep = dir ? (jj >= r) : (jj <= r); if (!keep) sb[x][reg] = 0.f; } } } }
                    v4u pw; pw.x = pk2(sb[0][0], sb[0][1]); pw.y = pk2(sb[0][2], sb[0][3]); pw.z = pk2(sb[1][0], sb[1][1]); pw.w = pk2(sb[1][2], sb[1][3]);
                    const bf16x8 pf = __builtin_bit_cast(bf16x8, pw);
#pragma unroll
                    for (int eb = 0; eb < 4; ++eb) { const LAS bf16* vp = Vh + (16 * eb + r) * 72 + 32 * kk + 4 * kq;
                        const v2u va = *(const LAS v2u*)vp, vb = *(const LAS v2u*)(vp + 16);
                        const bf16x8 vf = __builtin_bit_cast(bf16x8, (v4u){va.x, va.y, vb.x, vb.y});
                        oT[eb] = __builtin_amdgcn_mfma_f32_16x16x32_bf16(vf, pf, oT[eb], 0, 0, 0); }
                }
            }
            _Float16* op = YO + ((size_t)(2 + dir) * MA + row0 + 16 * ib + r) * 256 + h * 64 + 4 * kq;
#pragma unroll
            for (int eb = 0; eb < 4; ++eb) *(h4*)(op + 16 * eb) = (h4){(_Float16)oT[eb][0], (_Float16)oT[eb][1], (_Float16)oT[eb][2], (_Float16)oT[eb][3]};
        }
        f32x4 kvt[4][2];
#pragma unroll
        for (int eb = 0; eb < 4; ++eb) { kvt[eb][0] = (f32x4){0.f, 0.f, 0.f, 0.f}; kvt[eb][1] = (f32x4){0.f, 0.f, 0.f, 0.f}; }
#pragma unroll
        for (int kk = 0; kk < 2; ++kk) {
            bf16x8 bfr[2];
#pragma unroll
            for (int nb = 0; nb < 2; ++nb) bfr[nb] = *(const LAS bf16x8*)(Kw + (16 * nb + r) * 72 + 32 * kk + 8 * kq);
#pragma unroll
            for (int eb = 0; eb < 4; ++eb) { const bf16x8 afr = *(const LAS bf16x8*)(Vh + (16 * eb + r) * 72 + 32 * kk + 8 * kq);
                kvt[eb][0] = __builtin_amdgcn_mfma_f32_16x16x32_bf16(afr, bfr[0], kvt[eb][0], 0, 0, 0);
                kvt[eb][1] = __builtin_amdgcn_mfma_f32_16x16x32_bf16(afr, bfr[1], kvt[eb][1], 0, 0, 0); } }
        _Float16* kvp = KV + (size_t)u * 2048;
#pragma unroll
        for (int eb = 0; eb < 4; ++eb)
#pragma unroll
            for (int nb = 0; nb < 2; ++nb)
#pragma unroll
                for (int reg = 0; reg < 4; ++reg) kvp[(16 * eb + 4 * kq + reg) * 32 + 16 * nb + r] = (_Float16)kvt[eb][nb][reg];
    }
}
__device__ __forceinline__ void phase_gla_b(const _Float16* KV, const float* DEC, bf16* ST) {
    for (int g = obid() * 512 + otid(); g < 64 * 2048; g += ogdim() * 512) {
        const int chain = g >> 11, idx = g & 2047, d = idx & 31, dir = chain & 1;
        float S = 0.f;
#pragma unroll 1
        for (int s0 = 0; s0 < 68; s0 += 17) {
            float kvv[17], dc[17]; int uu[17];
#pragma unroll
            for (int x = 0; x < 17; ++x) { const int step = s0 + x; const int cc = dir ? (step < 4 ? 3 - step : 71 - step) : step; uu[x] = chain * 68 + cc;
                kvv[x] = (float)KV[(size_t)uu[x] * 2048 + idx]; dc[x] = DEC[(size_t)uu[x] * 32 + d]; }
#pragma unroll
            for (int x = 0; x < 17; ++x) { ST[(size_t)uu[x] * 2048 + idx] = (bf16)f2bf(S); S = dc[x] * S + kvv[x]; }
        }
    }
}
__device__ __forceinline__ void phase_gla_c(const bf16* P, const bf16* ST, _Float16* YO) {
    const int tid = otid(), wave = __builtin_amdgcn_readfirstlane(tid >> 6), lane = tid & 63, r = lane & 15, kq = lane >> 4, h = wave >> 1, dir = wave & 1;
    for (int unit = obid(); unit < 544; unit += ogdim()) {
        const int b = unit / 68, cc = unit % 68; const int row0 = cc < 4 ? ML + b * CTXL + cc * 64 : b * SEQ + (cc - 4) * 64;
        const int u = ((b * 4 + h) * 2 + dir) * 68 + cc;
        bf16x8 af[4];
#pragma unroll
        for (int eb = 0; eb < 4; ++eb) af[eb] = *(const bf16x8*)(ST + (size_t)u * 2048 + (16 * eb + r) * 32 + 8 * kq);
#pragma unroll
        for (int ib = 0; ib < 4; ++ib) {
            const bf16x8 qf = *(const bf16x8*)(P + (size_t)(row0 + 16 * ib + r) * DINP + (dir ? PC_GK : PC_GQ) + h * 32 + 8 * kq);
            _Float16* op = YO + ((size_t)(2 + dir) * MA + row0 + 16 * ib + r) * 256 + h * 64 + 4 * kq;
#pragma unroll
            for (int eb = 0; eb < 4; ++eb) { f32x4 acc = (f32x4){0.f, 0.f, 0.f, 0.f};
                acc = __builtin_amdgcn_mfma_f32_16x16x32_bf16(af[eb], qf, acc, 0, 0, 0);
                const h4 old = *(const h4*)(op + 16 * eb);
                *(h4*)(op + 16 * eb) = (h4){(_Float16)((float)old[0] + acc[0]), (_Float16)((float)old[1] + acc[1]), (_Float16)((float)old[2] + acc[2]), (_Float16)((float)old[3] + acc[3])}; }
        }
    }
}

__device__ __forceinline__ void phase_swa(const Args& a, int l, const bf16* P, bf16* MIX, bool with_ctx, LAS unsigned char* lds) {
    LAS bf16* Ks = (LAS bf16*)lds;
    LAS bf16* Vt = Ks + 64 * 72;
    const int tid = otid(), wave = __builtin_amdgcn_readfirstlane(tid >> 6), lane = tid & 63, li = lane & 15, lq = lane >> 4;
    const int nunits = with_ctx ? 1088 : 1024;
    for (int u = obid(); u < nunits; u += ogdim()) {
        const bool isctx = u >= 1024;
        int b, kvh, blk;
        if (!isctx) { b = u >> 7; kvh = (u >> 6) & 1; blk = u & 63; } else { const int v = u - 1024; b = v >> 3; kvh = (v >> 2) & 1; blk = v & 3; }
        const int g = wave >> 1, half = wave & 1, hq = kvh * 4 + g;
        const int qtok0 = blk * 64 + half * 32, qrow0 = isctx ? ML + b * CTXL + qtok0 : b * SEQ + qtok0;
        bf16x8 qf[2][2];
#pragma unroll
        for (int qb = 0; qb < 2; ++qb)
#pragma unroll
            for (int ks = 0; ks < 2; ++ks) qf[qb][ks] = *(const bf16x8*)(P + (size_t)(qrow0 + 16 * qb + li) * DINP + PC_SQ + hq * 64 + 32 * ks + 8 * lq);
        f32x4 Oa[4][2];
#pragma unroll
        for (int x = 0; x < 4; ++x)
#pragma unroll
            for (int y = 0; y < 2; ++y) Oa[x][y] = (f32x4){0.f, 0.f, 0.f, 0.f};
        const float sinkv = a.in[I_SINK][l * 8 + hq];
        float mrun[2], lrun[2];
#pragma unroll
        for (int qb = 0; qb < 2; ++qb) { mrun[qb] = sinkv; lrun[qb] = lq == 0 ? 1.0f : 0.f; }
        int lo = 0, nlocal = 0;
        if (!isctx) { lo = 64 * blk - 128; if (lo < 0) lo = 0; int hi = 64 * blk + 192; if (hi > SEQ) hi = SEQ; nlocal = (hi - lo) >> 6; }
        const int ntiles = nlocal + 4;
        const int skey = tid >> 3, sch = tid & 7;
        v4u pk_, pv_;
        {   const int kr0 = nlocal > 0 ? b * SEQ + lo : ML + b * CTXL; const bf16* src = P + (size_t)(kr0 + skey) * DINP;
            pk_ = *(const v4u*)(src + PC_SK + kvh * 64 + 8 * sch); pv_ = *(const v4u*)(src + PC_SV + kvh * 64 + 8 * sch); }
        for (int t = 0; t < ntiles; ++t) {
            const bool local = t < nlocal; const int ktok0 = local ? lo + 64 * t : 64 * (t - nlocal);
            asm volatile("s_waitcnt lgkmcnt(0)" ::: "memory"); __builtin_amdgcn_s_barrier(); asm volatile("" ::: "memory");
            {   *(LAS v4u*)(Ks + skey * 72 + 8 * sch) = pk_;
                const v4u v8 = pv_;
                LAS bf16* vd = Vt + (8 * sch) * 68 + skey;
                vd[0 * 68] = (bf16)(v8.x & 0xffffu); vd[1 * 68] = (bf16)(v8.x >> 16); vd[2 * 68] = (bf16)(v8.y & 0xffffu); vd[3 * 68] = (bf16)(v8.y >> 16);
                vd[4 * 68] = (bf16)(v8.z & 0xffffu); vd[5 * 68] = (bf16)(v8.z >> 16); vd[6 * 68] = (bf16)(v8.w & 0xffffu); vd[7 * 68] = (bf16)(v8.w >> 16); }
            if (t + 1 < ntiles) { const int t1 = t + 1; const bool l1 = t1 < nlocal; const int kt1 = l1 ? lo + 64 * t1 : 64 * (t1 - nlocal); const int kr1 = l1 ? b * SEQ + kt1 : ML + b * CTXL + kt1;
                const bf16* src = P + (size_t)(kr1 + skey) * DINP;
                pk_ = *(const v4u*)(src + PC_SK + kvh * 64 + 8 * sch); pv_ = *(const v4u*)(src + PC_SV + kvh * 64 + 8 * sch); }
            asm volatile("s_waitcnt lgkmcnt(0)" ::: "memory"); __builtin_amdgcn_s_barrier(); asm volatile("" ::: "memory");
            const bool rel = !local || (ktok0 + 63 >= qtok0 - 128 && ktok0 <= qtok0 + 31 + 128);
            if (rel) {
#pragma unroll
                for (int qb = 0; qb < 2; ++qb) {
                    f32x4 s[4];
#pragma unroll
                    for (int kb = 0; kb < 4; ++kb) { s[kb] = (f32x4){0.f, 0.f, 0.f, 0.f};
#pragma unroll
                        for (int ks = 0; ks < 2; ++ks) { const bf16x8 kf = *(const LAS bf16x8*)(Ks + (16 * kb + li) * 72 + 32 * ks + 8 * lq);
                            s[kb] = __builtin_amdgcn_mfma_f32_16x16x32_bf16(kf, qf[qb][ks], s[kb], 0, 0, 0); } }
                    if (local) { const int qt = qtok0 + 16 * qb + li;
#pragma unroll
                        for (int kb = 0; kb < 4; ++kb)
#pragma unroll
                            for (int j = 0; j < 4; ++j) { const int dlt = ktok0 + 16 * kb + 4 * lq + j - qt; if (dlt > 128 || dlt < -128) s[kb][j] = -INFINITY; } }
                    float mx = -INFINITY;
#pragma unroll
                    for (int kb = 0; kb < 4; ++kb) mx = fmaxf(mx, fmaxf(fmaxf(s[kb][0], s[kb][1]), fmaxf(s[kb][2], s[kb][3])));
                    mx = fmaxf(mx, __shfl_xor(mx, 16)); mx = fmaxf(mx, __shfl_xor(mx, 32));
                    const float mnew = fmaxf(mrun[qb], mx), corr = __expf(mrun[qb] - mnew); mrun[qb] = mnew;
                    float ls = 0.f;
#pragma unroll
                    for (int kb = 0; kb < 4; ++kb)
#pragma unroll
                        for (int j = 0; j < 4; ++j) { const float p = __expf(s[kb][j] - mnew); s[kb][j] = p; ls += p; }
                    lrun[qb] = lrun[qb] * corr + ls;
#pragma unroll
                    for (int db = 0; db < 4; ++db) Oa[db][qb] = Oa[db][qb] * corr;
#pragma unroll
                    for (int kk = 0; kk < 2; ++kk) {
                        v4u pw; pw.x = pk2(s[2 * kk][0], s[2 * kk][1]); pw.y = pk2(s[2 * kk][2], s[2 * kk][3]); pw.z = pk2(s[2 * kk + 1][0], s[2 * kk + 1][1]); pw.w = pk2(s[2 * kk + 1][2], s[2 * kk + 1][3]);
                        const bf16x8 pf = __builtin_bit_cast(bf16x8, pw);
#pragma unroll
                        for (int db = 0; db < 4; ++db) { const LAS bf16* vp = Vt + (16 * db + li) * 68 + 32 * kk + 4 * lq;
                            const v2u va = *(const LAS v2u*)vp, vb = *(const LAS v2u*)(vp + 16);
                            const bf16x8 vf = __builtin_bit_cast(bf16x8, (v4u){va.x, va.y, vb.x, vb.y});
                            Oa[db][qb] = __builtin_amdgcn_mfma_f32_16x16x32_bf16(vf, pf, Oa[db][qb], 0, 0, 0); }
                    }
                }
            }
        }
#pragma unroll
        for (int qb = 0; qb < 2; ++qb) { float lt = lrun[qb]; lt += __shfl_xor(lt, 16); lt += __shfl_xor(lt, 32); const float inv = 1.0f / lt;
            bf16* op = MIX + (size_t)(qrow0 + 16 * qb + li) * 1024 + 256 + hq * 64 + 4 * lq;
#pragma unroll
            for (int db = 0; db < 4; ++db) { const f32x4 o = Oa[db][qb] * inv; v2u w; w.x = pk2(o.x, o.y); w.y = pk2(o.z, o.w); *(v2u*)(op + 16 * db) = w; } }
    }
}

__device__ __forceinline__ void phase_assemble(const Args& a, int l, const bf16* P, const _Float16* RF, const _Float16* LO, const _Float16* YO, bf16* MIX, int nrows) {
    const int lane = otid() & 63, gw = obid() * 8 + (otid() >> 6), NGW = ogdim() * 8, c = 4 * lane;
    const f32x4 ng = *(const f32x4*)(a.in[I_GNORM] + l * 256 + c), ka = *(const f32x4*)(a.in[I_KA] + l * 256 + c), rk = *(const f32x4*)(a.in[I_RK] + l * 256 + c);
    const f32x4 gg = *(const f32x4*)(a.in[I_GNG] + l * 256 + c), gb = *(const f32x4*)(a.in[I_GNB] + l * 256 + c);
    for (int row = gw; row < nrows; row += NGW) {
        {
            const h4 of = *(const h4*)(YO + ((size_t)2 * MA + row) * 256 + c), ob = *(const h4*)(YO + ((size_t)3 * MA + row) * 256 + c);
            f32x4 o; float ss = 0.f;
#pragma unroll
            for (int e = 0; e < 4; ++e) { o[e] = (float)of[e] + (float)ob[e]; ss += o[e] * o[e]; }
            ss += __shfl_xor(ss, 1); ss += __shfl_xor(ss, 2); ss += __shfl_xor(ss, 4); ss += __shfl_xor(ss, 8);
            const float rms = 1.0f / sqrtf(ss * (1.0f / 64.0f) + LN_EPS);
            const v2u g2 = *(const v2u*)(P + (size_t)row * DINP + PC_GG + c);
            const float ga[4] = {bflo(g2.x), bfhi(g2.x), bflo(g2.y), bfhi(g2.y)}; float r[4];
#pragma unroll
            for (int e = 0; e < 4; ++e) r[e] = o[e] * rms * ng[e] * (ga[e] * sigmoidf_(ga[e]));
            v2u w; w.x = pk2(r[0], r[1]); w.y = pk2(r[2], r[3]); *(v2u*)(MIX + (size_t)row * 1024 + c) = w; }
        {
            const h4 yf = *(const h4*)(YO + ((size_t)0 * MA + row) * 256 + c), yb = *(const h4*)(YO + ((size_t)1 * MA + row) * 256 + c);
            const _Float16* rf = RF + (size_t)row * 1024 + c; const _Float16* lo = LO + (size_t)row * 1536 + c;
            const h4 r4 = *(const h4*)(rf + RF_R), k4 = *(const h4*)(rf + RF_K), v4 = *(const h4*)(rf + RF_V);
            const h4 af = *(const h4*)(lo + LC_A), ab = *(const h4*)(lo + LC_A + 256), g4 = *(const h4*)(lo + LC_G);
            f32x4 y; float s1 = 0.f, bon = 0.f;
#pragma unroll
            for (int e = 0; e < 4; ++e) { y[e] = (float)yf[e] + (float)yb[e]; s1 += y[e];
                bon += (float)r4[e] * (float)k4[e] * (1.0f + (0.5f * ((float)af[e] + (float)ab[e]) - 1.0f) * ka[e]) * rk[e]; }
            s1 += __shfl_xor(s1, 1); s1 += __shfl_xor(s1, 2); s1 += __shfl_xor(s1, 4); s1 += __shfl_xor(s1, 8);
            bon += __shfl_xor(bon, 1); bon += __shfl_xor(bon, 2); bon += __shfl_xor(bon, 4); bon += __shfl_xor(bon, 8);
            const float mu = s1 * (1.0f / 64.0f); float s2 = 0.f;
#pragma unroll
            for (int e = 0; e < 4; ++e) { y[e] -= mu; s2 += y[e] * y[e]; }
            s2 += __shfl_xor(s2, 1); s2 += __shfl_xor(s2, 2); s2 += __shfl_xor(s2, 4); s2 += __shfl_xor(s2, 8);
            const float rstd = 1.0f / sqrtf(s2 * (1.0f / 64.0f) + 64e-5f); float r[4];
#pragma unroll
            for (int e = 0; e < 4; ++e) r[e] = (y[e] * rstd * gg[e] + gb[e] + bon * (float)v4[e]) * (float)g4[e];
            v2u w; w.x = pk2(r[0], r[1]); w.y = pk2(r[2], r[3]); *(v2u*)(MIX + (size_t)row * 1024 + 768 + c) = w; }
    }
}

#define XB_TMO      128
#define XB_XCNT(j)  (256  + 64 * (j))
#define XB_XSUB(j)  (1280 + 64 * (j))
#define XB_XGEN(j)  (2304 + 64 * (j))
#define XB_TOP      3328
#define XB_TOPGEN   3392
#define XCD_BAR_WORDS 3456
#define XB_SPIN_CAP (1u << 18)

__device__ __forceinline__ unsigned xb_ld(unsigned* p)              { return __hip_atomic_load(p, __ATOMIC_RELAXED, __HIP_MEMORY_SCOPE_AGENT); }
__device__ __forceinline__ unsigned xb_add(unsigned* p, unsigned v) { return __hip_atomic_fetch_add(p, v, __ATOMIC_RELAXED, __HIP_MEMORY_SCOPE_AGENT); }
__device__ __forceinline__ unsigned xb_xcc_id() { return (unsigned)__builtin_amdgcn_s_getreg((3 << 11) | 20) & 0xFu; }
#define XB_SPIN(cond, bar) do { unsigned _sp = 0; while (cond) { __builtin_amdgcn_s_sleep(1); \
    if ((++_sp & 255u) == 0u) { if (xb_ld(&(bar)[XB_TMO])) break; if (_sp > XB_SPIN_CAP) { atomicAdd(&(bar)[XB_TMO], 1u); break; } } } } while (0)

struct XcdBarrier {
    unsigned* bar; unsigned x;
    volatile LAS unsigned* st;
};

__device__ __forceinline__ XcdBarrier xcd_barrier_post(unsigned* bar, volatile LAS unsigned* st) {
    XcdBarrier b; b.bar = bar; b.x = xb_xcc_id(); b.st = st;
    if (threadIdx.x == 0) (void)xb_add(&bar[XB_XCNT(b.x)], 1u);
    return b;
}
__device__ __forceinline__ void xcd_barrier_complete(unsigned* bar, unsigned x, unsigned& nloc, unsigned& nx) {
    const unsigned G = gridDim.x * gridDim.y * gridDim.z;
    unsigned sum, cnt, mine, sp = 0u;
    for (;;) {
        sum = 0u; cnt = 0u; mine = 0u;
#pragma unroll
        for (unsigned j = 0; j < 16; ++j) { const unsigned c = xb_ld(&bar[XB_XCNT(j)]); sum += c; cnt += (c > 0u) ? 1u : 0u; mine = (j == x) ? c : mine; }
        if (sum == G) break;
        __builtin_amdgcn_s_sleep(1);
        if ((++sp & 255u) == 0u) { if (xb_ld(&bar[XB_TMO])) break; if (sp > XB_SPIN_CAP) { atomicAdd(&bar[XB_TMO], 1u); break; } }
    }
    nloc = mine > 0u ? mine : 1u; nx = cnt > 0u ? cnt : 1u;
}

__device__ __forceinline__ void xcd_barrier(const XcdBarrier& b) {
    asm volatile("s_waitcnt vmcnt(0)" ::: "memory");
    __syncthreads();
    if (threadIdx.x == 0) {
        unsigned* bar = b.bar;
        __builtin_amdgcn_s_waitcnt(0);
        unsigned nloc = b.st[0], nx = b.st[1];
        if (nloc == 0u) { xcd_barrier_complete(bar, b.x, nloc, nx); b.st[0] = nloc; b.st[1] = nx; }
        const unsigned old = xb_add(&bar[XB_XSUB(b.x)], 1u);
        const unsigned gen = old / nloc;
        if (old + 1u == (gen + 1u) * nloc) {
            __builtin_amdgcn_fence(__ATOMIC_RELEASE, "agent");
            asm volatile("s_waitcnt vmcnt(0)" ::: "memory");
            const unsigned og = xb_add(&bar[XB_TOP], 1u);
            const unsigned tg = og / nx;
            if (og + 1u == (tg + 1u) * nx) xb_add(&bar[XB_TOPGEN], 1u);
            else XB_SPIN(xb_ld(&bar[XB_TOPGEN]) == tg, bar);
            __builtin_amdgcn_fence(__ATOMIC_ACQUIRE, "agent");
            xb_add(&bar[XB_XGEN(b.x)], 1u);
            asm volatile("s_waitcnt vmcnt(0)" ::: "memory");
        } else {
            XB_SPIN(xb_ld(&bar[XB_XGEN(b.x)]) == gen, bar);
            __builtin_amdgcn_fence(__ATOMIC_ACQUIRE, "agent");
            asm volatile("s_waitcnt vmcnt(0)" ::: "memory");
        }
    }
    __syncthreads();
}

#define GSYNC() do { XcdBarrier xb_; xb_.bar = (unsigned*)a.ws; xb_.x = xb_xcc_id(); xb_.st = (volatile LAS unsigned*)(lds + 133120); xcd_barrier(xb_); } while (0)
#ifndef REP_RWKV
#define REP_RWKV 1
#endif
#ifndef REP_GLA
#define REP_GLA 1
#endif
#ifndef REP_SWA
#define REP_SWA 1
#endif
#ifndef REP_UP
#define REP_UP 1
#endif
__global__ void __launch_bounds__(512, 2) mega_fwd(Args a) {
    extern __shared__ __attribute__((aligned(16))) unsigned char lds_raw[];
    cg::grid_group grid = cg::this_grid();
    LAS unsigned char* lds = (LAS unsigned char*)lds_raw;
    unsigned char* ws = a.ws;
    float* MOD = (float*)(ws + WS_MOD); float* STATS = (float*)(ws + WS_STATS);
    float* XL = a.out; float* XC = (float*)(ws + WS_XC);
    bf16* U = (bf16*)(ws + WS_U); bf16* HID = (bf16*)(ws + WS_HID);
    _Float16* LO = (_Float16*)(ws + WS_LO); _Float16* RF = (_Float16*)(ws + WS_RF); _Float16* YO = (_Float16*)(ws + WS_YO);

    { volatile LAS unsigned* st = (volatile LAS unsigned*)(lds + 133120); if (threadIdx.x < 2) st[threadIdx.x] = 0u; }
    __syncthreads();
    (void)xcd_barrier_post((unsigned*)ws, (volatile LAS unsigned*)(lds + 133120));
    phase_adaln(a, MOD, lds);
    __syncthreads();
    phase_convert(a, 0, ws, lds);
    grid.sync();
    phase_mod0(a, MOD, U);
    GSYNC();
    for (int l = 0; l < DEPTH; ++l) {
        const bool last = (l == DEPTH - 1);
        asm volatile("" : "+s"(ws));
        const float* modl = MOD + (size_t)l * 9 * 9216;
        const float* lng = a.in[I_LNG] + l * 3 * 1024; const float* lnb = a.in[I_LNB] + l * 3 * 1024;
        for (int rep = 0; rep < REP_UP; ++rep) { pg8::Gemm g{U, (const bf16*)(ws + WS_WGU1), MA, 2 * DFF, 1024}; pg8::StaticOrder S; S.init(MA, 2 * DFF, ogdim(), obid());
          pg8::EpiSwiglu E{HID, DFF}; pg8::gemm_phase<pg8::EpiSwiglu, pg8::StaticOrder, true, true>(lds, g, S, E); }
        GSYNC();
        { pg8::Gemm g{HID, (const bf16*)(ws + WS_WD1), MA, 1024, DFF}; pg8::StaticOrder S; S.init(MA, 1024, ogdim(), obid());
          pg8::EpiResid E{l == 0 ? a.in[I_X] : XL, l == 0 ? a.in[I_CTX] : XC, XL, XC, modl + 2 * 1024, ALPHA, 0.5f, STATS, lng - 1024, lnb - 1024, l > 0 ? 1 : 0};
          pg8::gemm_phase<pg8::EpiResid, pg8::StaticOrder, true, true>(lds, g, S, E); }
        GSYNC();
        phase_ln(XL, XC, lng, lnb, modl + 3 * 1024, U, MA, true, STATS, false);
        GSYNC();
        { pg8::Gemm g{U, (const bf16*)(ws + WS_WIN), MA, DINP, 1024}; pg8::StaticOrder S; S.init(MA, DINP, ogdim(), obid());
          pg8::EpiStore E{HID, DINP}; pg8::gemm_phase<pg8::EpiStore, pg8::StaticOrder, true, true>(lds, g, S, E); }
        GSYNC();
        phase_features(a, l, HID, RF, U, lds);
        GSYNC();
        { pg8::Gemm g{U, (const bf16*)(ws + WS_WLORA), MA, LORA_N, LORA_K}; pg8::StaticOrder S; S.init(MA, LORA_N, ogdim(), obid());
          pg8::EpiLora E{LO, a.in[I_W0] + l * 512, a.in[I_A0] + l * 512, a.in[I_GBIAS] + l * 256};
          pg8::gemm_phase<pg8::EpiLora, pg8::StaticOrder, true, true>(lds, g, S, E); }
        GSYNC();
        phase_gla_a(l, HID, LO, YO, (_Float16*)(ws + WS_KV), (float*)(ws + WS_DEC), lds);
        __syncthreads();
        for (int rep = 0; rep < REP_SWA; ++rep) { phase_swa(a, l, HID, U, !last, lds); __syncthreads(); }
        GSYNC();
        phase_gla_b((const _Float16*)(ws + WS_KV), (const float*)(ws + WS_DEC), (bf16*)(ws + WS_ST));
        for (int rep = 0; rep < REP_RWKV; ++rep) { phase_rwkv(a, l, RF, LO, YO, lds); __syncthreads(); }
        GSYNC();
        phase_gla_c(HID, (const bf16*)(ws + WS_ST), YO);
        GSYNC();
        phase_assemble(a, l, HID, RF, LO, YO, U, last ? ML : MA);
        GSYNC();
        const int Mo = last ? ML : MA;
        { pg8::Gemm g{U, (const bf16*)(ws + WS_WOUT), Mo, 1024, 1024}; pg8::StaticOrder S; S.init(Mo, 1024, ogdim(), obid());
          pg8::EpiResid E{XL, XC, XL, XC, modl + 5 * 1024, ALPHA, 1.0f, STATS, lng, lnb, 1};
          pg8::gemm_phase<pg8::EpiResid, pg8::StaticOrder, true, true>(lds, g, S, E); }
        GSYNC();
        phase_ln(XL, XC, lng + 1024, lnb + 1024, modl + 6 * 1024, U, Mo, true, STATS, false);
        GSYNC();
        { pg8::Gemm g{U, (const bf16*)(ws + WS_WGU2), Mo, 2 * DFF, 1024}; pg8::StaticOrder S; S.init(Mo, 2 * DFF, ogdim(), obid());
          pg8::EpiSwiglu E{HID, DFF}; pg8::gemm_phase<pg8::EpiSwiglu, pg8::StaticOrder, true, true>(lds, g, S, E); }
        GSYNC();
        { pg8::Gemm g{HID, (const bf16*)(ws + WS_WD2), Mo, 1024, DFF}; pg8::StaticOrder S; S.init(Mo, 1024, ogdim(), obid());
          pg8::EpiResid E{XL, XC, XL, XC, modl + 8 * 1024, ALPHA, 0.5f, STATS, lng + 1024, lnb + 1024, 1};
          pg8::gemm_phase<pg8::EpiResid, pg8::StaticOrder, true, true>(lds, g, S, E); }
        GSYNC();
        phase_ln(XL, XC, lng + 2048, lnb + 2048, MOD + (size_t)(last ? l : l + 1) * 9 * 9216, U, Mo, !last, STATS, last);
        if (!last) { __syncthreads(); phase_convert(a, l + 1, ws, lds); }
        GSYNC();
    }
}

extern "C" void kernel_launch(void* const* d_in, const int* in_sizes, int n_in, void* d_out, int out_size, void* d_ws, size_t ws_size, hipStream_t stream) {
    static int grid = 0;
    if (grid == 0) {
        if (n_in != 31 || out_size != ML * DM || ws_size < WS_END) { fprintf(stderr, "kernel_launch: unexpected problem (n_in %d, out %d, ws %zu need %zu)\n", n_in, out_size, ws_size, (size_t)WS_END); grid = -1; return; }
        int dev = 0, cus = 0, per_cu = 0;
        hipGetDevice(&dev); hipDeviceGetAttribute(&cus, hipDeviceAttributeMultiprocessorCount, dev);
        if (hipFuncSetAttribute((const void*)mega_fwd, hipFuncAttributeMaxDynamicSharedMemorySize, LDS_BYTES) != hipSuccess) { fprintf(stderr, "kernel_launch: hipFuncSetAttribute failed\n"); grid = -1; return; }
        if (hipOccupancyMaxActiveBlocksPerMultiprocessor(&per_cu, (const void*)mega_fwd, 512, LDS_BYTES) != hipSuccess || per_cu < 1) { fprintf(stderr, "kernel_launch: occupancy query says %d\n", per_cu); per_cu = 1; }
        (void)hipGetLastError();
        grid = cus * per_cu;
    }
    if (grid < 0) return;
    if (hipMemsetAsync(d_ws, 0, 65536, stream) != hipSuccess) { fprintf(stderr, "kernel_launch: memset failed\n"); return; }
    Args a{};
    for (int i = 0; i < 31; ++i) a.in[i] = (const float*)d_in[i];
    a.out = (float*)d_out; a.ws = (unsigned char*)d_ws;
    void* args[] = {&a};
    const hipError_t e = hipLaunchCooperativeKernel((const void*)mega_fwd, dim3(grid), dim3(512), args, LDS_BYTES, stream);
    if (e != hipSuccess) fprintf(stderr, "kernel_launch: cooperative launch failed: %s (grid %d)\n", hipGetErrorString(e), grid);
}
```

```cpp
#include <hip/hip_runtime.h>
#include <hip/hip_cooperative_groups.h>
#include <cstdio>
#include <cstdint>
namespace cg = cooperative_groups;
namespace pg8 {
#define PG8_LAS __attribute__((address_space(3)))
typedef unsigned short bf16_t;
typedef short bf16x8 __attribute__((ext_vector_type(8)));
typedef float f32x4 __attribute__((ext_vector_type(4)));
typedef unsigned u32x4 __attribute__((ext_vector_type(4)));
constexpr int BM = 256, BK = 64, HALF = 128, HTB = HALF * BK * 2  , STAGE_BYTES = 8 * HTB, NXCD = 8, WGM = 8;

__host__ __device__ __forceinline__ int lds_byte(int r, int c) { const int st = (r >> 4) * 2 + (c >> 5), rr = r & 15, cc = c & 31, ob = rr * 64 + cc * 2; return st * 1024 + (ob ^ (((ob >> 9) & 1) << 5)); }
__host__ __device__ __forceinline__ void stage_rc(int b, int& R, int& C) { const int st = b / 1024, sb = b % 1024, swz = sb ^ (((sb >> 9) & 1) << 5); R = (st >> 1) * 16 + swz / 64; C = (st & 1) * 32 + (swz % 64) / 2; }
__host__ __device__ __forceinline__ int perm32(int rho) { const int n = rho >> 4, i = rho & 15; return 8 * (i >> 2) + 4 * n + (i & 3); }

struct Unit { int pm, pn; };
struct Gemm { const bf16_t* A; const bf16_t* Bt; int M, N, K; };

struct StaticOrder {
    int nM, nN, nwg, G, c;
    __host__ __device__ void init(int M, int N, int G_, int c_) { nM = M / BM; nN = N / BM; nwg = nM * nN; G = G_; c = c_; }
    __host__ __device__ bool next(int i, Unit& u) const {
        const long L = (long)i * G + c; if (L >= nwg) return false;
        int wgid = (int)L; { const int q = nwg / NXCD, r = nwg % NXCD, xcd = wgid % NXCD, off = wgid / NXCD; wgid = (xcd < r ? xcd * (q + 1) : r * (q + 1) + (xcd - r) * q) + off; }
        const int nig = WGM * nN, gid = wgid / nig, fm = gid * WGM, gsz = (nM - fm) < WGM ? (nM - fm) : WGM;
        u.pm = fm + ((wgid % nig) % gsz); u.pn = (wgid % nig) / gsz; return true;
    }
    __device__ __forceinline__ void a_ready(const Unit&) const {}
    __device__ __forceinline__ void done(const Unit&) const {}
};

__device__ __forceinline__ unsigned cvt_pk_bf16(float lo, float hi) { unsigned r; asm volatile("v_cvt_pk_bf16_f32 %0, %1, %2" : "=v"(r) : "v"(lo), "v"(hi)); return r; }
typedef _Float16 f16x8 __attribute__((ext_vector_type(8)));
typedef unsigned u32x2 __attribute__((ext_vector_type(2)));
__device__ __forceinline__ float fast_sigmoid(float x) { return __builtin_amdgcn_rcpf(1.0f + __expf(-x)); }
__device__ __forceinline__ float log_sigmoid(float x) { return fminf(x, 0.f) - __logf(1.0f + __expf(-fabsf(x))); }

struct EpiSwiglu {
    static constexpr bool PERM = true, AFTER_DRAIN = false;
    bf16_t* O; int ldc;
    __device__ __forceinline__ void operator()(const f32x4 (&acc)[2][2][4][2], const Unit& u, int wr, int wc, int fr, int fq) const {
        const int row0 = u.pm * BM + wr * 64 + fr, col0 = u.pn * HALF + wc * 32 + 8 * fq;
#pragma unroll
        for (int ai = 0; ai < 2; ++ai)
#pragma unroll
            for (int m = 0; m < 4; ++m) {
                bf16_t* rowp = O + (size_t)(row0 + ai * HALF + m * 16) * ldc + col0;
                float h[8];
#pragma unroll
                for (int n = 0; n < 2; ++n)
#pragma unroll
                    for (int e = 0; e < 4; ++e) { const float g = acc[ai][0][m][n][e], up = acc[ai][1][m][n][e]; h[4 * n + e] = g * fast_sigmoid(g) * up; }
                u32x4 w; w.x = cvt_pk_bf16(h[0], h[1]); w.y = cvt_pk_bf16(h[2], h[3]); w.z = cvt_pk_bf16(h[4], h[5]); w.w = cvt_pk_bf16(h[6], h[7]);
                *(u32x4*)rowp = w;
            }
    }
};
struct EpiStore {
    static constexpr bool PERM = true, AFTER_DRAIN = false;
    bf16_t* O; int ldc;
    __device__ __forceinline__ void operator()(const f32x4 (&acc)[2][2][4][2], const Unit& u, int wr, int wc, int fr, int fq) const {
        const int row0 = u.pm * BM + wr * 64 + fr, col0 = u.pn * BM + wc * 32 + 8 * fq;
#pragma unroll
        for (int ai = 0; ai < 2; ++ai)
#pragma unroll
            for (int m = 0; m < 4; ++m) {
                bf16_t* rowp = O + (size_t)(row0 + ai * HALF + m * 16) * ldc + col0;
#pragma unroll
                for (int bj = 0; bj < 2; ++bj) { const f32x4 v0 = acc[ai][bj][m][0], v1 = acc[ai][bj][m][1];
                    u32x4 w; w.x = cvt_pk_bf16(v0[0], v0[1]); w.y = cvt_pk_bf16(v0[2], v0[3]); w.z = cvt_pk_bf16(v1[0], v1[1]); w.w = cvt_pk_bf16(v1[2], v1[3]);
                    *(u32x4*)(rowp + bj * HALF) = w; }
            }
    }
};
struct EpiResid {
    static constexpr bool PERM = false, AFTER_DRAIN = false;
    const float* src_lat; const float* src_ctx; float* dst_lat; float* dst_ctx; const float* gate  ; float alpha, coef;
    const float* stats; const float* lg; const float* lb; int use_ln;
    __device__ __forceinline__ void operator()(const f32x4 (&acc)[2][2][4][2], const Unit& u, int wr, int wc, int fr, int fq) const {
        const bool ctx = u.pm >= 128; const int bi = ctx ? 8 : (u.pm >> 4);
        const float* src = ctx ? src_ctx + (size_t)(u.pm - 128) * BM * 1024 : src_lat + (size_t)u.pm * BM * 1024;
        float* dst = ctx ? dst_ctx + (size_t)(u.pm - 128) * BM * 1024 : dst_lat + (size_t)u.pm * BM * 1024;
        const float* gp = gate + (size_t)bi * 9216;
        const int col0 = u.pn * BM + wc * 32 + 4 * fq;
        float mean[2][4], rstd[2][4];
#pragma unroll
        for (int ai = 0; ai < 2; ++ai)
#pragma unroll
            for (int m = 0; m < 4; ++m) { mean[ai][m] = 0.f; rstd[ai][m] = 1.f;
                if (use_ln) { typedef float f32x2s __attribute__((ext_vector_type(2))); const f32x2s st = *(const f32x2s*)(stats + 2 * (size_t)(u.pm * BM + ai * HALF + wr * 64 + m * 16 + fr)); mean[ai][m] = st.x; rstd[ai][m] = st.y; } }
#pragma unroll
        for (int bj = 0; bj < 2; ++bj)
#pragma unroll
            for (int n = 0; n < 2; ++n) { const int cc = col0 + bj * HALF + n * 16;
                const f32x4 gv = *(const f32x4*)(gp + cc) * coef; f32x4 ga = (f32x4){alpha, alpha, alpha, alpha}, ba = (f32x4){0.f, 0.f, 0.f, 0.f};
                if (use_ln) { ga = *(const f32x4*)(lg + cc) * alpha; ba = *(const f32x4*)(lb + cc) * alpha; }
#pragma unroll
                for (int ai = 0; ai < 2; ++ai)
#pragma unroll
                    for (int m = 0; m < 4; ++m) { const size_t off = (size_t)(ai * HALF + wr * 64 + m * 16 + fr) * 1024 + cc;
                        const f32x4 sv = *(const f32x4*)(src + off);
                        *(f32x4*)(dst + off) = (sv - mean[ai][m]) * rstd[ai][m] * ga + ba + gv * acc[ai][bj][m][n]; }
                asm volatile("" ::: "memory"); }
    }
};
struct EpiLora {
    static constexpr bool PERM = true, AFTER_DRAIN = false;
    _Float16* O; const float* w0; const float* a0; const float* gbias;
    template <int MODE> __device__ __forceinline__ void tile(const f32x4 (&acc)[2][2][4][2], const Unit& u, int wr, int wc, int fr, int fq, const float* bias) const {
        const int row0 = u.pm * BM + wr * 64 + fr, lc0 = wc * 32 + 8 * fq;
        float bv[2][8];
#pragma unroll
        for (int bj = 0; bj < 2; ++bj)
#pragma unroll
            for (int e = 0; e < 8; ++e) bv[bj][e] = (MODE == 2) ? 0.f : bias[lc0 + bj * HALF + e];
#pragma unroll
        for (int ai = 0; ai < 2; ++ai)
#pragma unroll
            for (int m = 0; m < 4; ++m) {
                _Float16* rowp = O + (size_t)(row0 + ai * HALF + m * 16) * 1536 + u.pn * BM + lc0;
#pragma unroll
                for (int bj = 0; bj < 2; ++bj) {
                    f16x8 o;
#pragma unroll
                    for (int e = 0; e < 8; ++e) { const float x = acc[ai][bj][m][e >> 2][e & 3] + bv[bj][e]; float r;
                        if (MODE == 0) r = __expf(-__expf(log_sigmoid(x) - 0.5f));
                        else if (MODE == 1) r = fast_sigmoid(x);
                        else if (MODE == 2) r = x;
                        else r = log_sigmoid(x) * (1.0f / 16.0f);
                        o[e] = (_Float16)r; }
                    *(f16x8*)(rowp + bj * HALF) = o;
                }
            }
    }
    __device__ __forceinline__ void operator()(const f32x4 (&acc)[2][2][4][2], const Unit& u, int wr, int wc, int fr, int fq) const {
        const int pn = u.pn;
        if (pn < 2) tile<0>(acc, u, wr, wc, fr, fq, w0 + pn * 256);
        else if (pn < 4) tile<1>(acc, u, wr, wc, fr, fq, a0 + (pn - 2) * 256);
        else if (pn == 4) tile<2>(acc, u, wr, wc, fr, fq, gbias);
        else tile<3>(acc, u, wr, wc, fr, fq, gbias);
    }
};

template <class Epi, class Sched, bool ALIGN_EPI = false, bool SP2 = false>
__device__ __forceinline__ void gemm_phase(PG8_LAS unsigned char* lds, const Gemm g, const Sched& S, const Epi& E) {
    int tid_ = threadIdx.x; asm volatile("" : "+v"(tid_)); const int tid = tid_, wid = __builtin_amdgcn_readfirstlane(tid >> 6), lane = tid & 63, wr = wid >> 2, wc = wid & 3, fr = lane & 15, fq = lane >> 4;
    const int K = g.K, nt = K / BK;
    unsigned voffA[2], voffB[2];
#pragma unroll
    for (int i = 0; i < 2; ++i) { int R, C; stage_rc(tid * 16 + i * 8192, R, C); const int Rb = Epi::PERM ? ((R & ~31) + perm32(R & 31)) : R;
        voffA[i] = (unsigned)(R * K + C) * 2u; voffB[i] = (unsigned)(Rb * K + C) * 2u; }
    const size_t kstep = (size_t)(BK * 2);
    const size_t hstep = (size_t)HALF * K * 2;
    const size_t tstep = 2 * hstep;
    const unsigned ldsw = (unsigned)wid * 1024u;
    const int aoff = lds_byte(wr * 64 + fr, fq * 8), boff = lds_byte(wc * 32 + fr, fq * 8);
#define PG8_SA(b, h) (((b) * 2 + (h)) * HTB)
#define PG8_SB(b, h) ((4 + (b) * 2 + (h)) * HTB)
#define PG8_STAGE(bufoff, gbase, voff) do { _Pragma("unroll") for (int _i = 0; _i < 2; ++_i) \
        __builtin_amdgcn_global_load_lds((const unsigned*)((const char*)(gbase) + (voff)[_i]), (PG8_LAS unsigned*)(lds + (bufoff) + ldsw + _i * 8192), 16, 0, 0); } while (0)
#define PG8_LDA(dst, b, h) do { _Pragma("unroll") for (int m = 0; m < 4; ++m) _Pragma("unroll") for (int k = 0; k < 2; ++k) dst[m][k] = *(const PG8_LAS bf16x8*)(lds + PG8_SA(b, h) + aoff + m * 2048 + k * 1024); } while (0)
#define PG8_LDB(dst, b, h) do { _Pragma("unroll") for (int n = 0; n < 2; ++n) _Pragma("unroll") for (int k = 0; k < 2; ++k) dst[n][k] = *(const PG8_LAS bf16x8*)(lds + PG8_SB(b, h) + boff + n * 2048 + k * 1024); } while (0)
#define PG8_MMA(ai, bj, At, Bt) do { __builtin_amdgcn_s_setprio(1); _Pragma("unroll") for (int m = 0; m < 4; ++m) _Pragma("unroll") for (int n = 0; n < 2; ++n) _Pragma("unroll") for (int k = 0; k < 2; ++k) \
        acc[ai][bj][m][n] = __builtin_amdgcn_mfma_f32_16x16x32_bf16(Bt[n][k], At[m][k], acc[ai][bj][m][n], 0, 0, 0); __builtin_amdgcn_s_setprio(0); } while (0)
#define PG8_WAIT_V(n) asm volatile("s_waitcnt vmcnt(" #n ")" ::: "memory")
#define PG8_WAIT_L(n) asm volatile("s_waitcnt lgkmcnt(" #n ")" ::: "memory")
#define PG8_BAR __builtin_amdgcn_s_barrier()
#define PG8_SCHED __builtin_amdgcn_sched_barrier(0)
    Unit cur, nxt; int ui = 0;
    if (!S.next(0, cur)) return;
    f32x4 acc[2][2][4][2];
#pragma unroll
    for (int a = 0; a < 2; ++a)
#pragma unroll
        for (int b = 0; b < 2; ++b)
#pragma unroll
            for (int m = 0; m < 4; ++m)
#pragma unroll
                for (int n = 0; n < 2; ++n) acc[a][b][m][n] = (f32x4){0.f, 0.f, 0.f, 0.f};
    bf16x8 At[4][2], B0[2][2], B1[2][2];
    const char* cA = (const char*)g.A + (size_t)cur.pm * tstep; const char* cB = (const char*)g.Bt + (size_t)cur.pn * tstep;
    S.a_ready(cur);
    if constexpr (SP2) {
        PG8_STAGE(PG8_SB(0, 0), cB, voffB); PG8_STAGE(PG8_SB(0, 1), cB + hstep, voffB); PG8_STAGE(PG8_SA(0, 0), cA, voffA); PG8_STAGE(PG8_SA(0, 1), cA + hstep, voffA);
        if (wr == 1) PG8_BAR;
        PG8_WAIT_V(2); PG8_BAR;
        PG8_STAGE(PG8_SB(1, 0), cB + kstep, voffB); PG8_STAGE(PG8_SA(1, 0), cA + kstep, voffA); PG8_STAGE(PG8_SB(1, 1), cB + hstep + kstep, voffB);
        PG8_WAIT_V(6); PG8_BAR;
    } else {
        PG8_STAGE(PG8_SB(0, 0), cB, voffB); PG8_STAGE(PG8_SA(0, 0), cA, voffA); PG8_STAGE(PG8_SB(0, 1), cB + hstep, voffB); PG8_STAGE(PG8_SA(0, 1), cA + hstep, voffA);
        if (wr == 1) PG8_BAR;
        PG8_WAIT_V(4); PG8_BAR;
        PG8_STAGE(PG8_SB(1, 0), cB + kstep, voffB); PG8_STAGE(PG8_SA(1, 0), cA + kstep, voffA); PG8_STAGE(PG8_SB(1, 1), cB + hstep + kstep, voffB);
        PG8_WAIT_V(6); PG8_BAR;
    }
    for (;;) {
        const bool has_next = S.next(ui + 1, nxt);
        const char* nA = has_next ? (const char*)g.A + (size_t)nxt.pm * tstep : cA; const char* nB = has_next ? (const char*)g.Bt + (size_t)nxt.pn * tstep : cB;
        for (int t = 0; t < nt; t += 2) {
            const bool last = (t == nt - 2);
            const char* a1 = cA + (size_t)(t + 1) * kstep;
            const char* a2 = last ? nA : cA + (size_t)(t + 2) * kstep; const char* b2 = last ? nB : cB + (size_t)(t + 2) * kstep;
            const char* a3 = a2 + kstep; const char* b3 = b2 + kstep;
            if (last && has_next) S.a_ready(nxt);
            if constexpr (SP2) {
            PG8_LDB(B0, 0, 0); PG8_LDB(B1, 0, 1); PG8_SCHED; PG8_LDA(At, 0, 0); PG8_STAGE(PG8_SA(1, 1), a1 + hstep, voffA);
            PG8_WAIT_V(8); PG8_WAIT_L(0); PG8_BAR; PG8_MMA(0, 0, At, B0); PG8_MMA(0, 1, At, B1); PG8_BAR; PG8_SCHED;
            PG8_LDA(At, 0, 1); PG8_STAGE(PG8_SB(0, 0), b2, voffB); PG8_STAGE(PG8_SB(0, 1), b2 + hstep, voffB); PG8_STAGE(PG8_SA(0, 0), a2, voffA);
            PG8_WAIT_V(8); PG8_WAIT_L(0); PG8_BAR; PG8_MMA(1, 0, At, B0); PG8_MMA(1, 1, At, B1); PG8_BAR; PG8_SCHED;
            PG8_LDB(B0, 1, 0); PG8_LDB(B1, 1, 1); PG8_SCHED; PG8_LDA(At, 1, 0); PG8_STAGE(PG8_SA(0, 1), a2 + hstep, voffA);
            PG8_WAIT_V(8); PG8_WAIT_L(0); PG8_BAR; PG8_MMA(0, 0, At, B0); PG8_MMA(0, 1, At, B1); PG8_BAR; PG8_SCHED;
            PG8_LDA(At, 1, 1); PG8_STAGE(PG8_SB(1, 0), b3, voffB); PG8_STAGE(PG8_SB(1, 1), b3 + hstep, voffB); PG8_STAGE(PG8_SA(1, 0), a3, voffA);
            PG8_WAIT_V(8); PG8_WAIT_L(0); PG8_BAR; PG8_MMA(1, 0, At, B0); PG8_MMA(1, 1, At, B1); PG8_BAR; PG8_SCHED;
            } else {
            PG8_LDB(B0, 0, 0); PG8_SCHED; PG8_LDA(At, 0, 0); PG8_STAGE(PG8_SA(1, 1), a1 + hstep, voffA);
            PG8_WAIT_L(8); PG8_BAR; PG8_WAIT_L(0); PG8_MMA(0, 0, At, B0); PG8_BAR; PG8_SCHED;
            PG8_LDB(B1, 0, 1); PG8_STAGE(PG8_SB(0, 0), b2, voffB);
            PG8_BAR; PG8_WAIT_L(0); PG8_MMA(0, 1, At, B1); PG8_BAR;
            PG8_LDA(At, 0, 1); PG8_STAGE(PG8_SA(0, 0), a2, voffA);
            PG8_BAR; PG8_WAIT_L(0); PG8_MMA(1, 0, At, B0); PG8_BAR; PG8_SCHED;
            PG8_STAGE(PG8_SB(0, 1), b2 + hstep, voffB);
            PG8_WAIT_V(6); PG8_BAR; PG8_MMA(1, 1, At, B1); PG8_BAR;
            PG8_LDB(B0, 1, 0); PG8_SCHED; PG8_LDA(At, 1, 0); PG8_STAGE(PG8_SA(0, 1), a2 + hstep, voffA);
            PG8_WAIT_L(8); PG8_BAR; PG8_WAIT_L(0); PG8_MMA(0, 0, At, B0); PG8_BAR; PG8_SCHED;
            PG8_LDB(B1, 1, 1); PG8_STAGE(PG8_SB(1, 0), b3, voffB);
            PG8_BAR; PG8_WAIT_L(0); PG8_MMA(0, 1, At, B1); PG8_BAR;
            PG8_LDA(At, 1, 1); PG8_STAGE(PG8_SA(1, 0), a3, voffA);
            PG8_BAR; PG8_WAIT_L(0); PG8_MMA(1, 0, At, B0); PG8_BAR; PG8_SCHED;
            PG8_STAGE(PG8_SB(1, 1), b3 + hstep, voffB);
            PG8_WAIT_V(6); PG8_BAR; PG8_MMA(1, 1, At, B1); PG8_BAR;
            }
        }
        if constexpr (ALIGN_EPI) { if (wr == 0) PG8_BAR; }
        if constexpr (!Epi::AFTER_DRAIN) { E(acc, cur, wr, wc, fr, fq); S.done(cur); }
        if (!has_next) break;
#pragma unroll
        for (int a = 0; a < 2; ++a)
#pragma unroll
            for (int b = 0; b < 2; ++b)
#pragma unroll
                for (int m = 0; m < 4; ++m)
#pragma unroll
                    for (int n = 0; n < 2; ++n) acc[a][b][m][n] = (f32x4){0.f, 0.f, 0.f, 0.f};
        cur = nxt; cA = nA; cB = nB; ++ui;
        if constexpr (ALIGN_EPI) { if (wr == 1) PG8_BAR; }
    }
    PG8_WAIT_V(0);
    if constexpr (!ALIGN_EPI) { if (wr == 0) PG8_BAR; }
    PG8_BAR;
    if constexpr (Epi::AFTER_DRAIN) { E.fused(acc, cur, wr, wc, fr, fq, lds, wid, lane); S.done(cur); }
#undef PG8_SA
#undef PG8_SB
#undef PG8_STAGE
#undef PG8_LDA
#undef PG8_LDB
#undef PG8_MMA
#undef PG8_WAIT_V
#undef PG8_WAIT_L
#undef PG8_BAR
#undef PG8_SCHED
}
}

#define LAS __attribute__((address_space(3)))
typedef unsigned short bf16;
typedef float f32x4 __attribute__((ext_vector_type(4)));
typedef float f32x2 __attribute__((ext_vector_type(2)));
typedef short bf16x8 __attribute__((ext_vector_type(8)));
typedef short bf16x4 __attribute__((ext_vector_type(4)));
typedef unsigned v4u __attribute__((ext_vector_type(4)));
typedef unsigned v2u __attribute__((ext_vector_type(2)));
typedef _Float16 h2 __attribute__((ext_vector_type(2)));
typedef _Float16 h4 __attribute__((ext_vector_type(4)));
typedef _Float16 h8 __attribute__((ext_vector_type(8)));

constexpr int DM = 1024, NBATCH = 8, SEQ = 4096, CTXL = 256, DEPTH = 4, DFF = 2816, DIN = 2720, DINP = 2816;
constexpr int ML = NBATCH * SEQ, MC = NBATCH * CTXL, MA = ML + MC;
constexpr int LORA_K = 512, LORA_N = 1536;
constexpr float ALPHA = 1.681792830507429f;
constexpr float LN_EPS = 1e-6f;
constexpr int PC_GQ = 0, PC_GK = 128, PC_GV = 256, PC_GG = 512, PC_ZF = 768, PC_SQ = 800, PC_SK = 1312, PC_SV = 1440, PC_RW = 1568;
constexpr int LC_DEC = 0, LC_A = 512, LC_G = 1024, LC_LG = 1280;
constexpr int RF_R = 0, RF_K = 256, RF_V = 512, RF_KK = 768;

constexpr size_t MiB = 1u << 20;
constexpr size_t WS_STATS = 131072;
constexpr size_t WS_MOD = 1 * MiB;
constexpr size_t WS_WGU1 = 3 * MiB;
constexpr size_t WS_WD1 = WS_WGU1 + 11 * MiB;
constexpr size_t WS_WGU2 = WS_WD1 + 6 * MiB;
constexpr size_t WS_WD2 = WS_WGU2 + 11 * MiB;
constexpr size_t WS_WIN = WS_WD2 + 6 * MiB;
constexpr size_t WS_WOUT = WS_WIN + 6 * MiB;
constexpr size_t WS_WLORA = WS_WOUT + 2 * MiB;
constexpr size_t WS_XC = WS_WLORA + 2 * MiB;
constexpr size_t WS_U = WS_XC + 8 * MiB;
constexpr size_t WS_HID = WS_U + 68 * MiB;
constexpr size_t WS_LO = WS_HID + 187 * MiB;
constexpr size_t WS_RF = WS_LO + 102 * MiB;
constexpr size_t WS_YO = WS_RF + 68 * MiB;
constexpr size_t WS_KV = WS_YO + 68 * MiB;
constexpr size_t WS_ST = WS_KV + 17 * MiB;
constexpr size_t WS_DEC = WS_ST + 17 * MiB;
constexpr size_t WS_END = WS_DEC + 1 * MiB;
constexpr int LDS_BYTES = 135168;

struct Args { const float* in[31]; float* out; unsigned char* ws; };
enum { I_X = 0, I_C, I_CTX, I_CCTX, I_WADA, I_BADA, I_F1G, I_F1U, I_F1D, I_F2G, I_F2U, I_F2D, I_LNG, I_LNB, I_WIN, I_WOUT, I_GUP, I_GBIAS, I_GNORM, I_SINK,
       I_MU, I_W0, I_WUP, I_A0, I_AUP, I_GUPR, I_KK, I_KA, I_RK, I_GNG, I_GNB };

__device__ __forceinline__ unsigned f2bf(float f) { unsigned u = __builtin_bit_cast(unsigned, f); return (u + 0x7fffu + ((u >> 16) & 1u)) >> 16; }
__device__ __forceinline__ unsigned pk2(float lo, float hi) { return f2bf(lo) | (f2bf(hi) << 16); }
__device__ __forceinline__ float bf2f(unsigned short u) { return __builtin_bit_cast(float, (unsigned)u << 16); }
__device__ __forceinline__ float bflo(unsigned u) { return __builtin_bit_cast(float, u << 16); }
__device__ __forceinline__ float bfhi(unsigned u) { return __builtin_bit_cast(float, u & 0xffff0000u); }
__device__ __forceinline__ float sigmoidf_(float x) { return 1.0f / (1.0f + __expf(-x)); }
__device__ __forceinline__ int otid() { int t = threadIdx.x; asm volatile("" : "+v"(t)); return t; }
__device__ __forceinline__ int obid() { int t = blockIdx.x; asm volatile("" : "+s"(t)); return t; }
__device__ __forceinline__ int ogdim() { int t = gridDim.x; asm volatile("" : "+s"(t)); return t; }
#define LDS_WAIT() asm volatile("s_waitcnt lgkmcnt(0)" ::: "memory")
template <int CTRL> __device__ __forceinline__ float dpp_f(float x) { return __builtin_bit_cast(float, __builtin_amdgcn_update_dpp(0, __builtin_bit_cast(int, x), CTRL, 0xF, 0xF, false)); }
__device__ __forceinline__ float allred16(float x) {
    x += dpp_f<0x128>(x); x += dpp_f<0x124>(x); x += dpp_f<0x122>(x); x += dpp_f<0x121>(x); return x;
}
__device__ __forceinline__ float wave_sum(float v) {
#pragma unroll
    for (int o = 1; o < 64; o <<= 1) v += __shfl_xor(v, o);
    return v;
}

__device__ __forceinline__ void phase_adaln(const Args& a, float* MOD, LAS unsigned char* lds) {
    LAS float* s = (LAS float*)lds;
    LAS float* red = s + 9 * 1024;
    const int tid = otid();
    for (int i = tid; i < 9 * 1024; i += 512) { const int bi = i >> 10, k = i & 1023; const float c = bi < 8 ? a.in[I_C][bi * 1024 + k] : a.in[I_CCTX][k]; s[i] = c * sigmoidf_(c); }
    __syncthreads();
    for (int unit = obid(); unit < 288; unit += ogdim()) {
        const int l = unit / 72, cb = unit % 72, col = cb * 128 + (tid & 127), kq = tid >> 7;
        const float* w = a.in[I_WADA] + (size_t)l * 1024 * 9216 + col;
        float acc[9];
#pragma unroll
        for (int bi = 0; bi < 9; ++bi) acc[bi] = 0.f;
#pragma unroll 8
        for (int k = kq * 256; k < kq * 256 + 256; ++k) { const float wv = w[(size_t)k * 9216];
#pragma unroll
            for (int bi = 0; bi < 9; ++bi) acc[bi] += s[bi * 1024 + k] * wv; }
#pragma unroll
        for (int bi = 0; bi < 9; ++bi) red[tid * 9 + bi] = acc[bi];
        __syncthreads();
        if (kq == 0) { const float bb = a.in[I_BADA][l * 9216 + col];
#pragma unroll
            for (int bi = 0; bi < 9; ++bi) { const float v = red[tid * 9 + bi] + red[(tid + 128) * 9 + bi] + red[(tid + 256) * 9 + bi] + red[(tid + 384) * 9 + bi] + bb;
                MOD[(size_t)(l * 9 + bi) * 9216 + col] = v; } }
        __syncthreads();
    }
}

__device__ __forceinline__ void transpose_item(const float* W, int K, int N, bf16* WT, int kb, int nb, int drow0, LAS float* scr, int lane) {
    const int k0 = 64 * kb, n0 = 32 * nb;
#pragma unroll 8
    for (int i = 0; i < 32; ++i) { const int kk = 2 * i + (lane >> 5); scr[kk * 33 + (lane & 31)] = W[(size_t)(k0 + kk) * N + n0 + (lane & 31)]; }
    LDS_WAIT(); asm volatile("" ::: "memory");
    const int c = lane & 7;
#pragma unroll
    for (int j = 0; j < 4; ++j) { const int n = (lane >> 3) + 8 * j; const LAS float* sp = scr + (8 * c) * 33 + n;
        v4u o; o.x = pk2(sp[0 * 33], sp[1 * 33]); o.y = pk2(sp[2 * 33], sp[3 * 33]); o.z = pk2(sp[4 * 33], sp[5 * 33]); o.w = pk2(sp[6 * 33], sp[7 * 33]);
        *(v4u*)(WT + (size_t)(drow0 + n) * K + k0 + 8 * c) = o; }
    LDS_WAIT(); asm volatile("" ::: "memory");
}
__device__ __forceinline__ void phase_convert(const Args& a, int l, unsigned char* ws, LAS unsigned char* lds) {
    const int tid = otid(), lane = tid & 63, wave = __builtin_amdgcn_readfirstlane(tid >> 6);
    LAS float* scr = (LAS float*)(lds + wave * 8704);
    const int gw = obid() * 8 + wave, NGW = ogdim() * 8;
    constexpr int I_GU = 16 * 88, I_D = 44 * 32, I_IN = 16 * 85, I_OUT = 16 * 32;
    constexpr int NIT = 4 * I_GU + 2 * I_D + I_IN + I_OUT;
    for (int it = gw; it < NIT; it += NGW) {
        int r = it;
        if (r < 4 * I_GU) { const int which = r / I_GU; r -= which * I_GU; const int kb = r / 88, nb = r % 88;
            const float* W = a.in[which == 0 ? I_F1G : which == 1 ? I_F1U : which == 2 ? I_F2G : I_F2U] + (size_t)l * 1024 * DFF;
            bf16* WT = (bf16*)(ws + (which < 2 ? WS_WGU1 : WS_WGU2));
            const int n0 = 32 * nb, drow0 = (n0 >> 7) * 256 + (which & 1) * 128 + (n0 & 127);
            transpose_item(W, 1024, DFF, WT, kb, nb, drow0, scr, lane); continue; }
        r -= 4 * I_GU;
        if (r < 2 * I_D) { const int which = r / I_D; r -= which * I_D; const int kb = r / 32, nb = r % 32;
            const float* W = a.in[which == 0 ? I_F1D : I_F2D] + (size_t)l * DFF * 1024;
            transpose_item(W, DFF, 1024, (bf16*)(ws + (which == 0 ? WS_WD1 : WS_WD2)), kb, nb, 32 * nb, scr, lane); continue; }
        r -= 2 * I_D;
        if (r < I_IN) { const int kb = r / 85, nb = r % 85;
            transpose_item(a.in[I_WIN] + (size_t)l * 1024 * DIN, 1024, DIN, (bf16*)(ws + WS_WIN), kb, nb, 32 * nb, scr, lane); continue; }
        r -= I_IN;
        { const int kb = r / 32, nb = r % 32; transpose_item(a.in[I_WOUT] + (size_t)l * 1024 * 1024, 1024, 1024, (bf16*)(ws + WS_WOUT), kb, nb, 32 * nb, scr, lane); }
    }
    const int gt = obid() * 512 + tid, NGT = ogdim() * 512;
    for (int i = gt; i < 96 * 1024 / 8; i += NGT) *(v4u*)((bf16*)(ws + WS_WIN) + (size_t)DIN * 1024 + (size_t)i * 8) = (v4u){0u, 0u, 0u, 0u};
    const float* wup = a.in[I_WUP] + (size_t)l * 2 * 64 * 256; const float* aup = a.in[I_AUP] + (size_t)l * 2 * 64 * 256;
    const float* gup = a.in[I_GUPR] + (size_t)l * 128 * 256; const float* ggu = a.in[I_GUP] + (size_t)l * 2 * 16 * 128;
    for (int ci = gt; ci < LORA_N * LORA_K / 8; ci += NGT) {
        const int n = ci >> 6, k8 = (ci & 63) * 8; float v[8];
#pragma unroll
        for (int e = 0; e < 8; ++e) v[e] = 0.f;
        const float* src = nullptr; int stride = 0;
        if (n < 256)       { if (k8 < 64)                 { src = wup + (size_t)k8 * 256 + n; stride = 256; } }
        else if (n < 512)  { if (k8 >= 64 && k8 < 128)    { src = wup + 64 * 256 + (size_t)(k8 - 64) * 256 + (n - 256); stride = 256; } }
        else if (n < 768)  { if (k8 >= 128 && k8 < 192)   { src = aup + (size_t)(k8 - 128) * 256 + (n - 512); stride = 256; } }
        else if (n < 1024) { if (k8 >= 192 && k8 < 256)   { src = aup + 64 * 256 + (size_t)(k8 - 192) * 256 + (n - 768); stride = 256; } }
        else if (n < 1280) { if (k8 >= 256 && k8 < 384)   { src = gup + (size_t)(k8 - 256) * 256 + (n - 1024); stride = 256; } }
        else if (n < 1408) { if (k8 >= 384 && k8 < 400)   { src = ggu + (size_t)(k8 - 384) * 128 + (n - 1280); stride = 128; } }
        else               { if (k8 >= 400 && k8 < 416)   { src = ggu + 16 * 128 + (size_t)(k8 - 400) * 128 + (n - 1408); stride = 128; } }
        if (src) {
#pragma unroll
            for (int e = 0; e < 8; ++e) v[e] = src[(size_t)e * stride]; }
        v4u o; o.x = pk2(v[0], v[1]); o.y = pk2(v[2], v[3]); o.z = pk2(v[4], v[5]); o.w = pk2(v[6], v[7]);
        *(v4u*)((bf16*)(ws + WS_WLORA) + (size_t)n * LORA_K + k8) = o;
    }
}

__device__ __forceinline__ float* xrow_ptr(float* xlat, float* xctx, int row) { return row < ML ? xlat + (size_t)row * 1024 : xctx + (size_t)(row - ML) * 1024; }
__device__ __forceinline__ int row_bi(int row) { return row < ML ? (row >> 12) : 8; }

__device__ __forceinline__ void phase_mod0(const Args& a, const float* MOD, bf16* U) {
    const int lane = otid() & 63, gw = obid() * 8 + (otid() >> 6), NGW = ogdim() * 8;
    for (int row = gw; row < MA; row += NGW) {
        const float* xr = row < ML ? a.in[I_X] + (size_t)row * 1024 : a.in[I_CTX] + (size_t)(row - ML) * 1024;
        const float* mp = MOD + (size_t)row_bi(row) * 9216;
#pragma unroll
        for (int j = 0; j < 4; ++j) { const int c = 4 * lane + 256 * j; const f32x4 v = *(const f32x4*)(xr + c), sh = *(const f32x4*)(mp + c), sc = *(const f32x4*)(mp + 1024 + c);
            const f32x4 o = v * (sc + 1.0f) + sh; v2u w; w.x = pk2(o.x, o.y); w.y = pk2(o.z, o.w); *(v2u*)(U + (size_t)row * 1024 + c) = w; }
    }
}
__device__ __forceinline__ void phase_ln(float* xlat, float* xctx, const float* lng, const float* lnb, const float* modn, bf16* U, int nrows, bool write_u, float* stats, bool write_x) {
    const int lane = otid() & 63, gw = obid() * 8 + (otid() >> 6), NGW = ogdim() * 8;
    for (int row = gw; row < nrows; row += NGW) {
        float* xr = xrow_ptr(xlat, xctx, row);
        f32x4 v[4]; float s = 0.f;
#pragma unroll
        for (int j = 0; j < 4; ++j) { v[j] = *(const f32x4*)(xr + 4 * lane + 256 * j); s += (v[j].x + v[j].y) + (v[j].z + v[j].w); }
        const float mean = wave_sum(s) * (1.0f / 1024.0f); float s2 = 0.f;
#pragma unroll
        for (int j = 0; j < 4; ++j) { v[j] = v[j] - mean; s2 += (v[j].x * v[j].x + v[j].y * v[j].y) + (v[j].z * v[j].z + v[j].w * v[j].w); }
        const float rstd = 1.0f / sqrtf(wave_sum(s2) * (1.0f / 1024.0f) + LN_EPS);
        const float* mp = modn + (size_t)row_bi(row) * 9216;
        if (lane == 0) *(f32x2*)(stats + 2 * (size_t)row) = (f32x2){mean, rstd};
#pragma unroll
        for (int j = 0; j < 4; ++j) { const int c = 4 * lane + 256 * j; const f32x4 h = v[j] * rstd * *(const f32x4*)(lng + c) + *(const f32x4*)(lnb + c);
            if (write_x) *(f32x4*)(xr + c) = h;
            if (write_u) { const f32x4 sh = *(const f32x4*)(mp + c), sc = *(const f32x4*)(mp + 1024 + c); const f32x4 o = h * (sc + 1.0f) + sh;
                v2u w; w.x = pk2(o.x, o.y); w.y = pk2(o.z, o.w); *(v2u*)(U + (size_t)row * 1024 + c) = w; } }
    }
}

__device__ __forceinline__ void phase_features(const Args& a, int l, bf16* P, _Float16* RF, bf16* AP, LAS unsigned char* lds) {
    LAS f32x2* tab = (LAS f32x2*)lds;
    const int tid = otid(), lane = tid & 63;
    for (int i = tid; i < 1024; i += 512) { const int pos = i >> 4, fi = i & 15; const float inv = exp2f(-(float)fi * (13.287712379549449f / 16.0f)); const float ang = (float)pos * inv;
        tab[i] = (f32x2){cosf(ang), sinf(ang)}; }
    __syncthreads();
    const float* mu = a.in[I_MU] + l * 1152; const float* kkw = a.in[I_KK] + l * 256;
    const int gw = obid() * 8 + (tid >> 6), NGW = ogdim() * 8;
    for (int row = gw; row < MA; row += NGW) {
        const bool lat = row < ML; const int t = lat ? (row & 4095) : ((row - ML) & 255); const int len = lat ? SEQ : CTXL;
        bf16* pr = P + (size_t)row * DINP;
        const float hp = t > 0 ? 0.5f : 0.f, hn = t < len - 1 ? 0.5f : 0.f;
        const bf16* rw = pr + PC_RW; const bf16* rwp = t > 0 ? rw - DINP : rw; const bf16* rwn = t < len - 1 ? rw + DINP : rw;
        _Float16* rf = RF + (size_t)row * 1024; bf16* ap = AP + (size_t)row * LORA_K;
#pragma unroll
        for (int j = 0; j < 9; ++j) {
            const int col = 2 * (lane + 64 * j);
            const unsigned uc = *(const unsigned*)(rw + col), up = *(const unsigned*)(rwp + col), un = *(const unsigned*)(rwn + col);
            const f32x2 m2 = *(const f32x2*)(mu + col);
            const float c0 = bflo(uc), c1 = bfhi(uc);
            const float f0 = c0 + m2.x * (hp * bflo(up) + hn * bflo(un) - c0), f1 = c1 + m2.y * (hp * bfhi(up) + hn * bfhi(un) - c1);
            if (j < 2) { *(h2*)(rf + RF_R + col) = (h2){(_Float16)f0, (_Float16)f1}; }
            else if (j < 4) { const int kc = col - 256; *(h2*)(rf + RF_K + kc) = (h2){(_Float16)f0, (_Float16)f1};
                const f32x2 kw = *(const f32x2*)(kkw + kc); const float q0 = f0 * kw.x, q1 = f1 * kw.y; float ss = q0 * q0 + q1 * q1;
#pragma unroll
                for (int o = 1; o < 32; o <<= 1) ss += __shfl_xor(ss, o);
                const float inv = 1.0f / fmaxf(sqrtf(ss), 1e-12f);
                *(h2*)(rf + RF_KK + kc) = (h2){(_Float16)(q0 * inv), (_Float16)(q1 * inv)}; }
            else if (j < 6) { *(h2*)(rf + RF_V + (col - 512)) = (h2){(_Float16)f0, (_Float16)f1}; }
            else if (j == 6) { *(unsigned*)(ap + (col - 768)) = pk2(tanhf(f0), tanhf(f1)); }
            else if (j == 7) { *(unsigned*)(ap + 128 + (col - 896)) = pk2(f0, f1); }
            else { *(unsigned*)(ap + 256 + (col - 1024)) = pk2(sigmoidf_(f0), sigmoidf_(f1)); }
        }
        { unsigned z = 0u; if (lane < 16) z = *(const unsigned*)(pr + PC_ZF + 2 * lane); *(unsigned*)(ap + 384 + 2 * lane) = z; }
#pragma unroll
        for (int j = 0; j < 5; ++j) {
            const int head = 2 * j + (lane >> 5), pi = lane & 31, fi = pi & 15;
            const int d1 = pi < 16 ? pi : 16 + pi, pos = pi < 16 ? (t >> 6) : (t & 63);
            bf16* hb = pr + (head < 8 ? PC_SQ + head * 64 : PC_SK + (head - 8) * 64);
            const float x1 = bf2f(hb[d1]), x2 = bf2f(hb[d1 + 16]);
            float o1 = x1, o2 = x2;
            if (lat) { const f32x2 cs = tab[pos * 16 + fi]; o1 = x1 * cs.x - x2 * cs.y; o2 = x1 * cs.y + x2 * cs.x; }
            if (head < 8) { o1 *= 0.125f; o2 *= 0.125f; }
            if (lat || head < 8) { hb[d1] = (bf16)f2bf(o1); hb[d1 + 16] = (bf16)f2bf(o2); }
        }
    }
}

__device__ __forceinline__ void phase_rwkv(const Args& a, int l, const _Float16* RF, const _Float16* LO, _Float16* YO, LAS unsigned char* lds) {
    constexpr int T = 32, SF = 336, NCH = (CTXL + SEQ) / T;
    LAS float* buf = (LAS float*)lds; LAS float* ybuf = buf + 2 * T * SF;
    const int tid = otid(), wave = __builtin_amdgcn_readfirstlane(tid >> 6), lane = tid & 63;
    for (int unit = obid(); unit < 256; unit += ogdim()) {
        const int chain = unit >> 2, rq = unit & 3, b = chain >> 3, h = (chain >> 1) & 3, dir = chain & 1;
        _Float16* Y = YO + (size_t)dir * MA * 256;
        const int ltid = tid - 256, lstep = ltid >> 3, lkq = ltid & 7, cols = h * 64 + 8 * lkq;
        float ka[8];
        if (wave >= 4) {
#pragma unroll
            for (int e = 0; e < 8; ++e) ka[e] = a.in[I_KA][l * 256 + cols + e]; }
        auto step_row = [&](int s) -> int { if (s < CTXL) return ML + b * CTXL + (dir ? CTXL - 1 - s : s); const int tq = s - CTXL; return b * SEQ + (dir ? SEQ - 1 - tq : tq); };
        h8 s0r, s0k, s0v, s0q, s0w, s0a, s1r, s1k, s1v, s1q, s1w, s1a, s2r, s2k, s2v, s2q, s2w, s2a;
#define RW_LOAD(c, R8, K8, V8, Q8, W8, A8) do { const int row_ = step_row((c) * T + lstep); \
            const _Float16* rf_ = RF + (size_t)row_ * 1024 + cols; const _Float16* lo_ = LO + (size_t)row_ * 1536 + dir * 256 + cols; \
            R8 = *(const h8*)(rf_ + RF_R); K8 = *(const h8*)(rf_ + RF_K); V8 = *(const h8*)(rf_ + RF_V); Q8 = *(const h8*)(rf_ + RF_KK); \
            W8 = *(const h8*)(lo_ + LC_DEC); A8 = *(const h8*)(lo_ + LC_A); } while (0)
#define RW_WRITE(c, R8, K8, V8, Q8, W8, A8) do { LAS float* d_ = buf + ((c) & 1) * T * SF + lstep * SF + 8 * lkq; \
            _Pragma("unroll") for (int e = 0; e < 8; ++e) { const float kk_ = (float)Q8[e], av_ = (float)A8[e], kv_ = (float)K8[e]; \
                d_[e] = kk_; d_[64 + e] = (float)W8[e]; d_[128 + e] = -(kk_ * av_); d_[192 + e] = kv_ * (1.0f + (av_ - 1.0f) * ka[e]); d_[256 + e] = (float)R8[e]; } \
            if ((lkq >> 1) == rq) { LAS float* dv_ = buf + ((c) & 1) * T * SF + lstep * SF + 320 + (lkq & 1) * 8; \
                _Pragma("unroll") for (int e = 0; e < 8; ++e) dv_[e] = (float)V8[e]; } } while (0)
        auto flush_y = [&](int c) {
            const int row = step_row(c * T + lstep);
            const LAS float* yb = ybuf + (c & 1) * T * 16 + lstep * 16 + 2 * lkq;
            *(h2*)(Y + (size_t)row * 256 + h * 64 + rq * 16 + 2 * lkq) = (h2){(_Float16)yb[0], (_Float16)yb[1]};
        };
        f32x4 S = (f32x4){0.f, 0.f, 0.f, 0.f};
        const int kg = lane & 15, ri = wave * 4 + (lane >> 4);
#define RW_BAR() do { asm volatile("s_waitcnt lgkmcnt(0)" ::: "memory"); __builtin_amdgcn_s_barrier(); asm volatile("" ::: "memory"); } while (0)
#define LSET(c, P) RW_LOAD(c, P##r, P##k, P##v, P##q, P##w, P##a)
#define WSET(c, P) RW_WRITE(c, P##r, P##k, P##v, P##q, P##w, P##a)
        if (wave >= 4) {
            LSET(0, s0); WSET(0, s0); LSET(1, s1); LSET(2, s2);
            RW_BAR();
            for (int c = 0; c < NCH; c += 3) {
                if (c + 3 < NCH) LSET(c + 3, s0);
                if (c + 1 < NCH) WSET(c + 1, s1);
                if (c > 0) flush_y(c - 1);
                RW_BAR();
                if (c + 1 < NCH) {
                    if (c + 4 < NCH) LSET(c + 4, s1);
                    if (c + 2 < NCH) WSET(c + 2, s2);
                    flush_y(c);
                    RW_BAR();
                }
                if (c + 2 < NCH) {
                    if (c + 5 < NCH) LSET(c + 5, s2);
                    if (c + 3 < NCH) WSET(c + 3, s0);
                    flush_y(c + 1);
                    RW_BAR();
                }
            }
        } else {
            RW_BAR();
            for (int c = 0; c < NCH; ++c) {
                const LAS float* bc = buf + (c & 1) * T * SF + 4 * kg; const LAS float* vb = buf + (c & 1) * T * SF + 320 + ri;
                LAS float* yw = (kg == 0) ? (ybuf + (c & 1) * T * 16 + ri) : (ybuf + 2 * T * 16 + lane);
                f32x4 Akk, Aw, Ab, Akd, Ar, Bkk, Bw, Bb, Bkd, Br, Ckk, Cw, Cb, Ckd, Cr; float Av, Bv, Cv;
                const unsigned bca = (unsigned)(uintptr_t)bc, vba = (unsigned)(uintptr_t)vb, ywa = (unsigned)(uintptr_t)yw;
#define RW_LD(X, s_) asm volatile("ds_read_b128 %0, %7 offset:%9\n\tds_read_b128 %1, %7 offset:%10\n\tds_read_b128 %2, %7 offset:%11\n\tds_read_b128 %3, %7 offset:%12\n\tds_read_b128 %4, %7 offset:%13\n\tds_read_b32 %5, %8 offset:%9" \
                    : "=&v"(X##kk), "=&v"(X##w), "=&v"(X##b), "=&v"(X##kd), "=&v"(X##r), "=&v"(X##v), "+v"(S) : "v"(bca), "v"(vba), "n"((s_) * SF * 4), "n"((s_) * SF * 4 + 256), "n"((s_) * SF * 4 + 512), "n"((s_) * SF * 4 + 768), "n"((s_) * SF * 4 + 1024))
#define RW_WAIT(X) asm volatile("s_waitcnt lgkmcnt(0)" : "+v"(X##kk), "+v"(X##w), "+v"(X##b), "+v"(X##kd), "+v"(X##r), "+v"(X##v), "+v"(S))
#define RW_YW(s_, Y_) asm volatile("ds_write_b32 %0, %1 offset:%2" :: "v"(ywa), "v"(Y_), "n"((s_) * 64) : "memory")
#define RW_DOT(V_, W_) __builtin_fmaf(V_.w, W_.w, __builtin_fmaf(V_.z, W_.z, __builtin_fmaf(V_.y, W_.y, V_.x * W_.x)))
#define RW_BODY(s_, X, Xn, Xnn, Xp) do { if ((s_) < T) { float yp_ = 0.f; \
                    if ((s_) > 0) yp_ = allred16(RW_DOT(S, Xp##r)); \
                    const f32x4 u_ = S * X##w + X##kd * X##v; const float sa_ = allred16(RW_DOT(S, X##kk)); S = u_ + X##b * sa_;     \
                    if ((s_) + 1 < T) RW_WAIT(Xn); if ((s_) > 0) RW_YW((s_) - 1, yp_); if ((s_) + 2 < T) RW_LD(Xnn, (s_) + 2); } } while (0)
                RW_LD(A, 0); RW_LD(B, 1); RW_WAIT(A);
#pragma unroll
                for (int s = 0; s < T + 2; s += 3) { RW_BODY(s, A, B, C, C); RW_BODY(s + 1, B, C, A, A); RW_BODY(s + 2, C, A, B, B); }
                { const float yl_ = allred16(RW_DOT(S, Br)); RW_YW(T - 1, yl_); }
                static_assert(T == 32, "the tail above assumes (T - 1) % 3 == 1");
#undef RW_WAIT
#undef RW_YW
#undef RW_LD
#undef RW_DOT
#undef RW_BODY
                RW_BAR();
            }
        }
#undef LSET
#undef WSET
#undef RW_BAR
        if (wave >= 4) flush_y(NCH - 1);
        __syncthreads();
    }
#undef RW_LOAD
#undef RW_WRITE
}

template <int CTRL> __device__ __forceinline__ float dpp0_f(float x) { return __builtin_bit_cast(float, __builtin_amdgcn_update_dpp(0, __builtin_bit_cast(int, x), CTRL, 0xF, 0xF, true)); }
__device__ __forceinline__ void phase_gla_a(int l, bf16* P, const _Float16* LO, _Float16* YO, _Float16* KV, float* DEC, LAS unsigned char* lds) {
    LAS bf16* Vt = (LAS bf16*)lds;
    LAS bf16* KhT = Vt + 4 * 64 * 72;
    const int tid = otid(), wave = __builtin_amdgcn_readfirstlane(tid >> 6), lane = tid & 63, r = lane & 15, kq = lane >> 4, h = wave >> 1, dir = wave & 1;
    LAS bf16* Vh = Vt + h * 64 * 72; LAS bf16* Kw = KhT + wave * 32 * 72;
    for (int unit = obid(); unit < 544; unit += ogdim()) {
        const int b = unit / 68, cc = unit % 68; const int row0 = cc < 4 ? ML + b * CTXL + cc * 64 : b * SEQ + (cc - 4) * 64;
        const int u = ((b * 4 + h) * 2 + dir) * 68 + cc;
        __syncthreads();
        {   const int j = tid >> 3, c8 = tid & 7; const bf16* src = P + (size_t)(row0 + j) * DINP + PC_GV;
#pragma unroll
            for (int q = 0; q < 4; ++q) { const int col = 8 * (c8 + 8 * q); const v4u v8 = *(const v4u*)(src + col);
                LAS bf16* vd = Vt + (col >> 6) * 64 * 72 + (col & 63) * 72 + j;
                vd[0 * 72] = (bf16)(v8.x & 0xffffu); vd[1 * 72] = (bf16)(v8.x >> 16); vd[2 * 72] = (bf16)(v8.y & 0xffffu); vd[3 * 72] = (bf16)(v8.y >> 16);
                vd[4 * 72] = (bf16)(v8.z & 0xffffu); vd[5 * 72] = (bf16)(v8.z >> 16); vd[6 * 72] = (bf16)(v8.w & 0xffffu); vd[7 * 72] = (bf16)(v8.w >> 16); } }
        v4u q8[4], k8[4]; h8 g8[4];
#pragma unroll
        for (int ib = 0; ib < 4; ++ib) { const size_t row = (size_t)(row0 + 16 * ib + r);
            q8[ib] = *(const v4u*)(P + row * DINP + PC_GQ + h * 32 + 8 * kq); k8[ib] = *(const v4u*)(P + row * DINP + PC_GK + h * 32 + 8 * kq);
            g8[ib] = *(const h8*)(LO + row * 1536 + LC_LG + dir * 128 + h * 32 + 8 * kq); }
        __syncthreads();
        float pre[4][8], G[8];
#pragma unroll
        for (int e = 0; e < 8; ++e) { float carry = 0.f;
#pragma unroll
            for (int ib = 0; ib < 4; ++ib) { const float g = (float)g8[ib][e]; float x = g;
                x += dpp0_f<0x111>(x); x += dpp0_f<0x112>(x); x += dpp0_f<0x114>(x); x += dpp0_f<0x118>(x);
                pre[ib][e] = x + carry; carry += allred16(g); }
            G[e] = carry; }
        bf16x8 qf[4], kf[4];
#pragma unroll
        for (int ib = 0; ib < 4; ++ib) { float qs[8], ks[8], kh[8];
            const unsigned qu[4] = {q8[ib].x, q8[ib].y, q8[ib].z, q8[ib].w}, ku[4] = {k8[ib].x, k8[ib].y, k8[ib].z, k8[ib].w};
#pragma unroll
            for (int e = 0; e < 8; ++e) { const float qv = (e & 1) ? bfhi(qu[e >> 1]) : bflo(qu[e >> 1]), kv = (e & 1) ? bfhi(ku[e >> 1]) : bflo(ku[e >> 1]);
                const float bb = dir ? (G[e] - pre[ib][e] + (float)g8[ib][e]) : pre[ib][e];
                qs[e] = qv * 0.17677669529663687f * __expf(bb); ks[e] = kv * __expf(-bb); kh[e] = kv * __expf(G[e] - bb);
                Kw[(8 * kq + e) * 72 + 16 * ib + r] = (bf16)f2bf(kh[e]); }
            v4u qw, kw; qw.x = pk2(qs[0], qs[1]); qw.y = pk2(qs[2], qs[3]); qw.z = pk2(qs[4], qs[5]); qw.w = pk2(qs[6], qs[7]);
            kw.x = pk2(ks[0], ks[1]); kw.y = pk2(ks[2], ks[3]); kw.z = pk2(ks[4], ks[5]); kw.w = pk2(ks[6], ks[7]);
            qf[ib] = __builtin_bit_cast(bf16x8, qw); kf[ib] = __builtin_bit_cast(bf16x8, kw);
            *(v4u*)(P + (size_t)(row0 + 16 * ib + r) * DINP + (dir ? PC_GK : PC_GQ) + h * 32 + 8 * kq) = qw; }
        if (r == 0) {
#pragma unroll
            for (int e = 0; e < 8; ++e) DEC[(size_t)u * 32 + 8 * kq + e] = __expf(G[e]); }
        LDS_WAIT(); asm volatile("" ::: "memory");
#pragma unroll
        for (int ib = 0; ib < 4; ++ib) {
            f32x4 oT[4];
#pragma unroll
            for (int eb = 0; eb < 4; ++eb) oT[eb] = (f32x4){0.f, 0.f, 0.f, 0.f};
#pragma unroll
            for (int kk = 0; kk < 2; ++kk) {
                const bool any = dir ? (2 * kk + 1 >= ib) : (2 * kk <= ib);
                if (any) {
                    f32x4 sb[2];
#pragma unroll
                    for (int x = 0; x < 2; ++x) { const int jb = 2 * kk + x; sb[x] = (f32x4){0.f, 0.f, 0.f, 0.f};
                        const bool need = dir ? (jb >= ib) : (jb <= ib);
                        if (need) { sb[x] = __builtin_amdgcn_mfma_f32_16x16x32_bf16(kf[jb], qf[ib], sb[x], 0, 0, 0);
                            if (jb == ib) {
#pragma unroll
                                for (int reg = 0; reg < 4; ++reg) { const int jj = 4 * kq + reg; const bool keep = dir ? (jj >= r) : (jj <= r); if (!keep) sb[x][reg] = 0.f; } } } }
                    v4u pw; pw.x = pk2(sb[0][0], sb[0][1]); pw.y = pk2(sb[0][2], sb[0][3]); pw.z = pk2(sb[1][0], sb[1][1]); pw.w = pk2(sb[1][2], sb[1][3]);
                    const bf16x8 pf = __builtin_bit_cast(bf16x8, pw);
#pragma unroll
                    for (int eb = 0; eb < 4; ++eb) { const LAS bf16* vp = Vh + (16 * eb + r) * 72 + 32 * kk + 4 * kq;
                        const v2u va = *(const LAS v2u*)vp, vb = *(const LAS v2u*)(vp + 16);
                        const bf16x8 vf = __builtin_bit_cast(bf16x8, (v4u){va.x, va.y, vb.x, vb.y});
                        oT[eb] = __builtin_amdgcn_mfma_f32_16x16x32_bf16(vf, pf, oT[eb], 0, 0, 0); }
                }
            }
            _Float16* op = YO + ((size_t)(2 + dir) * MA + row0 + 16 * ib + r) * 256 + h * 64 + 4 * kq;
#pragma unroll
            for (int eb = 0; eb < 4; ++eb) *(h4*)(op + 16 * eb) = (h4){(_Float16)oT[eb][0], (_Float16)oT[eb][1], (_Float16)oT[eb][2], (_Float16)oT[eb][3]};
        }
        f32x4 kvt[4][2];
#pragma unroll
        for (int eb = 0; eb < 4; ++eb) { kvt[eb][0] = (f32x4){0.f, 0.f, 0.f, 0.f}; kvt[eb][1] = (f32x4){0.f, 0.f, 0.f, 0.f}; }
#pragma unroll
        for (int kk = 0; kk < 2; ++kk) {
            bf16x8 bfr[2];
#pragma unroll
            for (int nb = 0; nb < 2; ++nb) bfr[nb] = *(const LAS bf16x8*)(Kw + (16 * nb + r) * 72 + 32 * kk + 8 * kq);
#pragma unroll
            for (int eb = 0; eb < 4; ++eb) { const bf16x8 afr = *(const LAS bf16x8*)(Vh + (16 * eb + r) * 72 + 32 * kk + 8 * kq);
                kvt[eb][0] = __builtin_amdgcn_mfma_f32_16x16x32_bf16(afr, bfr[0], kvt[eb][0], 0, 0, 0);
                kvt[eb][1] = __builtin_amdgcn_mfma_f32_16x16x32_bf16(afr, bfr[1], kvt[eb][1], 0, 0, 0); } }
        _Float16* kvp = KV + (size_t)u * 2048;
#pragma unroll
        for (int eb = 0; eb < 4; ++eb)
#pragma unroll
            for (int nb = 0; nb < 2; ++nb)
#pragma unroll
                for (int reg = 0; reg < 4; ++reg) kvp[(16 * eb + 4 * kq + reg) * 32 + 16 * nb + r] = (_Float16)kvt[eb][nb][reg];
    }
}
__device__ __forceinline__ void phase_gla_b(const _Float16* KV, const float* DEC, bf16* ST) {
    for (int g = obid() * 512 + otid(); g < 64 * 2048; g += ogdim() * 512) {
        const int chain = g >> 11, idx = g & 2047, d = idx & 31, dir = chain & 1;
        float S = 0.f;
#pragma unroll 1
        for (int s0 = 0; s0 < 68; s0 += 17) {
            float kvv[17], dc[17]; int uu[17];
#pragma unroll
            for (int x = 0; x < 17; ++x) { const int step = s0 + x; const int cc = dir ? (step < 4 ? 3 - step : 71 - step) : step; uu[x] = chain * 68 + cc;
                kvv[x] = (float)KV[(size_t)uu[x] * 2048 + idx]; dc[x] = DEC[(size_t)uu[x] * 32 + d]; }
#pragma unroll
            for (int x = 0; x < 17; ++x) { ST[(size_t)uu[x] * 2048 + idx] = (bf16)f2bf(S); S = dc[x] * S + kvv[x]; }
        }
    }
}
__device__ __forceinline__ void phase_gla_c(const bf16* P, const bf16* ST, _Float16* YO) {
    const int tid = otid(), wave = __builtin_amdgcn_readfirstlane(tid >> 6), lane = tid & 63, r = lane & 15, kq = lane >> 4, h = wave >> 1, dir = wave & 1;
    for (int unit = obid(); unit < 544; unit += ogdim()) {
        const int b = unit / 68, cc = unit % 68; const int row0 = cc < 4 ? ML + b * CTXL + cc * 64 : b * SEQ + (cc - 4) * 64;
        const int u = ((b * 4 + h) * 2 + dir) * 68 + cc;
        bf16x8 af[4];
#pragma unroll
        for (int eb = 0; eb < 4; ++eb) af[eb] = *(const bf16x8*)(ST + (size_t)u * 2048 + (16 * eb + r) * 32 + 8 * kq);
#pragma unroll
        for (int ib = 0; ib < 4; ++ib) {
            const bf16x8 qf = *(const bf16x8*)(P + (size_t)(row0 + 16 * ib + r) * DINP + (dir ? PC_GK : PC_GQ) + h * 32 + 8 * kq);
            _Float16* op = YO + ((size_t)(2 + dir) * MA + row0 + 16 * ib + r) * 256 + h * 64 + 4 * kq;
#pragma unroll
            for (int eb = 0; eb < 4; ++eb) { f32x4 acc = (f32x4){0.f, 0.f, 0.f, 0.f};
                acc = __builtin_amdgcn_mfma_f32_16x16x32_bf16(af[eb], qf, acc, 0, 0, 0);
                const h4 old = *(const h4*)(op + 16 * eb);
                *(h4*)(op + 16 * eb) = (h4){(_Float16)((float)old[0] + acc[0]), (_Float16)((float)old[1] + acc[1]), (_Float16)((float)old[2] + acc[2]), (_Float16)((float)old[3] + acc[3])}; }
        }
    }
}

__device__ __forceinline__ void phase_swa(const Args& a, int l, const bf16* P, bf16* MIX, bool with_ctx, LAS unsigned char* lds) {
    LAS bf16* Ks = (LAS bf16*)lds;
    LAS bf16* Vt = Ks + 64 * 72;
    const int tid = otid(), wave = __builtin_amdgcn_readfirstlane(tid >> 6), lane = tid & 63, li = lane & 15, lq = lane >> 4;
    const int nunits = with_ctx ? 1088 : 1024;
    for (int u = obid(); u < nunits; u += ogdim()) {
        const bool isctx = u >= 1024;
        int b, kvh, blk;
        if (!isctx) { b = u >> 7; kvh = (u >> 6) & 1; blk = u & 63; } else { const int v = u - 1024; b = v >> 3; kvh = (v >> 2) & 1; blk = v & 3; }
        const int g = wave >> 1, half = wave & 1, hq = kvh * 4 + g;
        const int qtok0 = blk * 64 + half * 32, qrow0 = isctx ? ML + b * CTXL + qtok0 : b * SEQ + qtok0;
        bf16x8 qf[2][2];
#pragma unroll
        for (int qb = 0; qb < 2; ++qb)
#pragma unroll
            for (int ks = 0; ks < 2; ++ks) qf[qb][ks] = *(const bf16x8*)(P + (size_t)(qrow0 + 16 * qb + li) * DINP + PC_SQ + hq * 64 + 32 * ks + 8 * lq);
        f32x4 Oa[4][2];
#pragma unroll
        for (int x = 0; x < 4; ++x)
#pragma unroll
            for (int y = 0; y < 2; ++y) Oa[x][y] = (f32x4){0.f, 0.f, 0.f, 0.f};
        const float sinkv = a.in[I_SINK][l * 8 + hq];
        float mrun[2], lrun[2];
#pragma unroll
        for (int qb = 0; qb < 2; ++qb) { mrun[qb] = sinkv; lrun[qb] = lq == 0 ? 1.0f : 0.f; }
        int lo = 0, nlocal = 0;
        if (!isctx) { lo = 64 * blk - 128; if (lo < 0) lo = 0; int hi = 64 * blk + 192; if (hi > SEQ) hi = SEQ; nlocal = (hi - lo) >> 6; }
        const int ntiles = nlocal + 4;
        const int skey = tid >> 3, sch = tid & 7;
        v4u pk_, pv_;
        {   const int kr0 = nlocal > 0 ? b * SEQ + lo : ML + b * CTXL; const bf16* src = P + (size_t)(kr0 + skey) * DINP;
            pk_ = *(const v4u*)(src + PC_SK + kvh * 64 + 8 * sch); pv_ = *(const v4u*)(src + PC_SV + kvh * 64 + 8 * sch); }
        for (int t = 0; t < ntiles; ++t) {
            const bool local = t < nlocal; const int ktok0 = local ? lo + 64 * t : 64 * (t - nlocal);
            asm volatile("s_waitcnt lgkmcnt(0)" ::: "memory"); __builtin_amdgcn_s_barrier(); asm volatile("" ::: "memory");
            {   *(LAS v4u*)(Ks + skey * 72 + 8 * sch) = pk_;
                const v4u v8 = pv_;
                LAS bf16* vd = Vt + (8 * sch) * 68 + skey;
                vd[0 * 68] = (bf16)(v8.x & 0xffffu); vd[1 * 68] = (bf16)(v8.x >> 16); vd[2 * 68] = (bf16)(v8.y & 0xffffu); vd[3 * 68] = (bf16)(v8.y >> 16);
                vd[4 * 68] = (bf16)(v8.z & 0xffffu); vd[5 * 68] = (bf16)(v8.z >> 16); vd[6 * 68] = (bf16)(v8.w & 0xffffu); vd[7 * 68] = (bf16)(v8.w >> 16); }
            if (t + 1 < ntiles) { const int t1 = t + 1; const bool l1 = t1 < nlocal; const int kt1 = l1 ? lo + 64 * t1 : 64 * (t1 - nlocal); const int kr1 = l1 ? b * SEQ + kt1 : ML + b * CTXL + kt1;
                const bf16* src = P + (size_t)(kr1 + skey) * DINP;
                pk_ = *(const v4u*)(src + PC_SK + kvh * 64 + 8 * sch); pv_ = *(const v4u*)(src + PC_SV + kvh * 64 + 8 * sch); }
            asm volatile("s_waitcnt lgkmcnt(0)" ::: "memory"); __builtin_amdgcn_s_barrier(); asm volatile("" ::: "memory");
            const bool rel = !local || (ktok0 + 63 >= qtok0 - 128 && ktok0 <= qtok0 + 31 + 128);
            if (rel) {
#pragma unroll
                for (int qb = 0; qb < 2; ++qb) {
                    f32x4 s[4];
#pragma unroll
                    for (int kb = 0; kb < 4; ++kb) { s[kb] = (f32x4){0.f, 0.f, 0.f, 0.f};
#pragma unroll
                        for (int ks = 0; ks < 2; ++ks) { const bf16x8 kf = *(const LAS bf16x8*)(Ks + (16 * kb + li) * 72 + 32 * ks + 8 * lq);
                            s[kb] = __builtin_amdgcn_mfma_f32_16x16x32_bf16(kf, qf[qb][ks], s[kb], 0, 0, 0); } }
                    if (local) { const int qt = qtok0 + 16 * qb + li;
#pragma unroll
                        for (int kb = 0; kb < 4; ++kb)
#pragma unroll
                            for (int j = 0; j < 4; ++j) { const int dlt = ktok0 + 16 * kb + 4 * lq + j - qt; if (dlt > 128 || dlt < -128) s[kb][j] = -INFINITY; } }
                    float mx = -INFINITY;
#pragma unroll
                    for (int kb = 0; kb < 4; ++kb) mx = fmaxf(mx, fmaxf(fmaxf(s[kb][0], s[kb][1]), fmaxf(s[kb][2], s[kb][3])));
                    mx = fmaxf(mx, __shfl_xor(mx, 16)); mx = fmaxf(mx, __shfl_xor(mx, 32));
                    const float mnew = fmaxf(mrun[qb], mx), corr = __expf(mrun[qb] - mnew); mrun[qb] = mnew;
                    float ls = 0.f;
#pragma unroll
                    for (int kb = 0; kb < 4; ++kb)
#pragma unroll
                        for (int j = 0; j < 4; ++j) { const float p = __expf(s[kb][j] - mnew); s[kb][j] = p; ls += p; }
                    lrun[qb] = lrun[qb] * corr + ls;
#pragma unroll
                    for (int db = 0; db < 4; ++db) Oa[db][qb] = Oa[db][qb] * corr;
#pragma unroll
                    for (int kk = 0; kk < 2; ++kk) {
                        v4u pw; pw.x = pk2(s[2 * kk][0], s[2 * kk][1]); pw.y = pk2(s[2 * kk][2], s[2 * kk][3]); pw.z = pk2(s[2 * kk + 1][0], s[2 * kk + 1][1]); pw.w = pk2(s[2 * kk + 1][2], s[2 * kk + 1][3]);
                        const bf16x8 pf = __builtin_bit_cast(bf16x8, pw);
#pragma unroll
                        for (int db = 0; db < 4; ++db) { const LAS bf16* vp = Vt + (16 * db + li) * 68 + 32 * kk + 4 * lq;
                            const v2u va = *(const LAS v2u*)vp, vb = *(const LAS v2u*)(vp + 16);
                            const bf16x8 vf = __builtin_bit_cast(bf16x8, (v4u){va.x, va.y, vb.x, vb.y});
                            Oa[db][qb] = __builtin_amdgcn_mfma_f32_16x16x32_bf16(vf, pf, Oa[db][qb], 0, 0, 0); }
                    }
                }
            }
        }
#pragma unroll
        for (int qb = 0; qb < 2; ++qb) { float lt = lrun[qb]; lt += __shfl_xor(lt, 16); lt += __shfl_xor(lt, 32); const float inv = 1.0f / lt;
            bf16* op = MIX + (size_t)(qrow0 + 16 * qb + li) * 1024 + 256 + hq * 64 + 4 * lq;
#pragma unroll
            for (int db = 0; db < 4; ++db) { const f32x4 o = Oa[db][qb] * inv; v2u w; w.x = pk2(o.x, o.y); w.y = pk2(o.z, o.w); *(v2u*)(op + 16 * db) = w; } }
    }
}

__device__ __forceinline__ void phase_assemble(const Args& a, int l, const bf16* P, const _Float16* RF, const _Float16* LO, const _Float16* YO, bf16* MIX, int nrows) {
    const int lane = otid() & 63, gw = obid() * 8 + (otid() >> 6), NGW = ogdim() * 8, c = 4 * lane;
    const f32x4 ng = *(const f32x4*)(a.in[I_GNORM] + l * 256 + c), ka = *(const f32x4*)(a.in[I_KA] + l * 256 + c), rk = *(const f32x4*)(a.in[I_RK] + l * 256 + c);
    const f32x4 gg = *(const f32x4*)(a.in[I_GNG] + l * 256 + c), gb = *(const f32x4*)(a.in[I_GNB] + l * 256 + c);
    for (int row = gw; row < nrows; row += NGW) {
        {
            const h4 of = *(const h4*)(YO + ((size_t)2 * MA + row) * 256 + c), ob = *(const h4*)(YO + ((size_t)3 * MA + row) * 256 + c);
            f32x4 o; float ss = 0.f;
#pragma unroll
            for (int e = 0; e < 4; ++e) { o[e] = (float)of[e] + (float)ob[e]; ss += o[e] * o[e]; }
            ss += __shfl_xor(ss, 1); ss += __shfl_xor(ss, 2); ss += __shfl_xor(ss, 4); ss += __shfl_xor(ss, 8);
            const float rms = 1.0f / sqrtf(ss * (1.0f / 64.0f) + LN_EPS);
            const v2u g2 = *(const v2u*)(P + (size_t)row * DINP + PC_GG + c);
            const float ga[4] = {bflo(g2.x), bfhi(g2.x), bflo(g2.y), bfhi(g2.y)}; float r[4];
#pragma unroll
            for (int e = 0; e < 4; ++e) r[e] = o[e] * rms * ng[e] * (ga[e] * sigmoidf_(ga[e]));
            v2u w; w.x = pk2(r[0], r[1]); w.y = pk2(r[2], r[3]); *(v2u*)(MIX + (size_t)row * 1024 + c) = w; }
        {
            const h4 yf = *(const h4*)(YO + ((size_t)0 * MA + row) * 256 + c), yb = *(const h4*)(YO + ((size_t)1 * MA + row) * 256 + c);
            const _Float16* rf = RF + (size_t)row * 1024 + c; const _Float16* lo = LO + (size_t)row * 1536 + c;
            const h4 r4 = *(const h4*)(rf + RF_R), k4 = *(const h4*)(rf + RF_K), v4 = *(const h4*)(rf + RF_V);
            const h4 af = *(const h4*)(lo + LC_A), ab = *(const h4*)(lo + LC_A + 256), g4 = *(const h4*)(lo + LC_G);
            f32x4 y; float s1 = 0.f, bon = 0.f;
#pragma unroll
            for (int e = 0; e < 4; ++e) { y[e] = (float)yf[e] + (float)yb[e]; s1 += y[e];
                bon += (float)r4[e] * (float)k4[e] * (1.0f + (0.5f * ((float)af[e] + (float)ab[e]) - 1.0f) * ka[e]) * rk[e]; }
            s1 += __shfl_xor(s1, 1); s1 += __shfl_xor(s1, 2); s1 += __shfl_xor(s1, 4); s1 += __shfl_xor(s1, 8);
            bon += __shfl_xor(bon, 1); bon += __shfl_xor(bon, 2); bon += __shfl_xor(bon, 4); bon += __shfl_xor(bon, 8);
            const float mu = s1 * (1.0f / 64.0f); float s2 = 0.f;
#pragma unroll
            for (int e = 0; e < 4; ++e) { y[e] -= mu; s2 += y[e] * y[e]; }
            s2 += __shfl_xor(s2, 1); s2 += __shfl_xor(s2, 2); s2 += __shfl_xor(s2, 4); s2 += __shfl_xor(s2, 8);
            const float rstd = 1.0f / sqrtf(s2 * (1.0f / 64.0f) + 64e-5f); float r[4];
#pragma unroll
            for (int e = 0; e < 4; ++e) r[e] = (y[e] * rstd * gg[e] + gb[e] + bon * (float)v4[e]) * (float)g4[e];
            v2u w; w.x = pk2(r[0], r[1]); w.y = pk2(r[2], r[3]); *(v2u*)(MIX + (size_t)row * 1024 + 768 + c) = w; }
    }
}

#define XB_TMO      128
#define XB_XCNT(j)  (256  + 64 * (j))
#define XB_XSUB(j)  (1280 + 64 * (j))
#define XB_XGEN(j)  (2304 + 64 * (j))
#define XB_TOP      3328
#define XB_TOPGEN   3392
#define XCD_BAR_WORDS 3456
#define XB_SPIN_CAP (1u << 18)

__device__ __forceinline__ unsigned xb_ld(unsigned* p)              { return __hip_atomic_load(p, __ATOMIC_RELAXED, __HIP_MEMORY_SCOPE_AGENT); }
__device__ __forceinline__ unsigned xb_add(unsigned* p, unsigned v) { return __hip_atomic_fetch_add(p, v, __ATOMIC_RELAXED, __HIP_MEMORY_SCOPE_AGENT); }
__device__ __forceinline__ unsigned xb_xcc_id() { return (unsigned)__builtin_amdgcn_s_getreg((3 << 11) | 20) & 0xFu; }
#define XB_SPIN(cond, bar) do { unsigned _sp = 0; while (cond) { __builtin_amdgcn_s_sleep(1); \
    if ((++_sp & 255u) == 0u) { if (xb_ld(&(bar)[XB_TMO])) break; if (_sp > XB_SPIN_CAP) { atomicAdd(&(bar)[XB_TMO], 1u); break; } } } } while (0)

struct XcdBarrier {
    unsigned* bar; unsigned x;
    volatile LAS unsigned* st;
};

__device__ __forceinline__ XcdBarrier xcd_barrier_post(unsigned* bar, volatile LAS unsigned* st) {
    XcdBarrier b; b.bar = bar; b.x = xb_xcc_id(); b.st = st;
    if (threadIdx.x == 0) (void)xb_add(&bar[XB_XCNT(b.x)], 1u);
    return b;
}
__device__ __forceinline__ void xcd_barrier_complete(unsigned* bar, unsigned x, unsigned& nloc, unsigned& nx) {
    const unsigned G = gridDim.x * gridDim.y * gridDim.z;
    unsigned sum, cnt, mine, sp = 0u;
    for (;;) {
        sum = 0u; cnt = 0u; mine = 0u;
#pragma unroll
        for (unsigned j = 0; j < 16; ++j) { const unsigned c = xb_ld(&bar[XB_XCNT(j)]); sum += c; cnt += (c > 0u) ? 1u : 0u; mine = (j == x) ? c : mine; }
        if (sum == G) break;
        __builtin_amdgcn_s_sleep(1);
        if ((++sp & 255u) == 0u) { if (xb_ld(&bar[XB_TMO])) break; if (sp > XB_SPIN_CAP) { atomicAdd(&bar[XB_TMO], 1u); break; } }
    }
    nloc = mine > 0u ? mine : 1u; nx = cnt > 0u ? cnt : 1u;
}

__device__ __forceinline__ void xcd_barrier(const XcdBarrier& b) {
    asm volatile("s_waitcnt vmcnt(0)" ::: "memory");
    __syncthreads();
    if (threadIdx.x == 0) {
        unsigned* bar = b.bar;
        __builtin_amdgcn_s_waitcnt(0);
        unsigned nloc = b.st[0], nx = b.st[1];
        if (nloc == 0u) { xcd_barrier_complete(bar, b.x, nloc, nx); b.st[0] = nloc; b.st[1] = nx; }
        const unsigned old = xb_add(&bar[XB_XSUB(b.x)], 1u);
        const unsigned gen = old / nloc;
        if (old + 1u == (gen + 1u) * nloc) {
            __builtin_amdgcn_fence(__ATOMIC_RELEASE, "agent");
            asm volatile("s_waitcnt vmcnt(0)" ::: "memory");
            const unsigned og = xb_add(&bar[XB_TOP], 1u);
            const unsigned tg = og / nx;
            if (og + 1u == (tg + 1u) * nx) xb_add(&bar[XB_TOPGEN], 1u);
            else XB_SPIN(xb_ld(&bar[XB_TOPGEN]) == tg, bar);
            __builtin_amdgcn_fence(__ATOMIC_ACQUIRE, "agent");
            xb_add(&bar[XB_XGEN(b.x)], 1u);
            asm volatile("s_waitcnt vmcnt(0)" ::: "memory");
        } else {
            XB_SPIN(xb_ld(&bar[XB_XGEN(b.x)]) == gen, bar);
            __builtin_amdgcn_fence(__ATOMIC_ACQUIRE, "agent");
            asm volatile("s_waitcnt vmcnt(0)" ::: "memory");
        }
    }
    __syncthreads();
}

#define GSYNC() do { XcdBarrier xb_; xb_.bar = (unsigned*)a.ws; xb_.x = xb_xcc_id(); xb_.st = (volatile LAS unsigned*)(lds + 133120); xcd_barrier(xb_); } while (0)
#ifndef REP_RWKV
#define REP_RWKV 1
#endif
#ifndef REP_GLA
#define REP_GLA 1
#endif
#ifndef REP_SWA
#define REP_SWA 1
#endif
#ifndef REP_UP
#define REP_UP 1
#endif
__global__ void __launch_bounds__(512, 2) mega_fwd(Args a) {
    extern __shared__ __attribute__((aligned(16))) unsigned char lds_raw[];
    cg::grid_group grid = cg::this_grid();
    LAS unsigned char* lds = (LAS unsigned char*)lds_raw;
    unsigned char* ws = a.ws;
    float* MOD = (float*)(ws + WS_MOD); float* STATS = (float*)(ws + WS_STATS);
    float* XL = a.out; float* XC = (float*)(ws + WS_XC);
    bf16* U = (bf16*)(ws + WS_U); bf16* HID = (bf16*)(ws + WS_HID);
    _Float16* LO = (_Float16*)(ws + WS_LO); _Float16* RF = (_Float16*)(ws + WS_RF); _Float16* YO = (_Float16*)(ws + WS_YO);

    { volatile LAS unsigned* st = (volatile LAS unsigned*)(lds + 133120); if (threadIdx.x < 2) st[threadIdx.x] = 0u; }
    __syncthreads();
    (void)xcd_barrier_post((unsigned*)ws, (volatile LAS unsigned*)(lds + 133120));
    phase_adaln(a, MOD, lds);
    __syncthreads();
    phase_convert(a, 0, ws, lds);
    grid.sync();
    phase_mod0(a, MOD, U);
    GSYNC();
    for (int l = 0; l < DEPTH; ++l) {
        const bool last = (l == DEPTH - 1);
        asm volatile("" : "+s"(ws));
        const float* modl = MOD + (size_t)l * 9 * 9216;
        const float* lng = a.in[I_LNG] + l * 3 * 1024; const float* lnb = a.in[I_LNB] + l * 3 * 1024;
        for (int rep = 0; rep < REP_UP; ++rep) { pg8::Gemm g{U, (const bf16*)(ws + WS_WGU1), MA, 2 * DFF, 1024}; pg8::StaticOrder S; S.init(MA, 2 * DFF, ogdim(), obid());
          pg8::EpiSwiglu E{HID, DFF}; pg8::gemm_phase<pg8::EpiSwiglu, pg8::StaticOrder, true, true>(lds, g, S, E); }
        GSYNC();
        { pg8::Gemm g{HID, (const bf16*)(ws + WS_WD1), MA, 1024, DFF}; pg8::StaticOrder S; S.init(MA, 1024, ogdim(), obid());
          pg8::EpiResid E{l == 0 ? a.in[I_X] : XL, l == 0 ? a.in[I_CTX] : XC, XL, XC, modl + 2 * 1024, ALPHA, 0.5f, STATS, lng - 1024, lnb - 1024, l > 0 ? 1 : 0};
          pg8::gemm_phase<pg8::EpiResid, pg8::StaticOrder, true, true>(lds, g, S, E); }
        GSYNC();
        phase_ln(XL, XC, lng, lnb, modl + 3 * 1024, U, MA, true, STATS, false);
        GSYNC();
        { pg8::Gemm g{U, (const bf16*)(ws + WS_WIN), MA, DINP, 1024}; pg8::StaticOrder S; S.init(MA, DINP, ogdim(), obid());
          pg8::EpiStore E{HID, DINP}; pg8::gemm_phase<pg8::EpiStore, pg8::StaticOrder, true, true>(lds, g, S, E); }
        GSYNC();
        phase_features(a, l, HID, RF, U, lds);
        GSYNC();
        { pg8::Gemm g{U, (const bf16*)(ws + WS_WLORA), MA, LORA_N, LORA_K}; pg8::StaticOrder S; S.init(MA, LORA_N, ogdim(), obid());
          pg8::EpiLora E{LO, a.in[I_W0] + l * 512, a.in[I_A0] + l * 512, a.in[I_GBIAS] + l * 256};
          pg8::gemm_phase<pg8::EpiLora, pg8::StaticOrder, true, true>(lds, g, S, E); }
        GSYNC();
        phase_gla_a(l, HID, LO, YO, (_Float16*)(ws + WS_KV), (float*)(ws + WS_DEC), lds);
        __syncthreads();
        for (int rep = 0; rep < REP_SWA; ++rep) { phase_swa(a, l, HID, U, !last, lds); __syncthreads(); }
        GSYNC();
        phase_gla_b((const _Float16*)(ws + WS_KV), (const float*)(ws + WS_DEC), (bf16*)(ws + WS_ST));
        for (int rep = 0; rep < REP_RWKV; ++rep) { phase_rwkv(a, l, RF, LO, YO, lds); __syncthreads(); }
        GSYNC();
        phase_gla_c(HID, (const bf16*)(ws + WS_ST), YO);
        GSYNC();
        phase_assemble(a, l, HID, RF, LO, YO, U, last ? ML : MA);
        GSYNC();
        const int Mo = last ? ML : MA;
        { pg8::Gemm g{U, (const bf16*)(ws + WS_WOUT), Mo, 1024, 1024}; pg8::StaticOrder S; S.init(Mo, 1024, ogdim(), obid());
          pg8::EpiResid E{XL, XC, XL, XC, modl + 5 * 1024, ALPHA, 1.0f, STATS, lng, lnb, 1};
          pg8::gemm_phase<pg8::EpiResid, pg8::StaticOrder, true, true>(lds, g, S, E); }
        GSYNC();
        phase_ln(XL, XC, lng + 1024, lnb + 1024, modl + 6 * 1024, U, Mo, true, STATS, false);
        GSYNC();
        { pg8::Gemm g{U, (const bf16*)(ws + WS_WGU2), Mo, 2 * DFF, 1024}; pg8::StaticOrder S; S.init(Mo, 2 * DFF, ogdim(), obid());
          pg8::EpiSwiglu E{HID, DFF}; pg8::gemm_phase<pg8::EpiSwiglu, pg8::StaticOrder, true, true>(lds, g, S, E); }
        GSYNC();
        { pg8::Gemm g{HID, (const bf16*)(ws + WS_WD2), Mo, 1024, DFF}; pg8::StaticOrder S; S.init(Mo, 1024, ogdim(), obid());
          pg8::EpiResid E{XL, XC, XL, XC, modl + 8 * 1024, ALPHA, 0.5f, STATS, lng + 1024, lnb + 1024, 1};
          pg8::gemm_phase<pg8::EpiResid, pg8::StaticOrder, true, true>(lds, g, S, E); }
        GSYNC();
        phase_ln(XL, XC, lng + 2048, lnb + 2048, MOD + (size_t)(last ? l : l + 1) * 9 * 9216, U, Mo, !last, STATS, last);
        if (!last) { __syncthreads(); phase_convert(a, l + 1, ws, lds); }
        GSYNC();
    }
}

extern "C" void kernel_launch(void* const* d_in, const int* in_sizes, int n_in, void* d_out, int out_size, void* d_ws, size_t ws_size, hipStream_t stream) {
    static int grid = 0;
    if (grid == 0) {
        if (n_in != 31 || out_size != ML * DM || ws_size < WS_END) { fprintf(stderr, "kernel_launch: unexpected problem (n_in %d, out %d, ws %zu need %zu)\n", n_in, out_size, ws_size, (size_t)WS_END); grid = -1; return; }
        int dev = 0, cus = 0, per_cu = 0;
        hipGetDevice(&dev); hipDeviceGetAttribute(&cus, hipDeviceAttributeMultiprocessorCount, dev);
        if (hipFuncSetAttribute((const void*)mega_fwd, hipFuncAttributeMaxDynamicSharedMemorySize, LDS_BYTES) != hipSuccess) { fprintf(stderr, "kernel_launch: hipFuncSetAttribute failed\n"); grid = -1; return; }
        if (hipOccupancyMaxActiveBlocksPerMultiprocessor(&per_cu, (const void*)mega_fwd, 512, LDS_BYTES) != hipSuccess || per_cu < 1) { fprintf(stderr, "kernel_launch: occupancy query says %d\n", per_cu); per_cu = 1; }
        (void)hipGetLastError();
        grid = cus * per_cu;
    }
    if (grid < 0) return;
    if (hipMemsetAsync(d_ws, 0, 65536, stream) != hipSuccess) { fprintf(stderr, "kernel_launch: memset failed\n"); return; }
    Args a{};
    for (int i = 0; i < 31; ++i) a.in[i] = (const float*)d_in[i];
    a.out = (float*)d_out; a.ws = (unsigned char*)d_ws;
    void* args[] = {&a};
    const hipError_t e = hipLaunchCooperativeKernel((const void*)mega_fwd, dim3(grid), dim3(512), args, LDS_BYTES, stream);
    if (e != hipSuccess) fprintf(stderr, "kernel_launch: cooperative launch failed: %s (grid %d)\n", hipGetErrorString(e), grid);
}
```
